# Optimizing an MI355X kernel written in HIP

```python
import math
import jax, jax.numpy as jnp
from jax import lax
import numpy as np

D_MODEL = 2048
BATCH = 4
SEQ = 4096
DEPTH = 2

DA_HEADS = 4
DA_HEAD_DIM = 128
DA_V_DIM = 2 * DA_HEAD_DIM
DA_WIDTH = DA_HEADS * DA_V_DIM
Q_BLOCK = 128
GLA_HEADS = 4
GLA_DK = 128
GLA_DV = 256
GLA_WIDTH = GLA_HEADS * GLA_DV
GLA_GATE_RANK = 16
GLA_TAU = 16.0
GLA_CHUNK = 64
SSD_HEADS = 16
SSD_HEAD_DIM = 64
SSD_STATE = 128
SSD_GROUPS = 4
SSD_CONV = 4
SSD_CHUNK = 128
SSD_WIDTH = SSD_HEADS * SSD_HEAD_DIM
SSD_CONV_DIM = SSD_WIDTH + 2 * SSD_GROUPS * SSD_STATE
N_BRANCH = 3
BRANCH_WIDTH = 1024
N_EXPERTS = 64
TOP_K = 8
EXPERT_DIM = 512
N_EXPERT_GROUPS = 8
TOPK_GROUPS = 4
ROUTED_SCALE = 2.5
MOE_BLOCK = 256
DEEPNORM_ALPHA = (2 * DEPTH) ** 0.25
DEEPNORM_BETA = (8 * DEPTH) ** -0.25
EPS = 1e-5

IN_SIZES = (
    DA_HEADS * 2 * DA_HEAD_DIM,
    DA_HEADS * 2 * DA_HEAD_DIM,
    DA_WIDTH,
    GLA_HEADS * GLA_DK,
    GLA_HEADS * GLA_DK,
    GLA_WIDTH,
    GLA_GATE_RANK,
    GLA_WIDTH,
    SSD_WIDTH,
    SSD_CONV_DIM,
    SSD_HEADS,
    N_BRANCH * D_MODEL,
)
IN_WIDTH = 15392

kernel_name = "hybrid_diffattn_gla_ssd_moe_deepnorm"


def _rmsnorm(x, g):
    xf = x.astype(jnp.float32)
    y = xf * lax.rsqrt(jnp.mean(xf * xf, axis=-1, keepdims=True) + EPS)
    return (y * g).astype(x.dtype)


def _layernorm(x, g, b):
    xf = x.astype(jnp.float32)
    mu = jnp.mean(xf, axis=-1, keepdims=True)
    var = jnp.mean((xf - mu) ** 2, axis=-1, keepdims=True)
    y = (xf - mu) * lax.rsqrt(var + EPS)
    return (y * g + b).astype(x.dtype)


def _diff_attention(q, k, v, lam_params, norm_g, layer_idx):
    B, S, _ = q.shape
    H, d = DA_HEADS, DA_HEAD_DIM
    q = q.reshape(B, S, H, 2, d).transpose(0, 2, 3, 1, 4) * (d ** -0.5)
    k = k.reshape(B, S, H, 2, d).transpose(0, 2, 3, 1, 4)
    v = v.reshape(B, S, H, DA_V_DIM).transpose(0, 2, 1, 3)
    lam_init = 0.8 - 0.6 * math.exp(-0.3 * layer_idx)
    lp = lam_params.astype(jnp.float32)
    lam = jnp.exp(jnp.sum(lp[0] * lp[1])) - jnp.exp(jnp.sum(lp[2] * lp[3])) + lam_init
    slopes = 2.0 ** (-8.0 * jnp.arange(1, H + 1, dtype=jnp.float32) / H)
    kpos = jnp.arange(S)

    def block(i):
        start = i * Q_BLOCK
        qb = lax.dynamic_slice_in_dim(q, start, Q_BLOCK, axis=3)
        qpos = start + jnp.arange(Q_BLOCK)
        s = jnp.einsum('bhcqd,bhckd->bhcqk', qb, k).astype(jnp.float32)
        dist = (qpos[:, None] - kpos[None, :]).astype(jnp.float32)
        s = s - slopes[None, :, None, None, None] * dist
        s = jnp.where(dist >= 0, s, -jnp.inf)
        p = jax.nn.softmax(s, axis=-1)
        a = p[:, :, 0] - lam * p[:, :, 1]
        return jnp.einsum('bhqk,bhke->bhqe', a.astype(v.dtype), v)

    o = lax.map(block, jnp.arange(S // Q_BLOCK))
    o = o.transpose(1, 0, 3, 2, 4).reshape(B, S, H, DA_V_DIM)
    o = _rmsnorm(o, norm_g) * (1.0 - lam_init)
    return o.reshape(B, S, DA_WIDTH)


def _gla(q, k, v, gate_lr, r, w2, b2, norm_g):
    B, S, _ = q.shape
    H, dk, dv, C = GLA_HEADS, GLA_DK, GLA_DV, GLA_CHUNK
    N = S // C
    gk = jax.nn.log_sigmoid((gate_lr @ w2 + b2).astype(jnp.float32)) / GLA_TAU

    def chunks(t, dim):
        return t.reshape(B, N, C, H, dim).transpose(0, 3, 1, 2, 4)

    q = chunks(q, dk) * (dk ** -0.5)
    k = chunks(k, dk)
    v = chunks(v, dv)
    bcum = jnp.cumsum(chunks(gk, dk), axis=3)
    q_e = q * jnp.exp(bcum)
    k_e = k * jnp.exp(-bcum)
    k_d = k * jnp.exp(bcum[..., -1:, :] - bcum)
    causal = jnp.tril(jnp.ones((C, C), dtype=bool))
    att = jnp.where(causal, jnp.einsum('bhncd,bhnsd->bhncs', q_e, k_e), 0.0)
    o_intra = jnp.einsum('bhncs,bhnse->bhnce', att, v)
    upd = jnp.einsum('bhnsd,bhnse->bhnde', k_d, v)
    decay = jnp.exp(bcum[..., -1, :])

    def step(state, inp):
        dec, u = inp
        return dec[..., None] * state + u, state

    _, s_prev = lax.scan(step, jnp.zeros_like(upd[:, :, 0]),
                         (jnp.moveaxis(decay, 2, 0), jnp.moveaxis(upd, 2, 0)))
    s_prev = jnp.moveaxis(s_prev, 0, 2)
    o = o_intra + jnp.einsum('bhncd,bhnde->bhnce', q_e, s_prev)
    o = o.transpose(0, 2, 3, 1, 4).reshape(B, S, H, dv)
    o = _rmsnorm(o, norm_g).reshape(B, S, GLA_WIDTH)
    return o * jax.nn.silu(r)


def _ssd(z, xbc, dt, conv_w, conv_b, dt_bias, a_log, d_skip, norm_g):
    B, S, _ = z.shape
    G, R, P, NS, Q = SSD_GROUPS, SSD_HEADS // SSD_GROUPS, SSD_HEAD_DIM, SSD_STATE, SSD_CHUNK
    N = S // Q
    xbc = lax.conv_general_dilated(xbc, conv_w[:, None, :], window_strides=(1,),
                                   padding=[(SSD_CONV - 1, 0)],
                                   dimension_numbers=('NWC', 'WIO', 'NWC'),
                                   feature_group_count=SSD_CONV_DIM)
    xbc = jax.nn.silu(xbc + conv_b)
    xs, bm, cm = jnp.split(xbc, [SSD_WIDTH, SSD_WIDTH + G * NS], axis=-1)
    xs = xs.reshape(B, N, Q, G, R, P)
    bm = bm.reshape(B, N, Q, G, NS)
    cm = cm.reshape(B, N, Q, G, NS)
    dt = jax.nn.softplus((dt + dt_bias).astype(jnp.float32)).reshape(B, N, Q, G, R)
    a = -jnp.exp(a_log.astype(jnp.float32)).reshape(G, R)
    a_cs = jnp.cumsum((dt * a).transpose(0, 3, 4, 1, 2), axis=-1)
    xdt = xs * dt[..., None]
    causal = jnp.tril(jnp.ones((Q, Q), dtype=bool))
    lmat = jnp.exp(jnp.where(causal, a_cs[..., :, None] - a_cs[..., None, :], -jnp.inf))
    cb = jnp.einsum('bnlgs,bnmgs->bgnlm', cm, bm)
    y_diag = jnp.einsum('bgnlm,bgrnlm,bnmgrp->bnlgrp', cb, lmat, xdt)
    decay_states = jnp.exp(a_cs[..., -1:] - a_cs)
    states = jnp.einsum('bnmgs,bgrnm,bnmgrp->bngrps', bm, decay_states, xdt)
    chunk_cs = jnp.cumsum(jnp.pad(a_cs[..., -1], ((0, 0), (0, 0), (0, 0), (1, 0))), axis=-1)
    cmask = jnp.tril(jnp.ones((N + 1, N + 1), dtype=bool))
    decay_chunk = jnp.exp(jnp.where(cmask, chunk_cs[..., :, None] - chunk_cs[..., None, :], -jnp.inf))
    states = jnp.pad(states, ((0, 0), (1, 0), (0, 0), (0, 0), (0, 0), (0, 0)))
    s_prev = jnp.einsum('bgrzc,bcgrps->bzgrps', decay_chunk, states)[:, :N]
    y_off = jnp.einsum('bnlgs,bngrps,bgrnl->bnlgrp', cm, s_prev, jnp.exp(a_cs))
    y = y_diag + y_off + xs * d_skip.reshape(G, R)[:, :, None]
    y = y.reshape(B, S, SSD_WIDTH) * jax.nn.silu(z)
    gw = SSD_WIDTH // G
    y = _rmsnorm(y.reshape(B, S, G, gw), norm_g.reshape(G, gw))
    return y.reshape(B, S, SSD_WIDTH)


def _routed_experts(xt, eidx, w, wg, wu, wd):
    T = xt.shape[0]
    A = T * TOP_K
    flat_e = eidx.reshape(-1)
    flat_w = w.reshape(-1)
    flat_tok = jnp.arange(A, dtype=jnp.int32) // TOP_K
    order = jnp.argsort(flat_e)
    e_sorted = flat_e[order]
    counts = jnp.bincount(flat_e, length=N_EXPERTS)
    padded = (counts + MOE_BLOCK - 1) // MOE_BLOCK * MOE_BLOCK
    start = jnp.cumsum(counts) - counts
    pend = jnp.cumsum(padded)
    pstart = pend - padded
    dest = pstart[e_sorted] + jnp.arange(A, dtype=jnp.int32) - start[e_sorted]
    nblk = -(-(A + N_EXPERTS * MOE_BLOCK) // MOE_BLOCK)
    P = nblk * MOE_BLOCK
    tok_buf = jnp.zeros((P,), jnp.int32).at[dest].set(flat_tok[order])
    w_buf = jnp.zeros((P,), flat_w.dtype).at[dest].set(flat_w[order])
    blk_e = jnp.minimum(jnp.searchsorted(pend, jnp.arange(nblk) * MOE_BLOCK, side='right'),
                        N_EXPERTS - 1)

    def body(j, y):
        tok = lax.dynamic_slice_in_dim(tok_buf, j * MOE_BLOCK, MOE_BLOCK)
        wt = lax.dynamic_slice_in_dim(w_buf, j * MOE_BLOCK, MOE_BLOCK)
        e = blk_e[j]
        xb = xt[tok]
        h = jax.nn.silu(xb @ wg[e]) * (xb @ wu[e])
        out = (h @ wd[e]) * wt[:, None]
        return y.at[tok].add(out.astype(y.dtype))

    return lax.fori_loop(0, nblk, body, jnp.zeros_like(xt))


def _moe(u, router_w, router_bias, wg, wu, wd, sg, su, sd):
    B, S, D = u.shape
    xt = u.reshape(B * S, D)
    scores = jax.nn.sigmoid((xt @ router_w).astype(jnp.float32))
    sel = scores + router_bias.astype(jnp.float32)
    grp = sel.reshape(-1, N_EXPERT_GROUPS, N_EXPERTS // N_EXPERT_GROUPS)
    gscore = lax.top_k(grp, 2)[0].sum(-1)
    _, gidx = lax.top_k(gscore, TOPK_GROUPS)
    gmask = jax.nn.one_hot(gidx, N_EXPERT_GROUPS).sum(-2) > 0
    emask = jnp.repeat(gmask, N_EXPERTS // N_EXPERT_GROUPS, axis=-1)
    _, eidx = lax.top_k(jnp.where(emask, sel, -jnp.inf), TOP_K)
    w = jnp.take_along_axis(scores, eidx, axis=-1)
    w = w / jnp.sum(w, axis=-1, keepdims=True) * ROUTED_SCALE
    routed = _routed_experts(xt, eidx, w, wg, wu, wd)
    shared = (jax.nn.silu(xt @ sg) * (xt @ su)) @ sd
    return (routed + shared).reshape(B, S, D)


def setup_inputs(seed: int = 0) -> dict:
    key = jax.random.key(seed)
    ks = jax.random.split(key, 32)
    f32 = jnp.float32

    def nrm(k, shape, scale):
        return jax.random.normal(k, shape, f32) * scale

    L, D, E, F = DEPTH, D_MODEL, N_EXPERTS, EXPERT_DIM
    dt0 = jnp.exp(jax.random.uniform(ks[9], (L, SSD_HEADS), f32, math.log(1e-3), math.log(1e-1)))
    return {
        "x": nrm(ks[0], (BATCH, SEQ, D), 1.0),
        "w_in": nrm(ks[1], (L, D, IN_WIDTH), D ** -0.5),
        "da_lambda": nrm(ks[2], (L, 4, DA_HEAD_DIM), 0.1),
        "da_norm_g": 1.0 + nrm(ks[3], (L, DA_V_DIM), 0.02),
        "gla_gate_w2": nrm(ks[4], (L, GLA_GATE_RANK, GLA_HEADS * GLA_DK), GLA_GATE_RANK ** -0.5),
        "gla_gate_b": nrm(ks[5], (L, GLA_HEADS * GLA_DK), 0.1),
        "gla_norm_g": 1.0 + nrm(ks[6], (L, GLA_DV), 0.02),
        "ssd_conv_w": nrm(ks[7], (L, SSD_CONV, SSD_CONV_DIM), SSD_CONV ** -0.5),
        "ssd_conv_b": nrm(ks[8], (L, SSD_CONV_DIM), 0.02),
        "ssd_dt_bias": dt0 + jnp.log(-jnp.expm1(-dt0)),
        "ssd_a_log": jnp.log(jax.random.uniform(ks[10], (L, SSD_HEADS), f32, 1.0, 16.0)),
        "ssd_d": 1.0 + nrm(ks[11], (L, SSD_HEADS), 0.02),
        "ssd_norm_g": 1.0 + nrm(ks[12], (L, SSD_WIDTH), 0.02),
        "w_branch": nrm(ks[13], (L, N_BRANCH, BRANCH_WIDTH, D), BRANCH_WIDTH ** -0.5 * DEEPNORM_BETA),
        "w_out": nrm(ks[14], (L, D, D), D ** -0.5 * DEEPNORM_BETA),
        "ln1_g": 1.0 + nrm(ks[15], (L, D), 0.02),
        "ln1_b": nrm(ks[16], (L, D), 0.02),
        "router_w": nrm(ks[17], (L, D, E), D ** -0.5),
        "router_bias": nrm(ks[18], (L, E), 0.01),
        "exp_w_gate": nrm(ks[19], (L, E, D, F), D ** -0.5),
        "exp_w_up": nrm(ks[20], (L, E, D, F), D ** -0.5),
        "exp_w_down": nrm(ks[21], (L, E, F, D), F ** -0.5 * DEEPNORM_BETA),
        "sh_w_gate": nrm(ks[22], (L, D, F), D ** -0.5),
        "sh_w_up": nrm(ks[23], (L, D, F), D ** -0.5),
        "sh_w_down": nrm(ks[24], (L, F, D), F ** -0.5 * DEEPNORM_BETA),
        "ln2_g": 1.0 + nrm(ks[25], (L, D), 0.02),
        "ln2_b": nrm(ks[26], (L, D), 0.02),
    }


def reference(x, w_in, da_lambda, da_norm_g, gla_gate_w2, gla_gate_b, gla_norm_g,
              ssd_conv_w, ssd_conv_b, ssd_dt_bias, ssd_a_log, ssd_d, ssd_norm_g,
              w_branch, w_out, ln1_g, ln1_b, router_w, router_bias,
              exp_w_gate, exp_w_up, exp_w_down, sh_w_gate, sh_w_up, sh_w_down,
              ln2_g, ln2_b):
    B, S, D = x.shape
    offsets = np.cumsum(IN_SIZES)[:-1].tolist()
    for l in range(DEPTH):
        proj = x @ w_in[l]
        (da_q, da_k, da_v, g_q, g_k, g_v, g_lr, g_r,
         s_z, s_xbc, s_dt, m_gate) = jnp.split(proj, offsets, axis=-1)
        br_a = _diff_attention(da_q, da_k, da_v, da_lambda[l], da_norm_g[l], l)
        br_b = _gla(g_q, g_k, g_v, g_lr, g_r, gla_gate_w2[l], gla_gate_b[l], gla_norm_g[l])
        br_c = _ssd(s_z, s_xbc, s_dt, ssd_conv_w[l], ssd_conv_b[l], ssd_dt_bias[l],
                    ssd_a_log[l], ssd_d[l], ssd_norm_g[l])
        gates = jax.nn.sigmoid(m_gate.reshape(B, S, N_BRANCH, D))
        branches = (br_a, br_b, br_c)
        merged = gates[:, :, 0] * (branches[0] @ w_branch[l, 0])
        for i in range(1, N_BRANCH):
            merged = merged + gates[:, :, i] * (branches[i] @ w_branch[l, i])
        mix = merged @ w_out[l]
        x = _layernorm(DEEPNORM_ALPHA * x + mix, ln1_g[l], ln1_b[l])
        ffn = _moe(x, router_w[l], router_bias[l], exp_w_gate[l], exp_w_up[l], exp_w_down[l],
                   sh_w_gate[l], sh_w_up[l], sh_w_down[l])
        x = _layernorm(DEEPNORM_ALPHA * x + ffn, ln2_g[l], ln2_b[l])
    return x
```

```cpp
#include <hip/hip_runtime.h>
#include <cstdio>
#include <cstdint>

#define LAS __attribute__((address_space(3)))
#define GAS __attribute__((address_space(1)))
typedef unsigned short bf16_t;
typedef short bf16x8 __attribute__((ext_vector_type(8)));
typedef short s16x4 __attribute__((ext_vector_type(4)));
typedef float f32x4 __attribute__((ext_vector_type(4)));
typedef float f32x2 __attribute__((ext_vector_type(2)));
typedef float f32x16 __attribute__((ext_vector_type(16)));
typedef unsigned u32x4 __attribute__((ext_vector_type(4)));
typedef unsigned u32x2 __attribute__((ext_vector_type(2)));
typedef GAS unsigned gu32;
typedef int i32x4 __attribute__((ext_vector_type(4)));
typedef int i32x8 __attribute__((ext_vector_type(8)));
typedef unsigned char fp8_t;
typedef float f32x2_ __attribute__((ext_vector_type(2)));
__device__ __forceinline__ void unpk4_fp8(unsigned w, float (&o)[4]) { const f32x2_ a = __builtin_amdgcn_cvt_pk_f32_fp8((int)w, false), b = __builtin_amdgcn_cvt_pk_f32_fp8((int)w, true); o[0] = a.x; o[1] = a.y; o[2] = b.x; o[3] = b.y; }
__device__ __forceinline__ float clamp448(float x) { return __builtin_amdgcn_fmed3f(x, -448.0f, 448.0f); }
__device__ __forceinline__ unsigned pk4_fp8(float a, float b, float c, float d) { int r = 0; r = __builtin_amdgcn_cvt_pk_fp8_f32(clamp448(a), clamp448(b), r, false); r = __builtin_amdgcn_cvt_pk_fp8_f32(clamp448(c), clamp448(d), r, true); return (unsigned)r; }
constexpr float OSCALE = 16.0f;
constexpr float WSCALE = 64.0f; constexpr int SC_W = 0x7c7c7c7c, SC_A = 0x7c7c7c7c;

__device__ __forceinline__ unsigned cvt_pk_bf16(float lo, float hi) { unsigned r; asm volatile("v_cvt_pk_bf16_f32 %0, %1, %2" : "=v"(r) : "v"(lo), "v"(hi)); return r; }
typedef __bf16 bf16x2_t __attribute__((ext_vector_type(2)));
__device__ __forceinline__ unsigned cvtpk(float lo, float hi) { f32x2 v = {lo, hi}; bf16x2_t b = __builtin_convertvector(v, bf16x2_t); return __builtin_bit_cast(unsigned, b); }
__device__ __forceinline__ float bf2f(unsigned short b) { return __uint_as_float(((unsigned)b) << 16); }
__device__ __forceinline__ float bflo(unsigned w) { return __uint_as_float(w << 16); }
__device__ __forceinline__ float bfhi(unsigned w) { return __uint_as_float(w & 0xffff0000u); }
__device__ __forceinline__ unsigned short f2bf(float f) { unsigned u = __float_as_uint(f); return (unsigned short)((u + 0x7fffu + ((u >> 16) & 1u)) >> 16); }
__device__ __forceinline__ float fast_exp(float x) { return __builtin_amdgcn_exp2f(x * 1.4426950408889634f); }
__device__ __forceinline__ float fast_log(float x) { return __builtin_amdgcn_logf(x) * 0.6931471805599453f; }
__device__ __forceinline__ float sigmoidf_(float x) { return __builtin_amdgcn_rcpf(1.0f + fast_exp(-x)); }
__device__ __forceinline__ float siluf_(float x) { return x * sigmoidf_(x); }

namespace pg8 {
constexpr int BM = 256, BK = 64, HALF = 128, HTB = HALF * BK * 2  , STAGE_BYTES = 8 * HTB, NXCD = 8, WGM = 8;

__host__ __device__ __forceinline__ int lds_byte(int r, int c) { const int st = (r >> 4) * 2 + (c >> 5), rr = r & 15, cc = c & 31, ob = rr * 64 + cc * 2; return st * 1024 + (ob ^ (((ob >> 9) & 1) << 5)); }
__host__ __device__ __forceinline__ void stage_rc(int b, int& R, int& C) { const int st = b / 1024, sb = b % 1024, swz = sb ^ (((sb >> 9) & 1) << 5); R = (st >> 1) * 16 + swz / 64; C = (st & 1) * 32 + (swz % 64) / 2; }
__host__ __device__ __forceinline__ int perm32(int rho) { const int n = rho >> 4, i = rho & 15; return 8 * (i >> 2) + 4 * n + (i & 3); }

struct Unit { int pm, pn; };
struct Gemm { const fp8_t* A; const fp8_t* Bt; int KB; const LAS int* gidx; };

struct StaticOrder {
    int nM, nN, nwg, G, c;
    __host__ __device__ void init(int M, int N, int G_, int c_) { nM = M / BM; nN = N / BM; nwg = nM * nN; G = G_; c = c_; }
    __host__ __device__ bool next(int i, Unit& u) const {
        const long L = (long)i * G + c; if (L >= nwg) return false;
        int wgid = (int)L; { const int q = nwg / NXCD, r = nwg % NXCD, xcd = wgid % NXCD, off = wgid / NXCD; wgid = (xcd < r ? xcd * (q + 1) : r * (q + 1) + (xcd - r) * q) + off; }
        const int nig = WGM * nN, gid = wgid / nig, fm = gid * WGM, gsz = (nM - fm) < WGM ? (nM - fm) : WGM;
        u.pm = fm + ((wgid % nig) % gsz); u.pn = (wgid % nig) / gsz; return true;
    }
};
struct MoeOrder {
    const int* blk_e; int nunits, NT, G, c;
    __device__ bool next(int i, Unit& u) const {
        const int L = i * G + c; if (L >= nunits) return false;
        const int j = L / NT, pl = L - j * NT; u.pm = j; u.pn = __builtin_amdgcn_readfirstlane(blk_e[j]) * NT + pl; return true;
    }
};

#ifndef PG8_ALIGN
#define PG8_ALIGN true
#endif
template <class E, class = void> struct epi_perm16 { static constexpr bool value = false; };
template <class E> struct epi_perm16<E, decltype((void)E::PERM16)> { static constexpr bool value = E::PERM16; };
template <class E, class = void> struct epi_perm64 { static constexpr bool value = false; };
template <class E> struct epi_perm64<E, decltype((void)E::PERM64)> { static constexpr bool value = E::PERM64; };
template <class Epi, class Sched, bool GATHER, bool ALIGN_EPI = PG8_ALIGN>
__device__ __forceinline__ void gemm_phase(LAS unsigned char* lds, const Gemm g, const Sched& S, const Epi& E, int tid_in) {
    int tid_ = tid_in; asm volatile("" : "+v"(tid_));
    const int tid = tid_, wid = __builtin_amdgcn_readfirstlane(tid >> 6), lane = tid & 63, wr = wid >> 2, wc = wid & 3, fr = lane & 15, fq = lane >> 4;
    int KB_ = g.KB; asm volatile("" : "+s"(KB_));
    const int KB = KB_, nt = KB / 128;
    unsigned vA[2][2], vAn[2][2], voffB[2]; int Rl[2], Cl[2];
    const size_t hstep = (size_t)HALF * KB, q64 = (size_t)64 * KB;
    constexpr bool P16 = epi_perm16<Epi>::value, P64 = epi_perm64<Epi>::value;
    const size_t bhstep = P16 ? (size_t)8 * KB : (P64 ? (size_t)32 * KB : hstep), qB = (P16 || P64) ? (size_t)128 * KB : (size_t)64 * KB;
    const size_t tstep = 2 * hstep;
#pragma unroll
    for (int i = 0; i < 2; ++i) { int R, C; stage_rc(tid * 16 + i * 8192, R, C); const int Rb = P16 ? (64 * (R >> 5) + 16 * ((R & 15) >> 2) + 4 * ((R >> 4) & 1) + (R & 3)) : P64 ? (64 * (R >> 5) + perm32(R & 31)) : (Epi::PERM ? ((R & ~31) + perm32(R & 31)) : R); Rl[i] = R; Cl[i] = C;
        voffB[i] = (unsigned)(Rb * KB + 2 * C);
        vA[0][i] = (unsigned)(R * KB + 2 * C); vA[1][i] = (unsigned)((R + HALF) * KB + 2 * C); vAn[0][i] = vA[0][i]; vAn[1][i] = vA[1][i]; }
    const size_t kstep = (size_t)(BK * 2);
    const unsigned ldsw = (unsigned)wid * 1024u;
    const int aoff = lds_byte(wr * 64 + fr, fq * 8), boff = lds_byte(wc * 32 + fr, fq * 8);
#define PG8_SA(b, h) (((b) * 2 + (h)) * HTB)
#define PG8_SB(b, h) ((4 + (b) * 2 + (h)) * HTB)
#define PG8_STAGE(bufoff, gbase, voff) do { _Pragma("unroll") for (int _i = 0; _i < 2; ++_i) \
        __builtin_amdgcn_global_load_lds((const unsigned*)((const char*)(gbase) + (size_t)_i * q64 + (voff)[0]), (LAS unsigned*)(lds + (bufoff) + ldsw + _i * 8192), 16, 0, 0); } while (0)
#define PG8_STAGE_B(bufoff, gbase, voff) do { _Pragma("unroll") for (int _i = 0; _i < 2; ++_i) \
        __builtin_amdgcn_global_load_lds((const unsigned*)((const char*)(gbase) + (size_t)_i * qB + (voff)[0]), (LAS unsigned*)(lds + (bufoff) + ldsw + _i * 8192), 16, 0, 0); } while (0)
#define PG8_STAGE_G(bufoff, gbase, voff) do { _Pragma("unroll") for (int _i = 0; _i < 2; ++_i) \
        __builtin_amdgcn_global_load_lds((const unsigned*)((const char*)(gbase) + (voff)[_i]), (LAS unsigned*)(lds + (bufoff) + ldsw + _i * 8192), 16, 0, 0); } while (0)
#define PG8_STAGE_A(bufoff, gbase, vv, h) do { if constexpr (GATHER) PG8_STAGE_G(bufoff, gbase, (vv)[h]); else PG8_STAGE(bufoff, (gbase) + (size_t)(h) * hstep, (vv)[0]); } while (0)
#define PG8_CAT(x0, x1) __builtin_shufflevector((x0), (x1), 0, 1, 2, 3, 4, 5, 6, 7)
#define PG8_LDA(dst, b, h) do { _Pragma("unroll") for (int m = 0; m < 4; ++m) dst[m] = PG8_CAT(*(const LAS i32x4*)(lds + PG8_SA(b, h) + aoff + m * 2048), *(const LAS i32x4*)(lds + PG8_SA(b, h) + aoff + m * 2048 + 1024)); } while (0)
#define PG8_LDB(dst, b, h) do { _Pragma("unroll") for (int n = 0; n < 2; ++n) dst[n] = PG8_CAT(*(const LAS i32x4*)(lds + PG8_SB(b, h) + boff + n * 2048), *(const LAS i32x4*)(lds + PG8_SB(b, h) + boff + n * 2048 + 1024)); } while (0)
#define PG8_MMA(ai, bj, At, Bt) do { __builtin_amdgcn_s_setprio(1); _Pragma("unroll") for (int m = 0; m < 4; ++m) _Pragma("unroll") for (int n = 0; n < 2; ++n) \
        asm volatile("v_mfma_scale_f32_16x16x128_f8f6f4 %0, %1, %2, %0, %3, %3 op_sel_hi:[0,0,0]" : "+v"(acc[ai][bj][m][n]) : "v"(Bt[n]), "v"(At[m]), "v"(scv)); __builtin_amdgcn_s_setprio(0); } while (0)
#define PG8_WAIT_V(n) asm volatile("s_waitcnt vmcnt(" #n ")" ::: "memory")
#define PG8_WAIT_L(n) asm volatile("s_waitcnt lgkmcnt(" #n ")" ::: "memory")
#define PG8_BAR __builtin_amdgcn_s_barrier()
#define PG8_SCHED __builtin_amdgcn_sched_barrier(0)
#define PG8_GIDX(dst, ord) do { if constexpr (GATHER) { _Pragma("unroll") for (int _h = 0; _h < 2; ++_h) _Pragma("unroll") for (int _i = 0; _i < 2; ++_i) \
        dst[_h][_i] = (unsigned)g.gidx[(ord) * BM + _h * HALF + Rl[_i]] * (unsigned)KB + 2u * (unsigned)Cl[_i]; } } while (0)
    Unit cur, nxt; int ui = 0;
    if (!S.next(0, cur)) return;
    f32x4 acc[2][2][4][2];
#pragma unroll
    for (int a = 0; a < 2; ++a)
#pragma unroll
        for (int b = 0; b < 2; ++b)
#pragma unroll
            for (int m = 0; m < 4; ++m)
#pragma unroll
                for (int n = 0; n < 2; ++n) acc[a][b][m][n] = (f32x4){0.f, 0.f, 0.f, 0.f};
    i32x8 At[4], B0[2], B1[2];
    int scv = SC_W; asm volatile("" : "+v"(scv));
    PG8_GIDX(vA, 0);
    const char* cA = (const char*)g.A + (GATHER ? (size_t)0 : (size_t)cur.pm * tstep); const char* cB = (const char*)g.Bt + (size_t)cur.pn * tstep;
    PG8_STAGE_B(PG8_SB(0, 0), cB, voffB); PG8_STAGE_B(PG8_SB(0, 1), cB + bhstep, voffB); PG8_STAGE_A(PG8_SA(0, 0), cA, vA, 0); PG8_STAGE_A(PG8_SA(0, 1), cA, vA, 1);
    if (wr == 1) PG8_BAR;
    PG8_WAIT_V(2); PG8_BAR;
    PG8_STAGE_B(PG8_SB(1, 0), cB + kstep, voffB); PG8_STAGE_A(PG8_SA(1, 0), cA + kstep, vA, 0); PG8_STAGE_B(PG8_SB(1, 1), cB + bhstep + kstep, voffB);
    PG8_WAIT_V(6); PG8_BAR;
    for (;;) {
        const bool has_next = S.next(ui + 1, nxt);
        if (has_next) PG8_GIDX(vAn, ui + 1);
        const char* nA = has_next ? (const char*)g.A + (GATHER ? (size_t)0 : (size_t)nxt.pm * tstep) : cA; const char* nB = has_next ? (const char*)g.Bt + (size_t)nxt.pn * tstep : cB;
        constexpr int NSEG = Epi::HAS_MID ? 3 : 1; const int seglen = nt / NSEG;
        for (int seg = 0; seg < NSEG; ++seg) {
        if constexpr (Epi::HAS_MID) { if (seg > 0) { asm volatile("s_nop 15\n\ts_nop 15" ::: "memory"); E.mid(acc, cur, seg * Epi::MID0, wr, wc, fr, fq); asm volatile("s_nop 7" ::: "memory"); } }
        for (int t = seg * seglen; t < (seg + 1) * seglen; t += 2) {
            const bool last = (t == nt - 2);
            const char* a1 = cA + (size_t)(t + 1) * kstep;
            const char* a2 = last ? nA : cA + (size_t)(t + 2) * kstep; const char* b2 = last ? nB : cB + (size_t)(t + 2) * kstep;
            const char* a3 = a2 + kstep; const char* b3 = b2 + kstep;
            unsigned v2[2][2];
#pragma unroll
            for (int h = 0; h < 2; ++h)
#pragma unroll
                for (int i = 0; i < 2; ++i) v2[h][i] = (GATHER && last) ? vAn[h][i] : vA[h][i];
            PG8_LDB(B0, 0, 0); PG8_LDB(B1, 0, 1); PG8_SCHED; PG8_LDA(At, 0, 0); PG8_STAGE_A(PG8_SA(1, 1), a1, vA, 1);
            PG8_WAIT_V(8); PG8_WAIT_L(0); PG8_BAR; PG8_MMA(0, 0, At, B0); PG8_MMA(0, 1, At, B1); PG8_BAR; PG8_SCHED;
            PG8_LDA(At, 0, 1); PG8_STAGE_B(PG8_SB(0, 0), b2, voffB); PG8_STAGE_B(PG8_SB(0, 1), b2 + bhstep, voffB); PG8_STAGE_A(PG8_SA(0, 0), a2, v2, 0);
            PG8_WAIT_V(8); PG8_WAIT_L(0); PG8_BAR; PG8_MMA(1, 0, At, B0); PG8_MMA(1, 1, At, B1); PG8_BAR; PG8_SCHED;
            PG8_LDB(B0, 1, 0); PG8_LDB(B1, 1, 1); PG8_SCHED; PG8_LDA(At, 1, 0); PG8_STAGE_A(PG8_SA(0, 1), a2, v2, 1);
            PG8_WAIT_V(8); PG8_WAIT_L(0); PG8_BAR; PG8_MMA(0, 0, At, B0); PG8_MMA(0, 1, At, B1); PG8_BAR; PG8_SCHED;
            PG8_LDA(At, 1, 1); PG8_STAGE_B(PG8_SB(1, 0), b3, voffB); PG8_STAGE_B(PG8_SB(1, 1), b3 + bhstep, voffB); PG8_STAGE_A(PG8_SA(1, 0), a3, v2, 0);
            PG8_WAIT_V(8); PG8_WAIT_L(0); PG8_BAR; PG8_MMA(1, 0, At, B0); PG8_MMA(1, 1, At, B1); PG8_BAR; PG8_SCHED;
        }
        }
        if constexpr (ALIGN_EPI) { if (wr == 0) PG8_BAR; }
        asm volatile("s_nop 15\n\ts_nop 15" ::: "memory");
        {   int l2_ = lane; asm volatile("" : "+v"(l2_));
            E(acc, cur, wr, wc, l2_ & 15, l2_ >> 4); }
        if (!has_next) break;
#pragma unroll
        for (int a = 0; a < 2; ++a)
#pragma unroll
            for (int b = 0; b < 2; ++b)
#pragma unroll
                for (int m = 0; m < 4; ++m)
#pragma unroll
                    for (int n = 0; n < 2; ++n) acc[a][b][m][n] = (f32x4){0.f, 0.f, 0.f, 0.f};
        cur = nxt; cA = nA; cB = nB; ++ui;
#pragma unroll
        for (int h = 0; h < 2; ++h)
#pragma unroll
            for (int i = 0; i < 2; ++i) vA[h][i] = vAn[h][i];
        if constexpr (ALIGN_EPI) { if (wr == 1) PG8_BAR; }
    }
    PG8_WAIT_V(0);
    if constexpr (!ALIGN_EPI) { if (wr == 0) PG8_BAR; }
    PG8_BAR;
#undef PG8_SA
#undef PG8_SB
#undef PG8_STAGE
#undef PG8_STAGE_A
#undef PG8_STAGE_G
#undef PG8_LDA
#undef PG8_LDB
#undef PG8_MMA
#undef PG8_CAT
#undef PG8_WAIT_V
#undef PG8_WAIT_L
#undef PG8_BAR
#undef PG8_SCHED
#undef PG8_GIDX
}
}

constexpr int NWAVES = 8, NTHR = 512;
constexpr int BATCH = 4, SEQ = 4096, T = BATCH * SEQ, D = 2048, DEPTH = 2;
constexpr int IN_WIDTH = 15392, NPROJ = 9216, NGATE = 6144, NPROJ_ALL = NPROJ + NGATE;
constexpr int PQ_DAQ = 0, PQ_DAK = 1024, PQ_DAV = 2048, PQ_GQ = 3072, PQ_GK = 3584, PQ_GV = 4096, PQ_GR = 5120, PQ_SZ = 6144, PQ_SX = 7168, PQ_SB = 8192, PQ_SC = 8704, PQ_MG = 9216;
constexpr int NEXP = 64, TOPK = 8, EDIM = 512;
constexpr int MAXSLOT = T * TOPK + NEXP * 256;
constexpr int NSLOT_ALL = MAXSLOT + T;
constexpr int MAXBLK = NSLOT_ALL / 256;
constexpr float ALPHA = 1.4142135623730951f;
constexpr float EPS = 1e-5f;

constexpr size_t MiB = 1u << 20;
constexpr size_t WS_CTL = 0, CTL_ZERO_BYTES = 1 * MiB;
constexpr size_t WS_MISC = 1 * MiB;
constexpr size_t WS_WIN = 10 * MiB, WS_SM = 70 * MiB, WS_WBR = 71 * MiB, WS_WOUT = 83 * MiB, WS_RT = 91 * MiB, WS_EXP1 = 92 * MiB, WS_EXP2 = 352 * MiB;
constexpr size_t WS_XB = 482 * MiB, WS_XRES = 546 * MiB;
constexpr size_t WS_R1 = 674 * MiB, WS_PROJ = WS_R1, WS_G8 = WS_PROJ + (size_t)T * NPROJ * 2, WS_BRCAT = 1154 * MiB, WS_OS = WS_R1;
constexpr size_t WS_R2 = 1314 * MiB, WS_UPDT = WS_R2, WS_SPREVT = 1442 * MiB, WS_STATES = 1506 * MiB, WS_SPREV = 1570 * MiB, WS_HS = WS_R2;
constexpr size_t WS_MERGED = 1602 * MiB, WS_X1B = WS_MERGED, WS_H = 1666 * MiB, WS_SMALL = 1794 * MiB, WS_GDEC = 1796 * MiB, WS_ALAST = WS_GDEC + 512 * 1024, WS_END = 1797 * MiB;
static_assert(WS_WIN + (size_t)NPROJ_ALL * D * 2 <= WS_SM && WS_EXP1 + (size_t)65 * 1024 * 2048 * 2 <= WS_EXP2 && WS_EXP2 + (size_t)65 * 2048 * 512 * 2 <= WS_XB, "weights map");
static_assert(WS_G8 + (size_t)T * NGATE <= WS_BRCAT && WS_BRCAT + (size_t)T * 3072 * 2 <= WS_R2 && WS_OS + (size_t)NSLOT_ALL * D * 2 <= WS_R2, "R1 map");
static_assert(WS_HS + (size_t)NSLOT_ALL * EDIM * 2 <= WS_MERGED && WS_SPREV + (size_t)4 * 32 * 16 * 64 * 128 * 2 <= WS_MERGED, "R2 map");
constexpr size_t MS_SELMASK = 0, MS_SELW = 256 * 1024, MS_CNT = 1024 * 1024, MS_TOK2SLOT = 1280 * 1024, MS_SLOTTOK = 2 * MiB, MS_BLKE = 3 * MiB, MS_NBLK = 3 * MiB + 4096;
constexpr int CW_BAR = 4096, CW_ATTQ = 16384;

constexpr int RING_BYTES = 131072;
constexpr int LDSCTL_OFF = 155648, MISC_OFF = LDSCTL_OFF + 64;
constexpr int LDS_BYTES = 155648 + 256;

#define RLX_AGENT __ATOMIC_RELAXED, __HIP_MEMORY_SCOPE_AGENT
#define LDS_WAIT() asm volatile("s_waitcnt lgkmcnt(0)" ::: "memory")
#define VM_WAIT() asm volatile("s_waitcnt vmcnt(0)" ::: "memory")

#define XB_TMO      128
#define XB_XCNT(j)  (256  + 64 * (j))
#define XB_XSUB(j)  (1280 + 64 * (j))
#define XB_XGEN(j)  (2304 + 64 * (j))
#define XB_TOP      3328
#define XB_TOPGEN   3392
#define XCD_BAR_WORDS 3456
#define XB_SPIN_CAP (1u << 20)
__device__ __forceinline__ unsigned xb_ld(unsigned* p)              { return __hip_atomic_load(p, __ATOMIC_RELAXED, __HIP_MEMORY_SCOPE_AGENT); }
__device__ __forceinline__ unsigned xb_add(unsigned* p, unsigned v) { return __hip_atomic_fetch_add(p, v, __ATOMIC_RELAXED, __HIP_MEMORY_SCOPE_AGENT); }
__device__ __forceinline__ unsigned xb_xcc_id() { return (unsigned)__builtin_amdgcn_s_getreg((3 << 11) | 20) & 0xFu; }
#define XB_SPIN(cond, bar) do { unsigned _sp = 0; while (cond) { __builtin_amdgcn_s_sleep(1); \
    if ((++_sp & 255u) == 0u) { if (xb_ld(&(bar)[XB_TMO])) break; if (_sp > XB_SPIN_CAP) { atomicAdd(&(bar)[XB_TMO], 1u); break; } } } } while (0)
struct XcdBarrier { unsigned* bar; unsigned x; volatile LAS unsigned* st; };
__device__ __forceinline__ XcdBarrier xcd_barrier_post(unsigned* bar, volatile LAS unsigned* st, bool leader) {
    XcdBarrier b; b.bar = bar; b.x = xb_xcc_id(); b.st = st;
    if (leader) (void)xb_add(&bar[XB_XCNT(b.x)], 1u);
    return b;
}
__device__ __forceinline__ void xcd_barrier_complete(unsigned* bar, unsigned x, unsigned& nloc, unsigned& nx) {
    const unsigned G = gridDim.x * gridDim.y * gridDim.z;
    unsigned sum, cnt, mine, sp = 0u;
    for (;;) {
        sum = 0u; cnt = 0u; mine = 0u;
#pragma unroll
        for (unsigned j = 0; j < 16; ++j) { const unsigned c = xb_ld(&bar[XB_XCNT(j)]); sum += c; cnt += (c > 0u) ? 1u : 0u; mine = (j == x) ? c : mine; }
        if (sum == G) break;
        __builtin_amdgcn_s_sleep(1);
        if ((++sp & 255u) == 0u) { if (xb_ld(&bar[XB_TMO])) break; if (sp > XB_SPIN_CAP) { atomicAdd(&bar[XB_TMO], 1u); break; } }
    }
    nloc = mine > 0u ? mine : 1u; nx = cnt > 0u ? cnt : 1u;
}
__device__ __forceinline__ void xcd_barrier(const XcdBarrier& b, bool leader) {
    asm volatile("s_waitcnt vmcnt(0)" ::: "memory");
    __syncthreads();
    if (leader) {
        unsigned* bar = b.bar;
        __builtin_amdgcn_s_waitcnt(0);
        unsigned nloc = b.st[0], nx = b.st[1];
        if (nloc == 0u) { xcd_barrier_complete(bar, b.x, nloc, nx); b.st[0] = nloc; b.st[1] = nx; }
        const unsigned old = xb_add(&bar[XB_XSUB(b.x)], 1u);
        const unsigned gen = old / nloc;
        if (old + 1u == (gen + 1u) * nloc) {
            __builtin_amdgcn_fence(__ATOMIC_RELEASE, "agent");
            asm volatile("s_waitcnt vmcnt(0)" ::: "memory");
            const unsigned og = xb_add(&bar[XB_TOP], 1u);
            const unsigned tg = og / nx;
            if (og + 1u == (tg + 1u) * nx) xb_add(&bar[XB_TOPGEN], 1u);
            else XB_SPIN(xb_ld(&bar[XB_TOPGEN]) == tg, bar);
            __builtin_amdgcn_fence(__ATOMIC_ACQUIRE, "agent");
            xb_add(&bar[XB_XGEN(b.x)], 1u);
            asm volatile("s_waitcnt vmcnt(0)" ::: "memory");
        } else {
            XB_SPIN(xb_ld(&bar[XB_XGEN(b.x)]) == gen, bar);
            __builtin_amdgcn_fence(__ATOMIC_ACQUIRE, "agent");
            asm volatile("s_waitcnt vmcnt(0)" ::: "memory");
        }
    }
    __syncthreads();
}

struct Args { const float* in[27]; float* out; unsigned char* ws; int ph_lo, ph_hi; int sub, pad; };
__device__ __forceinline__ int lane_id() { int r; asm volatile("v_mbcnt_lo_u32_b32 %0, -1, 0\n\tv_mbcnt_hi_u32_b32 %0, -1, %0" : "=v"(r)); return r; }
__device__ __forceinline__ Args load_args(const Args& a) {
#if defined(__HIP_DEVICE_COMPILE__)
    typedef const __attribute__((address_space(4))) unsigned long long* kptr;
    kptr p = (kptr)__builtin_amdgcn_kernarg_segment_ptr(); asm volatile("" : "+s"(p));
    Args r;
#pragma unroll
    for (int i = 0; i < 27; ++i) r.in[i] = (const float*)(const GAS float*)p[i];
    r.out = (float*)(GAS float*)p[27]; r.ws = (unsigned char*)(GAS unsigned char*)p[28]; const unsigned long long q = p[29], q2 = p[30]; r.ph_lo = (int)(unsigned)q; r.ph_hi = (int)(unsigned)(q >> 32); r.sub = (int)(unsigned)q2; r.pad = (int)(unsigned)(q2 >> 32);
    return r;
#else
    return a;
#endif
}
struct Frame {
    LAS unsigned char* lds;
    unsigned char* ws;
    int tid, lane, wave, G, bid;
};

template <int K> __device__ __forceinline__ float swz_xor(float v) { return __builtin_bit_cast(float, __builtin_amdgcn_ds_swizzle(__builtin_bit_cast(int, v), 0x1f | (K << 10))); }
__device__ __forceinline__ float x32_sum(float v) { auto r = __builtin_amdgcn_permlane32_swap(__float_as_uint(v), __float_as_uint(v), false, false); return __uint_as_float(r[0]) + __uint_as_float(r[1]); }
__device__ __forceinline__ float x32_max(float v) { auto r = __builtin_amdgcn_permlane32_swap(__float_as_uint(v), __float_as_uint(v), false, false); return fmaxf(__uint_as_float(r[0]), __uint_as_float(r[1])); }
__device__ __forceinline__ float wave_sum(float v) { v += swz_xor<1>(v); v += swz_xor<2>(v); v += swz_xor<4>(v); v += swz_xor<8>(v); v += swz_xor<16>(v); return x32_sum(v); }
__device__ __forceinline__ float wave_max(float v) { v = fmaxf(v, swz_xor<1>(v)); v = fmaxf(v, swz_xor<2>(v)); v = fmaxf(v, swz_xor<4>(v)); v = fmaxf(v, swz_xor<8>(v)); v = fmaxf(v, swz_xor<16>(v)); return x32_max(v); }
__device__ __forceinline__ float wave_scan_f(float v, int ln) {
#pragma unroll
    for (int o = 1; o < 64; o <<= 1) { const float t = __builtin_bit_cast(float, __builtin_amdgcn_ds_bpermute((ln - o) << 2, __builtin_bit_cast(int, v))); if (ln >= o) v += t; }
    return v;
}
__device__ __forceinline__ int wave_scan_i(int v, int ln) {
#pragma unroll
    for (int o = 1; o < 64; o <<= 1) { const int t = __builtin_amdgcn_ds_bpermute((ln - o) << 2, v); if (ln >= o) v += t; }
    return v;
}

constexpr int CV_NITEMS = 32 * 80 + 32 * 64 + 32 * 96 + 32 + 3 * 16 * 32 + 32 * 32 + 32 * 2 + 65 * (2 * 32 * 8 + 8 * 32);
__device__ __forceinline__ void cv_item(const float* W, int ldn, int k0, int ns0, bf16_t* dst, int ld_dst, int drow0, int dk0, LAS float* scr, int lane) {
#pragma unroll 8
    for (int i = 0; i < 32; ++i) { const int kk = 2 * i + (lane >> 5); scr[kk * 33 + (lane & 31)] = W[(size_t)(k0 + kk) * ldn + ns0 + (lane & 31)]; }
    LDS_WAIT(); asm volatile("" ::: "memory");
    const int c = lane & 7;
#pragma unroll
    for (int j = 0; j < 4; ++j) { const int n = (lane >> 3) + 8 * j; const LAS float* s = scr + (8 * c) * 33 + n;
        u32x4 o; o.x = cvt_pk_bf16(s[0 * 33], s[1 * 33]); o.y = cvt_pk_bf16(s[2 * 33], s[3 * 33]); o.z = cvt_pk_bf16(s[4 * 33], s[5 * 33]); o.w = cvt_pk_bf16(s[6 * 33], s[7 * 33]);
        *(GAS u32x4*)(dst + (size_t)(drow0 + n) * ld_dst + dk0 + k0 + 8 * c) = o; }
    LDS_WAIT(); asm volatile("" ::: "memory");
}
__device__ __forceinline__ void cv_item64(const float* W, int ldn, int k0, int ns0, fp8_t* dst, int ld_dst, int drow0, int dk0, LAS float* scr, int lane) {
    const float* wp = W + (size_t)(k0 + (lane >> 4)) * ldn + ns0 + 4 * (lane & 15);
    f32x4 v[16];
#pragma unroll
    for (int i = 0; i < 16; ++i) v[i] = *(const GAS f32x4*)(wp + (size_t)(4 * i) * ldn);
#pragma unroll
    for (int i = 0; i < 16; ++i) { LAS float* sp = scr + (4 * i + (lane >> 4)) * 65 + 4 * (lane & 15); sp[0] = v[i].x * WSCALE; sp[1] = v[i].y * WSCALE; sp[2] = v[i].z * WSCALE; sp[3] = v[i].w * WSCALE; }
    LDS_WAIT(); asm volatile("" ::: "memory");
    const int c = lane & 3;
#pragma unroll
    for (int j = 0; j < 4; ++j) { const int n = (lane >> 2) + 16 * j; const LAS float* s = scr + (16 * c) * 65 + n;
        u32x4 o; o.x = pk4_fp8(s[0 * 65], s[1 * 65], s[2 * 65], s[3 * 65]); o.y = pk4_fp8(s[4 * 65], s[5 * 65], s[6 * 65], s[7 * 65]);
        o.z = pk4_fp8(s[8 * 65], s[9 * 65], s[10 * 65], s[11 * 65]); o.w = pk4_fp8(s[12 * 65], s[13 * 65], s[14 * 65], s[15 * 65]);
        *(GAS u32x4*)(dst + (size_t)(drow0 + n) * ld_dst + dk0 + k0 + 16 * c) = o; }
    LDS_WAIT(); asm volatile("" ::: "memory");
}
__device__ __forceinline__ void cv_item_small(const float* W, int k0, bf16_t* dst, LAS float* scr, int lane) {
    const int c32 = lane & 31, sc = c32 < 16 ? 5120 + c32 : 9232 + (c32 - 16);
#pragma unroll 8
    for (int i = 0; i < 32; ++i) { const int kk = 2 * i + (lane >> 5); scr[kk * 33 + c32] = W[(size_t)(k0 + kk) * IN_WIDTH + sc]; }
    LDS_WAIT(); asm volatile("" ::: "memory");
    const int c = lane & 7;
#pragma unroll
    for (int j = 0; j < 4; ++j) { const int n = (lane >> 3) + 8 * j; const LAS float* s = scr + (8 * c) * 33 + n;
        u32x4 o; o.x = cvt_pk_bf16(s[0 * 33], s[1 * 33]); o.y = cvt_pk_bf16(s[2 * 33], s[3 * 33]); o.z = cvt_pk_bf16(s[4 * 33], s[5 * 33]); o.w = cvt_pk_bf16(s[6 * 33], s[7 * 33]);
        *(GAS u32x4*)(dst + (size_t)n * D + k0 + 8 * c) = o; }
    LDS_WAIT(); asm volatile("" ::: "memory");
}
__device__ __forceinline__ void cv_item_router(const float* W, int k0, int ns0, bf16_t* dhi, bf16_t* dlo, LAS float* scr, int lane) {
#pragma unroll 8
    for (int i = 0; i < 32; ++i) { const int kk = 2 * i + (lane >> 5); scr[kk * 33 + (lane & 31)] = W[(size_t)(k0 + kk) * NEXP + ns0 + (lane & 31)]; }
    LDS_WAIT(); asm volatile("" ::: "memory");
    const int c = lane & 7;
#pragma unroll
    for (int j = 0; j < 4; ++j) { const int n = (lane >> 3) + 8 * j; const LAS float* s = scr + (8 * c) * 33 + n;
        float v[8], r[8]; unsigned short hb[8];
#pragma unroll
        for (int q = 0; q < 8; ++q) { v[q] = s[q * 33]; hb[q] = f2bf(v[q]); r[q] = v[q] - bf2f(hb[q]); }
        u32x4 o; o.x = hb[0] | ((unsigned)hb[1] << 16); o.y = hb[2] | ((unsigned)hb[3] << 16); o.z = hb[4] | ((unsigned)hb[5] << 16); o.w = hb[6] | ((unsigned)hb[7] << 16);
        u32x4 l; l.x = cvt_pk_bf16(r[0], r[1]); l.y = cvt_pk_bf16(r[2], r[3]); l.z = cvt_pk_bf16(r[4], r[5]); l.w = cvt_pk_bf16(r[6], r[7]);
        *(GAS u32x4*)(dhi + (size_t)(ns0 + n) * D + k0 + 8 * c) = o;
        *(GAS u32x4*)(dlo + (size_t)(ns0 + n) * D + k0 + 8 * c) = l; }
    LDS_WAIT(); asm volatile("" ::: "memory");
}

struct CvDesc { const float* W; fp8_t* dst; int ldn, ld_dst; };
__device__ __forceinline__ void cv_load64(const CvDesc& d, int lane, f32x4 (&v)[16]) {
    const unsigned voff = (unsigned)(((lane >> 4) * d.ldn + 4 * (lane & 15)) * 4);
#pragma unroll
    for (int i = 0; i < 16; ++i) { const GAS float* rp = (const GAS float*)(d.W + (size_t)(4 * i) * d.ldn);
        asm volatile("s_nop 4\n\tglobal_load_dwordx4 %0, %1, %2" : "=&v"(v[i]) : "v"(voff), "s"(rp) : "memory"); }
}
template <int N> __device__ __forceinline__ void cv_wait(f32x4 (&v)[16]) {
    asm volatile("s_waitcnt vmcnt(%16)" : "+v"(v[0]), "+v"(v[1]), "+v"(v[2]), "+v"(v[3]), "+v"(v[4]), "+v"(v[5]), "+v"(v[6]), "+v"(v[7]), "+v"(v[8]), "+v"(v[9]), "+v"(v[10]), "+v"(v[11]), "+v"(v[12]), "+v"(v[13]), "+v"(v[14]), "+v"(v[15]) : "n"(N) : "memory");
}
__device__ __forceinline__ void cv_proc64(const CvDesc& d, f32x4 (&v)[16], LAS float* scr, int lane) {
#pragma unroll
    for (int i = 0; i < 16; ++i) { LAS float* sp = scr + (4 * i + (lane >> 4)) * 65 + 4 * (lane & 15); sp[0] = v[i].x * WSCALE; sp[1] = v[i].y * WSCALE; sp[2] = v[i].z * WSCALE; sp[3] = v[i].w * WSCALE; }
    LDS_WAIT(); asm volatile("" ::: "memory");
    const int c = lane & 3;
#pragma unroll
    for (int j = 0; j < 4; ++j) { const int n = (lane >> 2) + 16 * j; const LAS float* s = scr + (16 * c) * 65 + n;
        u32x4 o; o.x = pk4_fp8(s[0 * 65], s[1 * 65], s[2 * 65], s[3 * 65]); o.y = pk4_fp8(s[4 * 65], s[5 * 65], s[6 * 65], s[7 * 65]);
        o.z = pk4_fp8(s[8 * 65], s[9 * 65], s[10 * 65], s[11 * 65]); o.w = pk4_fp8(s[12 * 65], s[13 * 65], s[14 * 65], s[15 * 65]);
        *(GAS u32x4*)(d.dst + (size_t)n * d.ld_dst + 16 * c) = o; }
    LDS_WAIT(); asm volatile("" ::: "memory");
}
__device__ __forceinline__ void cv_load_k128(const CvDesc& d, int lane, f32x4 (&v)[16]) {
    const unsigned voff = (unsigned)(((lane >> 3) * d.ldn + 4 * (lane & 7)) * 4);
#pragma unroll
    for (int i = 0; i < 16; ++i) { const GAS float* rp = (const GAS float*)(d.W + (size_t)(8 * i) * d.ldn);
        asm volatile("s_nop 4\n\tglobal_load_dwordx4 %0, %1, %2" : "=&v"(v[i]) : "v"(voff), "s"(rp) : "memory"); }
}
__device__ __forceinline__ void cv_proc_k128(const CvDesc& d, f32x4 (&v)[16], LAS float* scr, int lane) {
#pragma unroll
    for (int i = 0; i < 16; ++i) { LAS float* sp = scr + (8 * i + (lane >> 3)) * 33 + 4 * (lane & 7); sp[0] = v[i].x * WSCALE; sp[1] = v[i].y * WSCALE; sp[2] = v[i].z * WSCALE; sp[3] = v[i].w * WSCALE; }
    LDS_WAIT(); asm volatile("" ::: "memory");
    const int c = lane & 7;
#pragma unroll
    for (int j = 0; j < 4; ++j) { const int n = (lane >> 3) + 8 * j; const LAS float* s = scr + (16 * c) * 33 + n;
        u32x4 o; o.x = pk4_fp8(s[0 * 33], s[1 * 33], s[2 * 33], s[3 * 33]); o.y = pk4_fp8(s[4 * 33], s[5 * 33], s[6 * 33], s[7 * 33]);
        o.z = pk4_fp8(s[8 * 33], s[9 * 33], s[10 * 33], s[11 * 33]); o.w = pk4_fp8(s[12 * 33], s[13 * 33], s[14 * 33], s[15 * 33]);
        *(GAS u32x4*)(d.dst + (size_t)n * d.ld_dst + 16 * c) = o; }
    LDS_WAIT(); asm volatile("" ::: "memory");
}
__device__ __forceinline__ void cv_item_k128(const float* W, int ldn, int k0, int n0, fp8_t* dst, int ld_dst, int drow0, int dk0, LAS float* scr, int lane) {
    const float* wp = W + (size_t)(k0 + (lane >> 3)) * ldn + n0 + 4 * (lane & 7);
    f32x4 v[16];
#pragma unroll
    for (int i = 0; i < 16; ++i) v[i] = *(const GAS f32x4*)(wp + (size_t)(8 * i) * ldn);
    CvDesc d; d.W = W; d.ldn = ldn; d.dst = dst + (size_t)drow0 * ld_dst + dk0 + k0; d.ld_dst = ld_dst;
    cv_proc_k128(d, v, scr, lane);
}
__device__ __forceinline__ void phase_convert_experts(Frame& F, const Args& a, int l, int r0, int r1, int gw, int NGW) {
    LAS float* scr = (LAS float*)(F.lds + F.wave * 16896);
    fp8_t* EXP1 = (fp8_t*)(F.ws + WS_EXP1); fp8_t* EXP2 = (fp8_t*)(F.ws + WS_EXP2);
    const float* e_g = a.in[19] + (size_t)l * NEXP * D * EDIM; const float* e_u = a.in[20] + (size_t)l * NEXP * D * EDIM; const float* e_d = a.in[21] + (size_t)l * NEXP * EDIM * D;
    const float* s_g = a.in[22] + (size_t)l * D * EDIM; const float* s_u = a.in[23] + (size_t)l * D * EDIM; const float* s_d = a.in[24] + (size_t)l * EDIM * D;
    auto desc = [&](int r) -> CvDesc {
        const int e = r / 768, q0 = r % 768, kind = q0 >> 8, q = q0 & 255;
        const float* W = (kind == 0 ? (e < 64 ? e_g + (size_t)e * D * EDIM : s_g) : kind == 1 ? (e < 64 ? e_u + (size_t)e * D * EDIM : s_u) : (e < 64 ? e_d + (size_t)e * D * EDIM : s_d));
        const int ldn = kind == 2 ? D : EDIM, nb = kind == 2 ? 64 : 16, k0 = 128 * (q / nb), n0 = 32 * (q % nb);
        fp8_t* dst = kind == 2 ? EXP2 + (size_t)e * D * EDIM : EXP1 + (size_t)e * 1024 * D;
        const int ld_dst = kind == 2 ? EDIM : D, drow0 = kind == 2 ? n0 : (n0 / 128) * 256 + (kind == 1 ? 128 : 0) + (n0 % 128);
        CvDesc d; d.W = W + (size_t)k0 * ldn + n0; d.ldn = ldn; d.dst = dst + (size_t)drow0 * ld_dst + k0; d.ld_dst = ld_dst; return d; };
    int r = r0 + gw;
    if (r < r1) {
        f32x4 va[16], vb[16]; CvDesc da = desc(r), db = da; cv_load_k128(da, F.lane, va);
        {   const int rn = r + NGW; db = desc(rn < r1 ? rn : r); cv_load_k128(db, F.lane, vb); cv_wait<16>(va); cv_proc_k128(da, va, scr, F.lane); r = rn; }
        while (r < r1) {
            {   const int rn = r + NGW; da = desc(rn < r1 ? rn : r); cv_load_k128(da, F.lane, va); cv_wait<20>(vb); cv_proc_k128(db, vb, scr, F.lane); r = rn; }
            if (r >= r1) break;
            {   const int rn = r + NGW; db = desc(rn < r1 ? rn : r); cv_load_k128(db, F.lane, vb); cv_wait<20>(va); cv_proc_k128(da, va, scr, F.lane); r = rn; }
        }
        asm volatile("s_waitcnt vmcnt(0)" ::: "memory");
    }
}
__device__ __forceinline__ void phase_convert(Frame& F, const Args& a, int l, int it0, int it1, int gw, int NGW, bool do_x) {
    LAS float* scr = (LAS float*)(F.lds + F.wave * 16896);
    const float* w_in = a.in[1] + (size_t)l * D * IN_WIDTH;
    const float* w_br = a.in[13] + (size_t)l * 3 * 1024 * D;
    const float* w_out = a.in[14] + (size_t)l * D * D;
    const float* w_rt = a.in[17] + (size_t)l * D * NEXP;
    const float* e_g = a.in[19] + (size_t)l * NEXP * D * EDIM;
    const float* e_u = a.in[20] + (size_t)l * NEXP * D * EDIM;
    const float* e_d = a.in[21] + (size_t)l * NEXP * EDIM * D;
    const float* s_g = a.in[22] + (size_t)l * D * EDIM;
    const float* s_u = a.in[23] + (size_t)l * D * EDIM;
    const float* s_d = a.in[24] + (size_t)l * EDIM * D;
    fp8_t* WIN = (fp8_t*)(F.ws + WS_WIN); bf16_t* SM = (bf16_t*)(F.ws + WS_SM); fp8_t* WBR = (fp8_t*)(F.ws + WS_WBR); fp8_t* WOUT = (fp8_t*)(F.ws + WS_WOUT);
    bf16_t* RTH = (bf16_t*)(F.ws + WS_RT); bf16_t* RTL = RTH + 64 * D; fp8_t* EXP1 = (fp8_t*)(F.ws + WS_EXP1); fp8_t* EXP2 = (fp8_t*)(F.ws + WS_EXP2);
    constexpr int I_A = 32 * 80, I_B = 32 * 64, I_C = 32 * 96, I_SM = 32, I_BR = 16 * 32, I_WO = 32 * 32, I_RT = 32 * 2, I_EG = 32 * 8, I_ED = 8 * 32;
    for (int it = it0 + gw; it < it1; it += NGW) {
        int r = it;
        if (r < I_A) { cv_item_k128(w_in, IN_WIDTH, 128 * (r / 160), 0 + 32 * (r % 160), WIN, D, 0 + 32 * (r % 160), 0, scr, F.lane); continue; } r -= I_A;
        if (r < I_B) { cv_item_k128(w_in, IN_WIDTH, 128 * (r / 128), 5136 + 32 * (r % 128), WIN, D, 5120 + 32 * (r % 128), 0, scr, F.lane); continue; } r -= I_B;
        if (r < I_C) { cv_item_k128(w_in, IN_WIDTH, 128 * (r / 192), 9248 + 32 * (r % 192), WIN, D, 9216 + 32 * (r % 192), 0, scr, F.lane); continue; } r -= I_C;
        if (r < I_SM) { cv_item_small(w_in, 64 * r, SM, scr, F.lane); continue; } r -= I_SM;
        if (r < 3 * I_BR) { const int br = r / I_BR, q = r % I_BR; cv_item_k128(w_br + (size_t)br * 1024 * D, D, 128 * (q / 64), 32 * (q % 64), WBR, 3072, 32 * (q % 64), 1024 * br, scr, F.lane); continue; } r -= 3 * I_BR;
        if (r < I_WO) { cv_item_k128(w_out, D, 128 * (r / 64), 32 * (r % 64), WOUT, D, 32 * (r % 64), 0, scr, F.lane); continue; } r -= I_WO;
        if (r < I_RT) { cv_item_router(w_rt, 64 * (r / 2), 32 * (r % 2), RTH, RTL, scr, F.lane); continue; } r -= I_RT;
        {
            constexpr int PER = 2 * I_EG + I_ED; const int e = r / PER; int q = r % PER;
            const float* wg = e < 64 ? e_g + (size_t)e * D * EDIM : s_g; const float* wu = e < 64 ? e_u + (size_t)e * D * EDIM : s_u; const float* wd = e < 64 ? e_d + (size_t)e * EDIM * D : s_d;
            fp8_t* d1 = EXP1 + (size_t)e * 1024 * D; fp8_t* d2 = EXP2 + (size_t)e * D * EDIM;
            if (q < I_EG) { const int n0 = 64 * (q % 8); cv_item64(wg, EDIM, 64 * (q / 8), n0, d1, D, (n0 / 128) * 256 + (n0 % 128), 0, scr, F.lane); continue; } q -= I_EG;
            if (q < I_EG) { const int n0 = 64 * (q % 8); cv_item64(wu, EDIM, 64 * (q / 8), n0, d1, D, (n0 / 128) * 256 + 128 + (n0 % 128), 0, scr, F.lane); continue; } q -= I_EG;
            cv_item64(wd, D, 64 * (q / 32), 64 * (q % 32), d2, EDIM, 64 * (q % 32), 0, scr, F.lane);
        }
    }
    if (do_x) {
        const float* x = a.in[0]; fp8_t* XB = (fp8_t*)(F.ws + WS_XB); bf16_t* XR = (bf16_t*)(F.ws + WS_XRES);
        for (int m = gw; m < T; m += NGW) { const GAS f32x4* xr = (const GAS f32x4*)(x + (size_t)m * D) + 2 * F.lane; GAS u32x2* o = (GAS u32x2*)(XB + (size_t)m * D) + F.lane; GAS u32x4* ob = (GAS u32x4*)(XR + (size_t)m * D) + F.lane;
            f32x4 v0[4], v1[4];
#pragma unroll
            for (int j = 0; j < 4; ++j) { v0[j] = xr[128 * j]; v1[j] = xr[128 * j + 1]; }
#pragma unroll
            for (int j = 0; j < 4; ++j) { u32x2 q8; q8.x = pk4_fp8(v0[j].x, v0[j].y, v0[j].z, v0[j].w); q8.y = pk4_fp8(v1[j].x, v1[j].y, v1[j].z, v1[j].w); o[64 * j] = q8;
                u32x4 wb; wb.x = cvt_pk_bf16(v0[j].x, v0[j].y); wb.y = cvt_pk_bf16(v0[j].z, v0[j].w); wb.z = cvt_pk_bf16(v1[j].x, v1[j].y); wb.w = cvt_pk_bf16(v1[j].z, v1[j].w); ob[64 * j] = wb; } }
    }
}

namespace pg8 {
struct EpiBf16 {
    static constexpr bool PERM = true, PERM64 = true, HAS_MID = false; static constexpr int MID0 = -1, MID1 = -1;
    bf16_t* O; int ldc; int nmod;
    __device__ __forceinline__ void mid(f32x4 (&)[2][2][4][2], const Unit&, int, int, int, int, int) const {}
    __device__ __forceinline__ void operator()(const f32x4 (&acc)[2][2][4][2], const Unit& u, int wr, int wc, int fr, int fq) const {
        const int pl = nmod ? (u.pn % nmod) : u.pn;
        const int odd = fr & 1;
        const int rowA = u.pm * BM + wr * 64 + fr - odd, rowB = rowA + 1, col = pl * BM + wc * 64 + 8 * fq + 32 * odd;
#pragma unroll
        for (int ai = 0; ai < 2; ++ai)
#pragma unroll
            for (int m = 0; m < 4; ++m) { u32x4 w0, w1;
                { const f32x4 v0 = acc[ai][0][m][0], v1 = acc[ai][0][m][1]; w0.x = cvt_pk_bf16(v0[0], v0[1]); w0.y = cvt_pk_bf16(v0[2], v0[3]); w0.z = cvt_pk_bf16(v1[0], v1[1]); w0.w = cvt_pk_bf16(v1[2], v1[3]); }
                { const f32x4 v0 = acc[ai][1][m][0], v1 = acc[ai][1][m][1]; w1.x = cvt_pk_bf16(v0[0], v0[1]); w1.y = cvt_pk_bf16(v0[2], v0[3]); w1.z = cvt_pk_bf16(v1[0], v1[1]); w1.w = cvt_pk_bf16(v1[2], v1[3]); }
                u32x4 keep, recv;
#pragma unroll
                for (int q = 0; q < 4; ++q) { const unsigned give = odd ? w0[q] : w1[q]; keep[q] = odd ? w1[q] : w0[q]; recv[q] = (unsigned)__builtin_amdgcn_mov_dpp((int)give, 0xB1, 0xF, 0xF, true); }
                u32x4 vA, vB;
#pragma unroll
                for (int q = 0; q < 4; ++q) { vA[q] = odd ? recv[q] : keep[q]; vB[q] = odd ? keep[q] : recv[q]; }
                bf16_t* base = O + (size_t)(ai * HALF + m * 16) * ldc + col;
                *(u32x4*)(base + (size_t)rowA * ldc) = vA; *(u32x4*)(base + (size_t)rowB * ldc) = vB; }
    }
};
struct EpiGate {
    static constexpr bool PERM = true, PERM16 = true, HAS_MID = false; static constexpr int MID0 = -1, MID1 = -1;
    unsigned char* G;
    __device__ __forceinline__ void mid(f32x4 (&)[2][2][4][2], const Unit&, int, int, int, int, int) const {}
    __device__ __forceinline__ void operator()(const f32x4 (&acc)[2][2][4][2], const Unit& u, int wr, int wc, int fr, int fq) const {
        const int row0 = u.pm * BM + wr * 64 + fr, col0 = u.pn * BM + wc * 64 + 16 * fq;
#pragma unroll
        for (int ai = 0; ai < 2; ++ai)
#pragma unroll
            for (int m = 0; m < 4; ++m) { unsigned char* rowp = G + (size_t)(row0 + ai * HALF + m * 16) * NGATE + col0; u32x4 w;
#pragma unroll
                for (int bj = 0; bj < 2; ++bj)
#pragma unroll
                    for (int n = 0; n < 2; ++n) { unsigned pk = 0;
#pragma unroll
                        for (int q = 0; q < 4; ++q) pk = __builtin_amdgcn_cvt_pk_u8_f32(fmaxf(__builtin_rintf(255.0f * sigmoidf_(acc[ai][bj][m][n][q])), 1.0f), q, pk);
                        w[2 * bj + n] = pk; }
                *(u32x4*)rowp = w; }
    }
};

struct EpiFp8 {
    static constexpr bool PERM = true, PERM16 = true, HAS_MID = false; static constexpr int MID0 = -1, MID1 = -1;
    fp8_t* O; int ldc; int nmod;
    __device__ __forceinline__ void mid(f32x4 (&)[2][2][4][2], const Unit&, int, int, int, int, int) const {}
    __device__ __forceinline__ void operator()(const f32x4 (&acc)[2][2][4][2], const Unit& u, int wr, int wc, int fr, int fq) const {
        const int pl = nmod ? (u.pn % nmod) : u.pn;
        const int row0 = u.pm * BM + wr * 64 + fr, col0 = pl * BM + wc * 64 + 16 * fq;
#pragma unroll
        for (int ai = 0; ai < 2; ++ai)
#pragma unroll
            for (int m = 0; m < 4; ++m) { fp8_t* rowp = O + (size_t)(row0 + ai * HALF + m * 16) * ldc + col0; u32x4 w;
#pragma unroll
                for (int bj = 0; bj < 2; ++bj)
#pragma unroll
                    for (int n = 0; n < 2; ++n) { const f32x4 v = acc[ai][bj][m][n] * OSCALE; w[2 * bj + n] = pk4_fp8(v[0], v[1], v[2], v[3]); }
                *(u32x4*)rowp = w; }
    }
};
struct EpiSwiglu {
    static constexpr bool PERM = true, HAS_MID = false; static constexpr int MID0 = -1, MID1 = -1;
    fp8_t* O; int ldc;
    __device__ __forceinline__ void mid(f32x4 (&)[2][2][4][2], const Unit&, int, int, int, int, int) const {}
    __device__ __forceinline__ void operator()(const f32x4 (&acc)[2][2][4][2], const Unit& u, int wr, int wc, int fr, int fq) const {
        const int pl = u.pn & 3;
        const int row0 = u.pm * BM + wr * 64 + fr, col0 = pl * HALF + wc * 32 + 8 * fq;
#pragma unroll
        for (int ai = 0; ai < 2; ++ai)
#pragma unroll
            for (int m = 0; m < 4; ++m) { fp8_t* rowp = O + (size_t)(row0 + ai * HALF + m * 16) * ldc + col0;
                float h[8];
#pragma unroll
                for (int n = 0; n < 2; ++n)
#pragma unroll
                    for (int j = 0; j < 4; ++j) { const float gt = acc[ai][0][m][n][j], up = acc[ai][1][m][n][j]; h[4 * n + j] = siluf_(gt) * up; }
                u32x2 w; w.x = pk4_fp8(h[0], h[1], h[2], h[3]); w.y = pk4_fp8(h[4], h[5], h[6], h[7]);
                *(u32x2*)(rowp) = w; }
    }
};
struct EpiMerge {
    static constexpr bool PERM = true, PERM16 = true, HAS_MID = true; static constexpr int MID0 = 8, MID1 = 16;
    const unsigned char* P; fp8_t* O;
    __device__ __forceinline__ void mid(f32x4 (&acc)[2][2][4][2], const Unit& u, int t, int wr, int wc, int fr, int fq) const {
        const int i = t >> 3;
        unsigned o0 = (unsigned)(u.pm * BM + wr * 64 + fr) * (unsigned)NGATE + (unsigned)((i - 1) * 2048 + u.pn * BM + wc * 64 + 16 * fq);
        asm volatile("" : "+v"(o0));
        const char* Pb = (const char*)P;
#pragma unroll
        for (int ai = 0; ai < 2; ++ai)
#pragma unroll
            for (int m = 0; m < 4; ++m) { const unsigned orow = o0 + (unsigned)((ai * HALF + m * 16) * NGATE);
                const u32x4 ga = *(const u32x4*)(Pb + orow), gb = *(const u32x4*)(Pb + orow + 2048);
#pragma unroll
                for (int bj = 0; bj < 2; ++bj)
#pragma unroll
                    for (int n = 0; n < 2; ++n)
#pragma unroll
                        for (int q = 0; q < 4; ++q) acc[ai][bj][m][n][q] *= (float)((ga[2 * bj + n] >> (8 * q)) & 255u) * __builtin_amdgcn_rcpf((float)((gb[2 * bj + n] >> (8 * q)) & 255u));
                asm volatile("" : "+v"(acc[ai][0][m][0]), "+v"(acc[ai][0][m][1]), "+v"(acc[ai][1][m][0]), "+v"(acc[ai][1][m][1]) :: "memory"); }
    }
    __device__ __forceinline__ void operator()(const f32x4 (&acc)[2][2][4][2], const Unit& u, int wr, int wc, int fr, int fq) const {
        unsigned o0 = (unsigned)(u.pm * BM + wr * 64 + fr) * (unsigned)NGATE + (unsigned)(2 * 2048 + u.pn * BM + wc * 64 + 16 * fq);
        unsigned q0 = (unsigned)(u.pm * BM + wr * 64 + fr) * (unsigned)D + (unsigned)(u.pn * BM + wc * 64 + 16 * fq);
        asm volatile("" : "+v"(o0), "+v"(q0));
        const char* Pb = (const char*)P; char* Ob = (char*)O;
#pragma unroll
        for (int ai = 0; ai < 2; ++ai)
#pragma unroll
            for (int m = 0; m < 4; ++m) { const unsigned orow = o0 + (unsigned)((ai * HALF + m * 16) * NGATE), qrow = q0 + (unsigned)((ai * HALF + m * 16) * D);
                const u32x4 gg = *(const u32x4*)(Pb + orow); u32x4 w;
#pragma unroll
                for (int bj = 0; bj < 2; ++bj)
#pragma unroll
                    for (int n = 0; n < 2; ++n) { float v[4];
#pragma unroll
                        for (int q = 0; q < 4; ++q) v[q] = acc[ai][bj][m][n][q] * ((float)((gg[2 * bj + n] >> (8 * q)) & 255u) * (1.0f / 255.0f));
                        w[2 * bj + n] = pk4_fp8(v[0], v[1], v[2], v[3]); }
                *(u32x4*)(Ob + qrow) = w;
                asm volatile("" ::: "memory"); }
    }
};
struct EpiWout {
    static constexpr bool PERM = true, HAS_MID = false; static constexpr int MID0 = -1, MID1 = -1;
    const bf16_t* Xb; bf16_t* H;
    __device__ __forceinline__ void mid(f32x4 (&)[2][2][4][2], const Unit&, int, int, int, int, int) const {}
    __device__ __forceinline__ void operator()(const f32x4 (&acc)[2][2][4][2], const Unit& u, int wr, int wc, int fr, int fq) const {
        const int row0 = u.pm * BM + wr * 64 + fr, col0 = u.pn * BM + wc * 32 + 8 * fq;
#pragma unroll
        for (int ai = 0; ai < 2; ++ai)
#pragma unroll
            for (int m = 0; m < 4; ++m) { const unsigned off = (unsigned)((row0 + ai * HALF + m * 16) * D + col0);
#pragma unroll
                for (int bj = 0; bj < 2; ++bj) { const u32x4 xp = *(const u32x4*)(Xb + off + bj * HALF);
                    const f32x4 x0 = {bflo(xp.x), bfhi(xp.x), bflo(xp.y), bfhi(xp.y)}, x1 = {bflo(xp.z), bfhi(xp.z), bflo(xp.w), bfhi(xp.w)};
                    const f32x4 h0 = x0 * ALPHA + acc[ai][bj][m][0], h1 = x1 * ALPHA + acc[ai][bj][m][1];
                    u32x4 w; w.x = cvt_pk_bf16(h0[0], h0[1]); w.y = cvt_pk_bf16(h0[2], h0[3]); w.z = cvt_pk_bf16(h1[0], h1[1]); w.w = cvt_pk_bf16(h1[2], h1[3]);
                    *(u32x4*)(H + off + bj * HALF) = w; } }
    }
};
}

#ifndef FUSE_LN1
#define FUSE_LN1 1
#endif
__device__ __forceinline__ void phase_ln1(Frame& F, const Args& a, int l) {
    const int gw = F.bid * NWAVES + F.wave, NGW = F.G * NWAVES;
    bf16_t* H = (bf16_t*)(F.ws + WS_H); fp8_t* X1B = (fp8_t*)(F.ws + WS_X1B);
    const GAS f32x4* gp = (const GAS f32x4*)(a.in[15] + (size_t)l * D) + 2 * F.lane; const GAS f32x4* bp = (const GAS f32x4*)(a.in[16] + (size_t)l * D) + 2 * F.lane;
    for (int m = gw; m < T; m += NGW) {
        GAS u32x4* xr = (GAS u32x4*)(H + (size_t)m * D) + F.lane;
        u32x4 p[4]; float v[4][8]; float s = 0.f;
#pragma unroll
        for (int j = 0; j < 4; ++j) p[j] = xr[64 * j];
#pragma unroll
        for (int j = 0; j < 4; ++j) { v[j][0] = bflo(p[j].x); v[j][1] = bfhi(p[j].x); v[j][2] = bflo(p[j].y); v[j][3] = bfhi(p[j].y); v[j][4] = bflo(p[j].z); v[j][5] = bfhi(p[j].z); v[j][6] = bflo(p[j].w); v[j][7] = bfhi(p[j].w);
            s += ((v[j][0] + v[j][1]) + (v[j][2] + v[j][3])) + ((v[j][4] + v[j][5]) + (v[j][6] + v[j][7])); }
        const float mean = wave_sum(s) * (1.f / D); float s2 = 0.f;
#pragma unroll
        for (int j = 0; j < 4; ++j)
#pragma unroll
            for (int q = 0; q < 8; ++q) { v[j][q] -= mean; s2 += v[j][q] * v[j][q]; }
        const float rstd = 1.f / sqrtf(wave_sum(s2) * (1.f / D) + EPS);
        GAS u32x2* o8 = (GAS u32x2*)(X1B + (size_t)m * D) + F.lane;
#pragma unroll
        for (int j = 0; j < 4; ++j) { const f32x4 g0 = gp[128 * j], g1 = gp[128 * j + 1], b0 = bp[128 * j], b1 = bp[128 * j + 1];
            const f32x4 y0 = {v[j][0] * rstd * g0.x + b0.x, v[j][1] * rstd * g0.y + b0.y, v[j][2] * rstd * g0.z + b0.z, v[j][3] * rstd * g0.w + b0.w};
            const f32x4 y1 = {v[j][4] * rstd * g1.x + b1.x, v[j][5] * rstd * g1.y + b1.y, v[j][6] * rstd * g1.z + b1.z, v[j][7] * rstd * g1.w + b1.w};
            u32x4 w; w.x = cvt_pk_bf16(y0.x, y0.y); w.y = cvt_pk_bf16(y0.z, y0.w); w.z = cvt_pk_bf16(y1.x, y1.y); w.w = cvt_pk_bf16(y1.z, y1.w); xr[64 * j] = w;
            u32x2 q8; q8.x = pk4_fp8(y0.x, y0.y, y0.z, y0.w); q8.y = pk4_fp8(y1.x, y1.y, y1.z, y1.w); o8[64 * j] = q8; }
    }
}

__device__ __forceinline__ void ln1_rows8(Frame& F, const Args& a, int l, int m0) {
    bf16_t* H = (bf16_t*)(F.ws + WS_H); fp8_t* X1B = (fp8_t*)(F.ws + WS_X1B);
    const GAS f32x4* gp = (const GAS f32x4*)(a.in[15] + (size_t)l * D) + 2 * F.lane; const GAS f32x4* bp = (const GAS f32x4*)(a.in[16] + (size_t)l * D) + 2 * F.lane;
    for (int hb = 0; hb < 2; ++hb) {
        u32x4 p[4][4];
#pragma unroll
        for (int r = 0; r < 4; ++r) { const GAS u32x4* xr = (const GAS u32x4*)(H + (size_t)(m0 + 4 * hb + r) * D) + F.lane;
#pragma unroll
            for (int j = 0; j < 4; ++j) p[r][j] = xr[64 * j]; }
#pragma unroll
        for (int r = 0; r < 4; ++r) { const int m = m0 + 4 * hb + r;
            float v[4][8]; float s = 0.f;
#pragma unroll
            for (int j = 0; j < 4; ++j) { v[j][0] = bflo(p[r][j].x); v[j][1] = bfhi(p[r][j].x); v[j][2] = bflo(p[r][j].y); v[j][3] = bfhi(p[r][j].y); v[j][4] = bflo(p[r][j].z); v[j][5] = bfhi(p[r][j].z); v[j][6] = bflo(p[r][j].w); v[j][7] = bfhi(p[r][j].w);
                s += ((v[j][0] + v[j][1]) + (v[j][2] + v[j][3])) + ((v[j][4] + v[j][5]) + (v[j][6] + v[j][7])); }
            const float mean = wave_sum(s) * (1.f / D); float s2 = 0.f;
#pragma unroll
            for (int j = 0; j < 4; ++j)
#pragma unroll
                for (int q = 0; q < 8; ++q) { v[j][q] -= mean; s2 += v[j][q] * v[j][q]; }
            const float rstd = 1.f / sqrtf(wave_sum(s2) * (1.f / D) + EPS);
            GAS u32x4* xw = (GAS u32x4*)(H + (size_t)m * D) + F.lane; GAS u32x2* o8 = (GAS u32x2*)(X1B + (size_t)m * D) + F.lane;
#pragma unroll
            for (int j = 0; j < 4; ++j) { const f32x4 g0 = gp[128 * j], g1 = gp[128 * j + 1], b0 = bp[128 * j], b1 = bp[128 * j + 1];
                const f32x4 y0 = {v[j][0] * rstd * g0.x + b0.x, v[j][1] * rstd * g0.y + b0.y, v[j][2] * rstd * g0.z + b0.z, v[j][3] * rstd * g0.w + b0.w};
                const f32x4 y1 = {v[j][4] * rstd * g1.x + b1.x, v[j][5] * rstd * g1.y + b1.y, v[j][6] * rstd * g1.z + b1.z, v[j][7] * rstd * g1.w + b1.w};
                u32x4 w; w.x = cvt_pk_bf16(y0.x, y0.y); w.y = cvt_pk_bf16(y0.z, y0.w); w.z = cvt_pk_bf16(y1.x, y1.y); w.w = cvt_pk_bf16(y1.z, y1.w); xw[64 * j] = w;
                u32x2 q8; q8.x = pk4_fp8(y0.x, y0.y, y0.z, y0.w); q8.y = pk4_fp8(y1.x, y1.y, y1.z, y1.w); o8[64 * j] = q8; } }
    }
}

__device__ __forceinline__ bf16x8 pack8(const float* v) { u32x4 p; p.x = cvt_pk_bf16(v[0], v[1]); p.y = cvt_pk_bf16(v[2], v[3]); p.z = cvt_pk_bf16(v[4], v[5]); p.w = cvt_pk_bf16(v[6], v[7]); return __builtin_bit_cast(bf16x8, p); }
__device__ __forceinline__ float grp8_max(float v) { v = fmaxf(v, swz_xor<1>(v)); v = fmaxf(v, swz_xor<2>(v)); v = fmaxf(v, swz_xor<4>(v)); return v; }
__device__ __forceinline__ void phase_router(Frame& F, const Args& a, int l) {
    const bf16_t* X1 = (const bf16_t*)(F.ws + WS_H);
    const bf16_t* RTH = (const bf16_t*)(F.ws + WS_RT); const bf16_t* RTL = RTH + 64 * D;
    unsigned long long* SELMASK = (unsigned long long*)(F.ws + WS_MISC + MS_SELMASK); float* SELW = (float*)(F.ws + WS_MISC + MS_SELW); int* CNT = (int*)(F.ws + WS_MISC + MS_CNT);
    LAS float* PART = (LAS float*)F.lds;
    LAS float* LG = (LAS float*)(F.lds + 131072);
    LAS int* CNTL = (LAS int*)(F.lds + 131072 + 16384);
    const int lane = F.lane, w = F.wave, li = lane & 15, lq = lane >> 4;
    const float bias = a.in[18][l * NEXP + lane];
    for (int blk = F.bid; blk < T / 64; blk += F.G) {
#if FUSE_LN1
        ln1_rows8(F, a, l, blk * 64 + w * 8);
        __syncthreads();
#endif
        if (F.tid < 64) CNTL[F.tid] = 0;
        {
            f32x4 acc[4][4];
#pragma unroll
            for (int rt = 0; rt < 4; ++rt)
#pragma unroll
                for (int nb = 0; nb < 4; ++nb) acc[rt][nb] = (f32x4){0.f, 0.f, 0.f, 0.f};
            const bf16_t* xp = X1 + (size_t)(blk * 64 + li) * D + 256 * w + 8 * lq;
            const bf16_t* whp = RTH + (size_t)li * D + 256 * w + 8 * lq;
#pragma unroll 4
            for (int ks = 0; ks < 8; ++ks) {
                bf16x8 xh[4], bh[4];
#pragma unroll
                for (int rt = 0; rt < 4; ++rt) xh[rt] = *(const bf16x8*)(xp + (size_t)(16 * rt) * D + 32 * ks);
#pragma unroll
                for (int nb = 0; nb < 4; ++nb) bh[nb] = *(const bf16x8*)(whp + (size_t)(16 * nb) * D + 32 * ks);
#pragma unroll
                for (int rt = 0; rt < 4; ++rt)
#pragma unroll
                    for (int nb = 0; nb < 4; ++nb) acc[rt][nb] = __builtin_amdgcn_mfma_f32_16x16x32_bf16(xh[rt], bh[nb], acc[rt][nb], 0, 0, 0);
            }
#pragma unroll
            for (int rt = 0; rt < 4; ++rt)
#pragma unroll
                for (int nb = 0; nb < 4; ++nb)
#pragma unroll
                    for (int r = 0; r < 4; ++r) PART[(w * 64 + 16 * rt + 4 * lq + r) * 64 + 16 * nb + li] = acc[rt][nb][r];
        }
        __syncthreads();
#pragma unroll
        for (int i = 0; i < 8; ++i) { const int id = F.tid + 512 * i; float sacc = 0.f;
#pragma unroll
            for (int q = 0; q < 8; ++q) sacc += PART[q * 4096 + id];
            LG[id] = sacc; }
        __syncthreads();
        int mycnt = 0;
        for (int i = 0; i < 8; ++i) {
            const int tl = w * 8 + i, t = blk * 64 + tl;
            const float logit = LG[tl * 64 + lane];
            const float score = 1.0f / (1.0f + expf(-logit));
            const float sel = score + bias;
            const float m1 = grp8_max(sel);
            const unsigned long long eqm = __ballot(sel == m1);
            const unsigned gb = (unsigned)(eqm >> (lane & ~7)) & 0xffu;
            const int first = __builtin_ctz(gb);
            const float v2 = ((lane & 7) == first) ? -INFINITY : sel;
            const float gs = m1 + grp8_max(v2);
            const int g = lane >> 3; int grank = 0;
#pragma unroll
            for (int g2 = 0; g2 < 8; ++g2) { const float o = __builtin_bit_cast(float, __builtin_amdgcn_readlane(__builtin_bit_cast(int, gs), 8 * g2)); grank += (o > gs || (o == gs && g2 < g)) ? 1 : 0; }
            const float mv = grank < 4 ? sel : -INFINITY;
            int rank = 0;
#pragma unroll 4
            for (int e2 = 0; e2 < 64; ++e2) { const float o = __builtin_bit_cast(float, __builtin_amdgcn_readlane(__builtin_bit_cast(int, mv), e2)); rank += (o > mv || (o == mv && e2 < lane)) ? 1 : 0; }
            const bool chosen = rank < 8;
            const unsigned long long mask = __ballot(chosen);
            const float wsum = wave_sum(chosen ? score : 0.f);
            const float wgt = score / wsum * 2.5f;
            if (chosen) { const int j = __builtin_popcountll(mask & ((1ull << lane) - 1ull)); SELW[(size_t)t * 8 + j] = wgt; }
            if (lane == 0) SELMASK[t] = mask;
            mycnt += chosen ? 1 : 0;
        }
        __hip_atomic_fetch_add(&CNTL[lane], mycnt, __ATOMIC_RELAXED, __HIP_MEMORY_SCOPE_WORKGROUP);
        __syncthreads();
        if (F.tid < 64) CNT[blk * 64 + F.tid] = CNTL[F.tid];
        __syncthreads();
    }
}

__device__ __forceinline__ void phase_lists(Frame& F) {
    const unsigned long long* SELMASK = (const unsigned long long*)(F.ws + WS_MISC + MS_SELMASK); const int* CNT = (const int*)(F.ws + WS_MISC + MS_CNT);
    int* TOK2SLOT = (int*)(F.ws + WS_MISC + MS_TOK2SLOT); int* SLOTTOK = (int*)(F.ws + WS_MISC + MS_SLOTTOK); int* BLKE = (int*)(F.ws + WS_MISC + MS_BLKE); int* NBLK = (int*)(F.ws + WS_MISC + MS_NBLK);
    LAS int* P = (LAS int*)F.lds;
    LAS int* TOT = P + 1024;
    LAS int* PST = TOT + 64; LAS int* BASE = TOT + 192;
    const int lane = F.lane, e = F.tid & 63, part = F.tid >> 6;
    for (int blk = F.bid; blk < T / 64; blk += F.G) {
        int tot = 0, pre = 0;
        for (int b2 = part; b2 < T / 64; b2 += 8) { const int c = CNT[b2 * 64 + e]; tot += c; pre += (b2 < blk) ? c : 0; }
        P[part * 64 + e] = tot; P[512 + part * 64 + e] = pre;
        __syncthreads();
        if (F.tid < 64) { int t2 = 0, p2 = 0;
#pragma unroll
            for (int q = 0; q < 8; ++q) { t2 += P[q * 64 + e]; p2 += P[512 + q * 64 + e]; }
            TOT[e] = t2; BASE[e] = p2;
            const int padded = (t2 + 255) & ~255;
            const int incl = wave_scan_i(padded, lane);
            PST[e] = incl - padded; if (e == 63) PST[64] = incl;
        }
        __syncthreads();
        if (F.wave == 0) {
            int running = PST[lane] + BASE[lane];
            const unsigned long long mymask = SELMASK[blk * 64 + lane];
            const unsigned mlo = (unsigned)mymask, mhi = (unsigned)(mymask >> 32);
            for (int i = 0; i < 64; ++i) {
                const unsigned long long mk = ((unsigned long long)(unsigned)__builtin_amdgcn_readlane((int)mhi, i) << 32) | (unsigned)__builtin_amdgcn_readlane((int)mlo, i);
                if ((mk >> lane) & 1ull) { const int t = blk * 64 + i, j = __builtin_popcountll(mk & ((1ull << lane) - 1ull)); TOK2SLOT[t * 8 + j] = running; SLOTTOK[running] = t; ++running; }
            }
        }
        if (blk == 0) {
            const int nblk = PST[64] >> 8;
            if (F.tid == 0) NBLK[0] = nblk;
            for (int ee = F.wave; ee < 64; ee += NWAVES) { const int s0 = PST[ee] + TOT[ee], s1 = PST[ee + 1]; for (int s = s0 + lane; s < s1; s += 64) SLOTTOK[s] = 0;
                for (int j = (PST[ee] >> 8) + lane; j < (PST[ee + 1] >> 8); j += 64) BLKE[j] = ee; }
            for (int j = F.tid; j < 64; j += NTHR) BLKE[MAXSLOT / 256 + j] = 64;
        }
        for (int i = F.tid; i < 64; i += NTHR) SLOTTOK[MAXSLOT + blk * 64 + i] = blk * 64 + i;
        __syncthreads();
    }
}

constexpr int MOE_TOKL = 131072, MOE_BLKL = 131072 + 12288;
struct MoeOrder2 {
    const LAS int* blke_l; int nblk, NT, G, c;
    __device__ bool next(int i, pg8::Unit& u) const {
        const int L = i * G + c; if (L >= (nblk + 64) * NT) return false;
        const int j = L / NT, pl = L - j * NT, jj = j < nblk ? j : (MAXSLOT / 256 + (j - nblk));
        u.pm = jj; u.pn = __builtin_amdgcn_readfirstlane(blke_l[i]) * NT + pl; return true;
    }
};
template <bool GATHER> __device__ __forceinline__ void moe_fill(Frame& F, int nblk, int NT) {
    const int* BLKE = (const int*)(F.ws + WS_MISC + MS_BLKE); const int* SLOTTOK = (const int*)(F.ws + WS_MISC + MS_SLOTTOK);
    LAS int* TOKL = (LAS int*)(F.lds + MOE_TOKL); LAS int* BLKL = (LAS int*)(F.lds + MOE_BLKL);
    const int total = (nblk + 64) * NT;
    for (int i = 0; i < (GATHER ? 12 : 64); ++i) { const int L = i * F.G + F.bid; if (L >= total) break;
        const int j = L / NT, jj = j < nblk ? j : (MAXSLOT / 256 + (j - nblk));
        if (F.tid == 0) BLKL[i] = BLKE[jj];
        if (GATHER && F.tid < 256) TOKL[i * 256 + F.tid] = SLOTTOK[jj * 256 + F.tid]; }
    __syncthreads();
}

__device__ __forceinline__ void phase_combine(Frame& F, const Args& a, int l) {
    const int gw = F.bid * NWAVES + F.wave, NGW = F.G * NWAVES;
    const GAS char* X1 = (const GAS char*)(F.ws + WS_H); const GAS char* OS = (const GAS char*)(F.ws + WS_OS);
    const int* TOK2SLOT = (const int*)(F.ws + WS_MISC + MS_TOK2SLOT); const float* SELW = (const float*)(F.ws + WS_MISC + MS_SELW);
    GAS char* XRES = (GAS char*)((l == DEPTH - 1) ? a.out : (float*)(F.ws + WS_XRES)); GAS char* XB = (GAS char*)(F.ws + WS_XB);
    const GAS char* gp = (const GAS char*)(a.in[25] + (size_t)l * D); const GAS char* bp = (const GAS char*)(a.in[26] + (size_t)l * D);
    for (int m = gw; m < T; m += NGW) {
        int ln = F.lane; asm volatile("" : "+v"(ln));
        const unsigned o32 = (unsigned)ln * 32u, o8 = (unsigned)ln * 8u;
        int slot[8]; float wt[8];
#pragma unroll
        for (int k = 0; k < 8; ++k) { slot[k] = __builtin_amdgcn_readfirstlane(TOK2SLOT[m * 8 + k]); wt[k] = __builtin_bit_cast(float, __builtin_amdgcn_readfirstlane(__builtin_bit_cast(int, SELW[m * 8 + k]))) * (1.0f / OSCALE); }
        const GAS char* xr = X1 + (size_t)m * (D * 2); const GAS char* shr = OS + (size_t)(MAXSLOT + m) * D;
        float v[4][8];
#pragma unroll
        for (int j = 0; j < 4; ++j) {
            const u32x4 xp8 = *(const GAS u32x4*)(xr + 2u * o8 + 1024 * j);
            const u32x2 sh = *(const GAS u32x2*)(shr + o8 + 512 * j);
            u32x2 ex[8];
#pragma unroll
            for (int k = 0; k < 8; ++k) ex[k] = *(const GAS u32x2*)(OS + (size_t)slot[k] * D + o8 + 512 * j);
            float acc[8] = {bflo(xp8.x) * ALPHA, bfhi(xp8.x) * ALPHA, bflo(xp8.y) * ALPHA, bfhi(xp8.y) * ALPHA, bflo(xp8.z) * ALPHA, bfhi(xp8.z) * ALPHA, bflo(xp8.w) * ALPHA, bfhi(xp8.w) * ALPHA};
            {   float f0[4], f1[4]; unpk4_fp8(sh.x, f0); unpk4_fp8(sh.y, f1);
#pragma unroll
                for (int q = 0; q < 4; ++q) { acc[q] += f0[q] * (1.0f / OSCALE); acc[4 + q] += f1[q] * (1.0f / OSCALE); } }
#pragma unroll
            for (int k = 0; k < 8; ++k) { float f0[4], f1[4]; unpk4_fp8(ex[k].x, f0); unpk4_fp8(ex[k].y, f1);
#pragma unroll
                for (int q = 0; q < 4; ++q) { acc[q] += wt[k] * f0[q]; acc[4 + q] += wt[k] * f1[q]; } }
#pragma unroll
            for (int q = 0; q < 8; ++q) v[j][q] = acc[q];
        }
        float s = 0.f;
#pragma unroll
        for (int j = 0; j < 4; ++j)
#pragma unroll
            for (int q = 0; q < 8; ++q) s += v[j][q];
        const float mean = wave_sum(s) * (1.f / D); float s2 = 0.f;
#pragma unroll
        for (int j = 0; j < 4; ++j)
#pragma unroll
            for (int q = 0; q < 8; ++q) { v[j][q] -= mean; s2 += v[j][q] * v[j][q]; }
        const float rstd = 1.f / sqrtf(wave_sum(s2) * (1.f / D) + EPS);
        GAS char* orow = XRES + (size_t)m * (D * 4); GAS char* orow16 = XRES + (size_t)m * (D * 2); GAS char* xbr = XB + (size_t)m * D;
#pragma unroll
        for (int j = 0; j < 4; ++j) { const f32x4 g0 = *(const GAS f32x4*)(gp + o32 + 2048 * j), g1 = *(const GAS f32x4*)(gp + o32 + 2048 * j + 16), b0 = *(const GAS f32x4*)(bp + o32 + 2048 * j), b1 = *(const GAS f32x4*)(bp + o32 + 2048 * j + 16);
            const f32x4 y0 = {v[j][0] * rstd * g0.x + b0.x, v[j][1] * rstd * g0.y + b0.y, v[j][2] * rstd * g0.z + b0.z, v[j][3] * rstd * g0.w + b0.w};
            const f32x4 y1 = {v[j][4] * rstd * g1.x + b1.x, v[j][5] * rstd * g1.y + b1.y, v[j][6] * rstd * g1.z + b1.z, v[j][7] * rstd * g1.w + b1.w};
            if (l == DEPTH - 1) { *(GAS f32x4*)(orow + o32 + 2048 * j) = y0; *(GAS f32x4*)(orow + o32 + 2048 * j + 16) = y1; }
            else {
                u32x4 wb; wb.x = cvt_pk_bf16(y0.x, y0.y); wb.y = cvt_pk_bf16(y0.z, y0.w); wb.z = cvt_pk_bf16(y1.x, y1.y); wb.w = cvt_pk_bf16(y1.z, y1.w); *(GAS u32x4*)(orow16 + 2u * o8 + 1024 * j) = wb;
                u32x2 w; w.x = pk4_fp8(y0.x, y0.y, y0.z, y0.w); w.y = pk4_fp8(y1.x, y1.y, y1.z, y1.w); *(GAS u32x2*)(xbr + o8 + 512 * j) = w; } }
    }
}

typedef short v4i16_t __attribute__((ext_vector_type(4)));
__device__ __forceinline__ unsigned offb(unsigned row, unsigned ch) { return 256u * row + 16u * (ch ^ (((row & 3u) << 2) | ((row >> 2) & 3u))); }
__device__ __forceinline__ s16x4 trr(const LAS unsigned char* p) { return __builtin_bit_cast(s16x4, __builtin_amdgcn_ds_read_tr16_b64_v4i16((LAS v4i16_t*)p)); }
#define MFMA32(a, b, c) __builtin_amdgcn_mfma_f32_32x32x16_bf16((a), (b), (c), 0, 0, 0)
__device__ __forceinline__ int crow(int i, int hh) { return (i & 3) + 8 * (i >> 2) + 4 * hh; }
__device__ __forceinline__ bf16x8 frag_row(const LAS unsigned char* img, int row0, int s, int lane) { return *(const LAS bf16x8*)(img + offb(row0 + (lane & 31), 2 * s + (lane >> 5))); }
template <bool PERMK> __device__ __forceinline__ bf16x8 frag_tr(const LAS unsigned char* img, int cb, int k0, int lane) {
    const int hh = lane >> 5, blk = (lane >> 4) & 1, q = (lane & 15) >> 2, p = lane & 3;
    const int r0 = PERMK ? (k0 + 4 * hh + q) : (k0 + 8 * hh + q), r1 = PERMK ? (r0 + 8) : (r0 + 4);
    const int ch = 4 * cb + 2 * blk + (p >> 1);
    const s16x4 lo = trr(img + offb(r0, ch) + 8 * (p & 1)), hi = trr(img + offb(r1, ch) + 8 * (p & 1));
    return __builtin_shufflevector(lo, hi, 0, 1, 2, 3, 4, 5, 6, 7);
}
__device__ __forceinline__ bf16x8 pack_acc(const f32x16& x, int half) {
    u32x4 p;
    if (half == 0) { p.x = cvtpk(x[0], x[1]); p.y = cvtpk(x[2], x[3]); p.z = cvtpk(x[4], x[5]); p.w = cvtpk(x[6], x[7]); }
    else { p.x = cvtpk(x[8], x[9]); p.y = cvtpk(x[10], x[11]); p.z = cvtpk(x[12], x[13]); p.w = cvtpk(x[14], x[15]); }
    return __builtin_bit_cast(bf16x8, p);
}

__device__ __forceinline__ void attn_unit(Frame& F, const bf16_t* PROJ, fp8_t* BRCAT, const float* normg, int b, int h, int j, float lam, float lam_init) {
    int tid_ = F.tid; asm volatile("" : "+v"(tid_));
    const int tid = tid_, lane = tid & 63, w = F.wave, c = w >> 2, r0 = 32 * (w & 3), r32 = lane & 31, hh = lane >> 5;
    LAS unsigned char* lds = F.lds;
    unsigned rowa = offb(r32, hh), tb[4][2];
    {   const int blk = (lane >> 4) & 1, q = (lane & 15) >> 2, p = lane & 3; const unsigned tra = 32768u + offb(4 * hh + q, 2 * blk + (p >> 1)) + 8 * (p & 1);
#pragma unroll
        for (int cb = 0; cb < 4; ++cb) { tb[cb][0] = tra ^ (64u * cb); tb[cb][1] = ((tra ^ (64u * cb)) ^ 32u) + 2048u; asm volatile("" : "+v"(tb[cb][0]), "+v"(tb[cb][1])); } }
    asm volatile("" : "+v"(rowa));
    const unsigned kq = (unsigned)(c * 16384), qq = (unsigned)(65536 + w * 8192);
    unsigned ko = (unsigned)(((tid >> 4) * NPROJ + PQ_DAK + h * 256 + 8 * (tid & 15)) * 2), vo = (unsigned)(((tid >> 5) * NPROJ + PQ_DAV + h * 256 + 8 * (tid & 31)) * 2);
    unsigned kl = offb(tid >> 4, tid & 15), vl = 32768u + ((tid >> 4) & 1) * 16384u + offb(tid >> 5, tid & 15);
    asm volatile("" : "+v"(ko), "+v"(vo), "+v"(kl), "+v"(vl));
    const float c1 = 0.08838834764831845f * 1.4426950408889634f;
    __syncthreads();
    {   int ln = lane; asm volatile("" : "+v"(ln));
        const char* qp = (const char*)(PROJ + ((size_t)b * SEQ + 128 * j + r0) * NPROJ + PQ_DAQ + h * 256 + c * 128);
#pragma unroll
        for (int i = 0; i < 8; ++i) { const int id = ln + 64 * i, row = id >> 4, ch = id & 15; const u32x4 qv = *(const u32x4*)(qp + (unsigned)((row * NPROJ + 8 * ch) * 2));
            u32x4 qs; qs.x = cvtpk(bflo(qv.x) * c1, bfhi(qv.x) * c1); qs.y = cvtpk(bflo(qv.y) * c1, bfhi(qv.y) * c1); qs.z = cvtpk(bflo(qv.z) * c1, bfhi(qv.z) * c1); qs.w = cvtpk(bflo(qv.w) * c1, bfhi(qv.w) * c1);
            *(LAS u32x4*)(lds + qq + offb(row, ch)) = qs; } }
    f32x16 o[8];
#pragma unroll
    for (int eb = 0; eb < 8; ++eb)
#pragma unroll
        for (int i = 0; i < 16; ++i) o[eb][i] = 0.f;
    float mrun = 0.f, lrun = 0.f;
    const int qpos = 128 * j + r0 + r32;
    const float c2 = __builtin_amdgcn_exp2f(-2.0f * (float)(h + 1)) * 1.4426950408889634f;
    const int nt = 2 * (j + 1);
    u32x4 k1a, k2a, k1b, k2b, v0, v1, v2, v3;
#define ATT_LOAD(kt_) do { const char* kb_ = (const char*)(PROJ + ((size_t)b * SEQ + 64 * (kt_)) * NPROJ); \
        k1a = *(const u32x4*)(kb_ + ko); k2a = *(const u32x4*)(kb_ + ko + 256); k1b = *(const u32x4*)(kb_ + ko + 32 * NPROJ * 2); k2b = *(const u32x4*)(kb_ + ko + 32 * NPROJ * 2 + 256); \
        v0 = *(const u32x4*)(kb_ + vo); v1 = *(const u32x4*)(kb_ + vo + 16 * NPROJ * 2); v2 = *(const u32x4*)(kb_ + vo + 32 * NPROJ * 2); v3 = *(const u32x4*)(kb_ + vo + 48 * NPROJ * 2); } while (0)
    ATT_LOAD(0);
    for (int kt = 0; kt < nt; ++kt) {
        __syncthreads();
        *(LAS u32x4*)(lds + kl) = k1a; *(LAS u32x4*)(lds + kl + 16384) = k2a; *(LAS u32x4*)(lds + kl + 8192) = k1b; *(LAS u32x4*)(lds + kl + 8192 + 16384) = k2b;
        *(LAS u32x4*)(lds + vl) = v0; *(LAS u32x4*)(lds + vl + 4096) = v1; *(LAS u32x4*)(lds + vl + 8192) = v2; *(LAS u32x4*)(lds + vl + 12288) = v3;
        __syncthreads();
        if (kt + 1 < nt) ATT_LOAD(kt + 1);
        const int kbase = 64 * kt + 4 * hh - qpos;
        const float fkb = c2 * (float)kbase - (kt == 0 ? 0.f : mrun);
        f32x16 p0, p1;
#pragma unroll
        for (int i = 0; i < 16; ++i) { p0[i] = fmaf(c2, (float)((i & 3) + 8 * (i >> 2)), fkb); p1[i] = fmaf(c2, (float)(32 + (i & 3) + 8 * (i >> 2)), fkb); }
#pragma unroll
        for (int s = 0; s < 8; ++s) { const unsigned ra = rowa ^ (32u * s); const bf16x8 a0 = *(const LAS bf16x8*)(lds + kq + ra), a1 = *(const LAS bf16x8*)(lds + kq + ra + 8192), qv = *(const LAS bf16x8*)(lds + qq + ra);
            p0 = MFMA32(a0, qv, p0); p1 = MFMA32(a1, qv, p1); }
        if (kt >= 2 * j) {
#pragma unroll
            for (int i = 0; i < 16; ++i) { const int dk = kbase + (i & 3) + 8 * (i >> 2); if (dk > 0) p0[i] = -INFINITY; if (dk + 32 > 0) p1[i] = -INFINITY; } }
        float mx = fmaxf(p0[0], p1[0]);
#pragma unroll
        for (int i = 1; i < 16; ++i) mx = fmaxf(fmaxf(mx, p0[i]), p1[i]);
        mx = x32_max(mx);
        if (kt == 0) {
#pragma unroll
            for (int i = 0; i < 16; ++i) { p0[i] -= mx; p1[i] -= mx; }
            mrun = mx; mx = 0.f; }
        float psum = 0.f;
#pragma unroll
        for (int i = 0; i < 16; ++i) { p0[i] = __builtin_amdgcn_exp2f(p0[i]); p1[i] = __builtin_amdgcn_exp2f(p1[i]); psum += p0[i] + p1[i]; }
        lrun += psum;
        bf16x8 pf[4]; pf[0] = pack_acc(p0, 0); pf[1] = pack_acc(p0, 1); pf[2] = pack_acc(p1, 0); pf[3] = pack_acc(p1, 1);
#pragma unroll
        for (int ks = 0; ks < 4; ++ks)
#pragma unroll
            for (int eb = 0; eb < 8; ++eb) { const unsigned ab = (eb >> 2) * 16384 + ks * 4096;
                const s16x4 lo = trr(lds + tb[eb & 3][0] + ab), hi = trr(lds + tb[eb & 3][1] + ab);
                const bf16x8 va = __builtin_shufflevector(lo, hi, 0, 1, 2, 3, 4, 5, 6, 7); o[eb] = MFMA32(va, pf[ks], o[eb]); }
        const float dm = fmaxf(mx, 0.f);
        if (__builtin_amdgcn_ballot_w64(dm > 0.f) != 0ull) { const float sc = __builtin_amdgcn_exp2f(-dm);
#pragma unroll
            for (int eb = 0; eb < 8; ++eb) o[eb] = o[eb] * sc;
            lrun *= sc; mrun += dm; }
    }
#undef ATT_LOAD
    asm volatile("" : "+s"(normg), "+s"(BRCAT) :: "memory");
    const GAS float* normg_g = (const GAS float*)normg; GAS fp8_t* brcat_g = (GAS fp8_t*)BRCAT;
    const float lsum = x32_sum(lrun), inv = 1.0f / lsum;
    LAS float* XCH = (LAS float*)lds;
    int ln2 = lane; asm volatile("" : "+v"(ln2));
    const int hh2 = ln2 >> 5;
    __syncthreads();
    if (c == 1) {
        const float sc = inv * lam;
#pragma unroll
        for (int eb = 0; eb < 8; ++eb)
#pragma unroll
            for (int i = 0; i < 16; ++i) XCH[(((w & 3) * 128 + eb * 16 + i) << 6) + ln2] = o[eb][i] * sc;
    }
    __syncthreads();
    if (c == 0) {
        float ss = 0.f;
#pragma unroll
        for (int eb = 0; eb < 8; ++eb)
#pragma unroll
            for (int i = 0; i < 16; ++i) { const float v = o[eb][i] * inv - XCH[(((w & 3) * 128 + eb * 16 + i) << 6) + ln2]; o[eb][i] = v; ss += v * v; }
        ss = x32_sum(ss);
        const float rstd = (1.0f - lam_init) / sqrtf(ss * (1.0f / 256.0f) + EPS);
        GAS char* op = (GAS char*)(brcat_g + ((size_t)b * SEQ + 128 * j + r0) * 3072 + h * 256);
        const unsigned oo = (unsigned)((ln2 & 31) * 3072 + 4 * hh2);
#pragma unroll
        for (int eb = 0; eb < 8; ++eb)
#pragma unroll
            for (int g = 0; g < 4; ++g) { const int e0 = 32 * eb + 8 * g; const f32x4 gn = *(const GAS f32x4*)(normg_g + e0 + 4 * hh2);
                *(GAS unsigned*)(op + oo + e0) = pk4_fp8(o[eb][4 * g] * rstd * gn.x, o[eb][4 * g + 1] * rstd * gn.y, o[eb][4 * g + 2] * rstd * gn.z, o[eb][4 * g + 3] * rstd * gn.w); }
    }
}
__device__ __forceinline__ void phase_attn(Frame& F, const Args& a, int l) {
    const bf16_t* PROJ = (const bf16_t*)(F.ws + WS_PROJ); fp8_t* BRCAT = (fp8_t*)(F.ws + WS_BRCAT);
    const float* lp = a.in[2] + (size_t)l * 4 * 128; const float* normg = a.in[3] + (size_t)l * 256;
    const float s01 = wave_sum(lp[F.lane] * lp[128 + F.lane] + lp[64 + F.lane] * lp[192 + F.lane]);
    const float s23 = wave_sum(lp[256 + F.lane] * lp[384 + F.lane] + lp[320 + F.lane] * lp[448 + F.lane]);
    const float lam_init = 0.8f - 0.6f * expf(-0.3f * (float)l);
    const float lam = __builtin_bit_cast(float, __builtin_amdgcn_readfirstlane(__builtin_bit_cast(int, expf(s01) - expf(s23) + lam_init)));
    volatile LAS unsigned* qslot = (volatile LAS unsigned*)(F.lds + MISC_OFF + 128);
    for (;;) {
        __syncthreads();
        if (F.tid == 0) *qslot = __hip_atomic_fetch_add((unsigned*)(F.ws + WS_CTL) + CW_ATTQ + 64 * l, 1u, __ATOMIC_RELAXED, __HIP_MEMORY_SCOPE_AGENT);
        __syncthreads();
        const int k = __builtin_amdgcn_readfirstlane((int)*qslot);
        if (k >= 512) break;
        const int bh = k & 15, b = bh >> 2, h = bh & 3;
        attn_unit(F, PROJ, BRCAT, normg, b, h, 31 - (k >> 4), lam, lam_init);
    }
}


__device__ __forceinline__ void gla_gates(Frame& F, const float* SMALL, const float* w2, const float* b2, int h, size_t t0, float (&bc)[16], float& btot) {
    LAS float* LR = (LAS float*)F.lds; LAS float* GT = (LAS float*)(F.lds + 4096);
    const int tid = F.tid, d = tid & 127, g4 = tid >> 7;
#pragma unroll
    for (int i = 0; i < 2; ++i) { const int id = tid + 512 * i, pos = id >> 4, r = id & 15; LR[id] = SMALL[(t0 + pos) * 32 + r]; }
    float wv[16];
#pragma unroll
    for (int r = 0; r < 16; ++r) wv[r] = w2[r * 512 + h * 128 + d];
    const float bb = b2[h * 128 + d];
    __syncthreads();
    float run = 0.f;
#pragma unroll
    for (int i = 0; i < 16; ++i) { const int pos = 16 * g4 + i; float z = bb;
#pragma unroll
        for (int r4 = 0; r4 < 4; ++r4) { const f32x4 lv = *(const LAS f32x4*)(LR + pos * 16 + 4 * r4); z += lv.x * wv[4 * r4] + lv.y * wv[4 * r4 + 1] + lv.z * wv[4 * r4 + 2] + lv.w * wv[4 * r4 + 3]; }
        const float ls = fminf(z, 0.f) - fast_log(1.0f + fast_exp(-fabsf(z)));
        run += ls * (1.0f / 16.0f); bc[i] = run; }
    GT[g4 * 128 + d] = run;
    __syncthreads();
    float pre = 0.f, tot = 0.f;
#pragma unroll
    for (int q = 0; q < 4; ++q) { const float v = GT[q * 128 + d]; tot += v; pre += (q < g4) ? v : 0.f; }
#pragma unroll
    for (int i = 0; i < 16; ++i) bc[i] += pre;
    btot = tot;
}
__device__ __forceinline__ void gla_stage_v(Frame& F, const bf16_t* PROJ, int h, size_t t0, int voff) {
#pragma unroll
    for (int i = 0; i < 4; ++i) { const int cid = F.tid + 512 * i, row = cid >> 5, c32 = cid & 31;
        const u32x4 v = *(const u32x4*)(PROJ + (t0 + row) * NPROJ + PQ_GV + h * 256 + 8 * c32);
        *(LAS u32x4*)(F.lds + voff + (c32 >> 4) * 16384 + offb(row, c32 & 15)) = v; }
}
__device__ __forceinline__ void gla_stage128(Frame& F, const bf16_t* PROJ, int col0, size_t t0, int off) {
#pragma unroll
    for (int i = 0; i < 2; ++i) { const int cid = F.tid + 512 * i, row = cid >> 4, ch = cid & 15;
        *(LAS u32x4*)(F.lds + off + offb(row, ch)) = *(const u32x4*)(PROJ + (t0 + row) * NPROJ + col0 + 8 * ch); }
}
__device__ __forceinline__ void phase_gla_local(Frame& F, const Args& a, int l) {
    const bf16_t* PROJ = (const bf16_t*)(F.ws + WS_PROJ); const float* SMALL = (const float*)(F.ws + WS_SMALL);
    bf16_t* UPDT = (bf16_t*)(F.ws + WS_UPDT); float* GDEC = (float*)(F.ws + WS_GDEC);
    const float* w2 = a.in[4] + (size_t)l * 16 * 512; const float* b2 = a.in[5] + (size_t)l * 512;
    const int w = F.wave;
    constexpr int KDT = 8192, VOFF = 40960, KRAW = 73728;
    u32x4 pk[2], pv[4];
    auto ldkv = [&](int uu) { const int bh2 = uu >> 6, n2 = uu & 63, b2i = bh2 >> 2, h2 = bh2 & 3; const size_t tt = (size_t)b2i * SEQ + 64 * n2;
#pragma unroll
        for (int i = 0; i < 2; ++i) { const int cid = F.tid + 512 * i, row = cid >> 4, ch = cid & 15; pk[i] = *(const u32x4*)(PROJ + (tt + row) * NPROJ + PQ_GK + h2 * 128 + 8 * ch); }
#pragma unroll
        for (int i = 0; i < 4; ++i) { const int cid = F.tid + 512 * i, row = cid >> 5, c32 = cid & 31; pv[i] = *(const u32x4*)(PROJ + (tt + row) * NPROJ + PQ_GV + h2 * 256 + 8 * c32); } };
    if (F.bid < 1024) ldkv(F.bid);
    for (int u = F.bid; u < 1024; u += F.G) {
        const int bh = u >> 6, n = u & 63, b = bh >> 2, h = bh & 3; const size_t t0 = (size_t)b * SEQ + 64 * n;
        int tid_ = F.tid; asm volatile("" : "+v"(tid_));
        const int tid = tid_, lane = tid & 63, d = tid & 127, g4 = tid >> 7, r32 = lane & 31, hh = lane >> 5;
        __syncthreads();
        float bc[16], btot;
#pragma unroll
        for (int i = 0; i < 2; ++i) { const int cid = F.tid + 512 * i, row = cid >> 4, ch = cid & 15; *(LAS u32x4*)(F.lds + KRAW + offb(row, ch)) = pk[i]; }
#pragma unroll
        for (int i = 0; i < 4; ++i) { const int cid = F.tid + 512 * i, row = cid >> 5, c32 = cid & 31; *(LAS u32x4*)(F.lds + VOFF + (c32 >> 4) * 16384 + offb(row, c32 & 15)) = pv[i]; }
        gla_gates(F, SMALL, w2, b2, h, t0, bc, btot);
        { const int un = u + F.G; ldkv(un < 1024 ? un : u); }
        {   float kd[16];
#pragma unroll
            for (int i = 0; i < 16; ++i) kd[i] = bf2f(*(const LAS unsigned short*)(F.lds + KRAW + offb(16 * g4 + i, d >> 3) + 2 * (d & 7))) * fast_exp(btot - bc[i]);
            u32x4 w0, w1; w0.x = cvtpk(kd[0], kd[1]); w0.y = cvtpk(kd[2], kd[3]); w0.z = cvtpk(kd[4], kd[5]); w0.w = cvtpk(kd[6], kd[7]);
            w1.x = cvtpk(kd[8], kd[9]); w1.y = cvtpk(kd[10], kd[11]); w1.z = cvtpk(kd[12], kd[13]); w1.w = cvtpk(kd[14], kd[15]);
            *(LAS u32x4*)(F.lds + KDT + offb(d, 2 * g4)) = w0; *(LAS u32x4*)(F.lds + KDT + offb(d, 2 * g4 + 1)) = w1;
            if (g4 == 0) GDEC[((size_t)bh * 64 + n) * 128 + d] = fast_exp(btot);
        }
        __syncthreads();
        f32x16 acc[4];
#pragma unroll
        for (int db = 0; db < 4; ++db)
#pragma unroll
            for (int i = 0; i < 16; ++i) acc[db][i] = 0.f;
#pragma unroll
        for (int s = 0; s < 4; ++s) { const bf16x8 va = frag_tr<false>(F.lds + VOFF + (w >> 2) * 16384, w & 3, 16 * s, lane);
#pragma unroll
            for (int db = 0; db < 4; ++db) { const bf16x8 kb = frag_row(F.lds + KDT, 32 * db, s, lane); acc[db] = MFMA32(va, kb, acc[db]); } }
        bf16_t* up = UPDT + ((size_t)bh * 64 + n) * 256 * 128;
#pragma unroll
        for (int db = 0; db < 4; ++db)
#pragma unroll
            for (int i = 0; i < 16; ++i) up[(size_t)(32 * w + crow(i, hh)) * 128 + 32 * db + r32] = (bf16_t)(cvtpk(acc[db][i], 0.f) & 0xffffu);
    }
}
__device__ __forceinline__ void phase_gla_scan(Frame& F) {
    const bf16_t* UPDT = (const bf16_t*)(F.ws + WS_UPDT); const float* GDEC = (const float*)(F.ws + WS_GDEC); bf16_t* SPT = (bf16_t*)(F.ws + WS_SPREVT);
    for (int idx = F.bid * NTHR + F.tid; idx < 16 * 256 * 32; idx += F.G * NTHR) {
        const int bh = idx >> 13, e = (idx >> 5) & 255, d4 = idx & 31;
        f32x4 st = {0.f, 0.f, 0.f, 0.f};
        const size_t base = ((size_t)bh * 64) * 256 * 128 + (size_t)e * 128 + 4 * d4;
#pragma unroll 8
        for (int n = 0; n < 64; ++n) {
            const u32x2 up2 = *(const u32x2*)(UPDT + base + (size_t)n * 256 * 128); const f32x4 uu = {bflo(up2.x), bfhi(up2.x), bflo(up2.y), bfhi(up2.y)}; const f32x4 dc = *(const f32x4*)(GDEC + ((size_t)bh * 64 + n) * 128 + 4 * d4);
            u32x2 o; o.x = cvtpk(st.x, st.y); o.y = cvtpk(st.z, st.w); *(u32x2*)(SPT + base + (size_t)n * 256 * 128) = o;
            st = dc * st + uu; }
    }
}
__device__ __forceinline__ void phase_gla_out(Frame& F, const Args& a, int l) {
    const bf16_t* PROJ = (const bf16_t*)(F.ws + WS_PROJ); const float* SMALL = (const float*)(F.ws + WS_SMALL); const bf16_t* SPT = (const bf16_t*)(F.ws + WS_SPREVT);
    fp8_t* BRCAT = (fp8_t*)(F.ws + WS_BRCAT);
    const float* w2 = a.in[4] + (size_t)l * 16 * 512; const float* b2 = a.in[5] + (size_t)l * 512; const float* normg = a.in[6] + (size_t)l * 256;
    const int w = F.wave;
    constexpr int SSO = 6144, QE = 8192, KE = 24576, VOFF = 40960;
    LAS float* SS = (LAS float*)(F.lds + SSO);
    u32x4 pq[2], pk[2], pv[4];
    auto ldqkv = [&](int uu) { const int bh2 = uu >> 6, n2 = uu & 63, bi2 = bh2 >> 2, h2 = bh2 & 3; const size_t tt = (size_t)bi2 * SEQ + 64 * n2;
#pragma unroll
        for (int i = 0; i < 2; ++i) { const int cid = F.tid + 512 * i, row = cid >> 4, ch = cid & 15; pq[i] = *(const u32x4*)(PROJ + (tt + row) * NPROJ + PQ_GQ + h2 * 128 + 8 * ch); pk[i] = *(const u32x4*)(PROJ + (tt + row) * NPROJ + PQ_GK + h2 * 128 + 8 * ch); }
#pragma unroll
        for (int i = 0; i < 4; ++i) { const int cid = F.tid + 512 * i, row = cid >> 5, c32 = cid & 31; pv[i] = *(const u32x4*)(PROJ + (tt + row) * NPROJ + PQ_GV + h2 * 256 + 8 * c32); } };
    if (F.bid < 1024) ldqkv(F.bid);
    for (int u = F.bid; u < 1024; u += F.G) {
        const int bh = u >> 6, n = u & 63, b = bh >> 2, h = bh & 3; const size_t t0 = (size_t)b * SEQ + 64 * n;
        int tid_ = F.tid; asm volatile("" : "+v"(tid_));
        const int tid = tid_, lane = tid & 63, d = tid & 127, g4 = tid >> 7, r32 = lane & 31, hh = lane >> 5;
        bf16x8 spf[8]; u32x2 rvp[2][4];
        {   const bf16_t* sp = SPT + (((size_t)bh * 64 + n) * 256 + 32 * w + r32) * 128 + 8 * hh;
#pragma unroll
            for (int ks = 0; ks < 8; ++ks) spf[ks] = *(const bf16x8*)(sp + 16 * ks);
#pragma unroll
            for (int qb = 0; qb < 2; ++qb)
#pragma unroll
                for (int g = 0; g < 4; ++g) rvp[qb][g] = *(const u32x2*)(PROJ + (t0 + 32 * qb + r32) * NPROJ + PQ_GR + h * 256 + 32 * w + 8 * g + 4 * hh); }
        __syncthreads();
        float bc[16], btot;
#pragma unroll
        for (int i = 0; i < 2; ++i) { const int cid = F.tid + 512 * i, row = cid >> 4, ch = cid & 15; *(LAS u32x4*)(F.lds + QE + offb(row, ch)) = pq[i]; *(LAS u32x4*)(F.lds + KE + offb(row, ch)) = pk[i]; }
#pragma unroll
        for (int i = 0; i < 4; ++i) { const int cid = F.tid + 512 * i, row = cid >> 5, c32 = cid & 31; *(LAS u32x4*)(F.lds + VOFF + (c32 >> 4) * 16384 + offb(row, c32 & 15)) = pv[i]; }
        gla_gates(F, SMALL, w2, b2, h, t0, bc, btot);
#pragma unroll
        for (int i = 0; i < 16; ++i) { const int pos = 16 * g4 + i; const float eb = fast_exp(bc[i]), reb = __builtin_amdgcn_rcpf(eb);
            LAS unsigned short* qa = (LAS unsigned short*)(F.lds + QE + offb(pos, d >> 3) + 2 * (d & 7)); LAS unsigned short* ka = (LAS unsigned short*)(F.lds + KE + offb(pos, d >> 3) + 2 * (d & 7));
            const float qv = bf2f(*qa) * 0.08838834764831845f * eb, kv = bf2f(*ka) * reb;
            *qa = f2bf(qv); *ka = f2bf(kv); }
        __syncthreads();
        f32x16 att[2][2];
#pragma unroll
        for (int sb = 0; sb < 2; ++sb)
#pragma unroll
            for (int qb = 0; qb < 2; ++qb)
#pragma unroll
                for (int i = 0; i < 16; ++i) att[sb][qb][i] = 0.f;
#pragma unroll
        for (int ks = 0; ks < 8; ++ks) { const bf16x8 k0 = frag_row(F.lds + KE, 0, ks, lane), k1 = frag_row(F.lds + KE, 32, ks, lane), q0 = frag_row(F.lds + QE, 0, ks, lane), q1 = frag_row(F.lds + QE, 32, ks, lane);
            att[0][0] = MFMA32(k0, q0, att[0][0]); att[0][1] = MFMA32(k0, q1, att[0][1]); att[1][0] = MFMA32(k1, q0, att[1][0]); att[1][1] = MFMA32(k1, q1, att[1][1]); }
#pragma unroll
        for (int sb = 0; sb < 2; ++sb)
#pragma unroll
            for (int qb = 0; qb < 2; ++qb)
#pragma unroll
                for (int i = 0; i < 16; ++i) { const int sp = 32 * sb + crow(i, hh), qp = 32 * qb + r32; if (sp > qp) att[sb][qb][i] = 0.f; }
        f32x16 o[2];
#pragma unroll
        for (int qb = 0; qb < 2; ++qb)
#pragma unroll
            for (int i = 0; i < 16; ++i) o[qb][i] = 0.f;
#pragma unroll
        for (int ks = 0; ks < 4; ++ks) { const bf16x8 va = frag_tr<true>(F.lds + VOFF + (w >> 2) * 16384, w & 3, 16 * ks, lane);
#pragma unroll
            for (int qb = 0; qb < 2; ++qb) { const bf16x8 pf = pack_acc(att[ks >> 1][qb], ks & 1); o[qb] = MFMA32(va, pf, o[qb]); } }
#pragma unroll
        for (int ks = 0; ks < 8; ++ks) {
#pragma unroll
            for (int qb = 0; qb < 2; ++qb) { const bf16x8 qf = frag_row(F.lds + QE, 32 * qb, ks, lane); o[qb] = MFMA32(spf[ks], qf, o[qb]); } }
        f32x4 gnv[4];
#pragma unroll
        for (int g = 0; g < 4; ++g) gnv[g] = *(const f32x4*)(normg + 32 * w + 8 * g + 4 * hh);
        { const int un = u + F.G; ldqkv(un < 1024 ? un : u); }
#pragma unroll
        for (int qb = 0; qb < 2; ++qb) { float ss = 0.f;
#pragma unroll
            for (int i = 0; i < 16; ++i) ss += o[qb][i] * o[qb][i];
            ss = x32_sum(ss);
            if (hh == 0) SS[w * 64 + 32 * qb + r32] = ss; }
        __syncthreads();
#pragma unroll
        for (int qb = 0; qb < 2; ++qb) { float tot = 0.f;
#pragma unroll
            for (int q = 0; q < 8; ++q) tot += SS[q * 64 + 32 * qb + r32];
            const float rstd = __builtin_amdgcn_rsqf(tot * (1.0f / 256.0f) + EPS);
            const size_t t = t0 + 32 * qb + r32;
#pragma unroll
            for (int g = 0; g < 4; ++g) { const int e0 = 32 * w + 8 * g + 4 * hh; const f32x4 gn = gnv[g];
                const u32x2 rv = rvp[qb][g];
                const float y0 = o[qb][4 * g] * rstd * gn.x * siluf_(bflo(rv.x)), y1 = o[qb][4 * g + 1] * rstd * gn.y * siluf_(bfhi(rv.x));
                const float y2 = o[qb][4 * g + 2] * rstd * gn.z * siluf_(bflo(rv.y)), y3 = o[qb][4 * g + 3] * rstd * gn.w * siluf_(bfhi(rv.y));
                *(unsigned*)(BRCAT + t * 3072 + 1024 + h * 256 + e0) = pk4_fp8(y0, y1, y2, y3); } }
    }
}

constexpr int SD_DT = 0, SD_ACS = 2048, SD_WT = 4096, SD_SSX = 4352, SD_XT = 8192, SD_BT = 73728, SD_CT = 106496;
__device__ __forceinline__ void ssd_tables(Frame& F, const Args& a, int l, const float* SMALL, int g, size_t t0, int tid) {
    LAS float* DT = (LAS float*)(F.lds + SD_DT); LAS float* ACS = (LAS float*)(F.lds + SD_ACS); LAS float* WT = (LAS float*)(F.lds + SD_WT);
    const int lane = tid & 63, hq = tid >> 7, pos = tid & 127, hd = 4 * g + hq;
    const float raw = SMALL[(t0 + pos) * 32 + 16 + hd] + a.in[9][l * 16 + hd];
    const float dt = raw > 20.f ? raw : logf(1.0f + expf(raw));
    const float A = -expf(a.in[10][l * 16 + hd]);
    float incl = wave_scan_f(dt * A, lane);
    if (lane == 63) WT[F.wave] = incl;
    __syncthreads();
    if (F.wave & 1) incl += WT[F.wave - 1];
    DT[hq * 128 + pos] = dt; ACS[hq * 128 + pos] = incl;
    __syncthreads();
}
struct SsdRows { u32x4 r[19]; };
template <int MODE> __device__ __forceinline__ void ssd_conv_load(SsdRows& R, const bf16_t* PROJ, int g, int n, size_t t0, int tid) {
    const int cg = tid & 63, seg = tid >> 6, pos0 = 16 * seg;
    const int cc0 = cg < 32 ? g * 256 + 8 * cg : (cg < 48 ? 1024 + g * 128 + 8 * (cg - 32) : 1536 + g * 128 + 8 * (cg - 48));
    const bf16_t* src = PROJ + (t0 + pos0) * NPROJ + PQ_SX + cc0;
    const bool havehalo = (n > 0) || (seg > 0);
#pragma unroll
    for (int p = 0; p < 19; ++p) { if ((p >= 3 || havehalo) && !(MODE == 0 && cg >= 48)) R.r[p] = *(const u32x4*)(src + (ptrdiff_t)(p - 3) * NPROJ); else R.r[p] = (u32x4){0u, 0u, 0u, 0u}; }
}
template <int MODE> __device__ __forceinline__ void ssd_conv(Frame& F, const Args& a, int l, const SsdRows& R, int g, int tid) {
    const LAS float* DT = (const LAS float*)(F.lds + SD_DT); const LAS float* ACS = (const LAS float*)(F.lds + SD_ACS);
    const int cg = tid & 63, seg = tid >> 6, pos0 = 16 * seg;
    if (MODE == 0 && cg >= 48) return;
    int cc0, row0; LAS unsigned char* img;
    if (cg < 32) { cc0 = g * 256 + 8 * cg; img = F.lds + SD_XT; row0 = 8 * cg; }
    else if (cg < 48) { cc0 = 1024 + g * 128 + 8 * (cg - 32); img = F.lds + SD_BT; row0 = 8 * (cg - 32); }
    else { cc0 = 1536 + g * 128 + 8 * (cg - 48); img = F.lds + SD_CT; row0 = 8 * (cg - 48); }
    const float* cw = a.in[7] + (size_t)l * 4 * 2048 + cc0; const float* cbp = a.in[8] + (size_t)l * 2048 + cc0;
    float wt[4][8], cb[8];
#pragma unroll
    for (int j = 0; j < 4; ++j) { const f32x4 w0 = *(const f32x4*)(cw + 2048 * j), w1 = *(const f32x4*)(cw + 2048 * j + 4); wt[j][0] = w0.x; wt[j][1] = w0.y; wt[j][2] = w0.z; wt[j][3] = w0.w; wt[j][4] = w1.x; wt[j][5] = w1.y; wt[j][6] = w1.z; wt[j][7] = w1.w; }
    {   const f32x4 b0 = *(const f32x4*)cbp, b1 = *(const f32x4*)(cbp + 4); cb[0] = b0.x; cb[1] = b0.y; cb[2] = b0.z; cb[3] = b0.w; cb[4] = b1.x; cb[5] = b1.y; cb[6] = b1.z; cb[7] = b1.w; }
    const int hq = cg >> 3;
    const float alast = (MODE == 0 && cg < 32) ? ACS[hq * 128 + 127] : 0.f;
    float sc[16];
#pragma unroll
    for (int p = 0; p < 16; ++p) { sc[p] = 1.0f; if (cg < 32) { sc[p] = DT[hq * 128 + pos0 + p]; if (MODE == 0) sc[p] *= fast_exp(alast - ACS[hq * 128 + pos0 + p]); } }
#pragma unroll
    for (int c = 0; c < 8; ++c) {
        float y[16];
#pragma unroll
        for (int p = 0; p < 16; ++p) { float v = cb[c];
#pragma unroll
            for (int j = 0; j < 4; ++j) { const unsigned wv = R.r[p + j][c >> 1]; v += wt[j][c] * ((c & 1) ? bfhi(wv) : bflo(wv)); }
            y[p] = siluf_(v) * sc[p]; }
        u32x4 o0, o1; o0.x = cvtpk(y[0], y[1]); o0.y = cvtpk(y[2], y[3]); o0.z = cvtpk(y[4], y[5]); o0.w = cvtpk(y[6], y[7]);
        o1.x = cvtpk(y[8], y[9]); o1.y = cvtpk(y[10], y[11]); o1.z = cvtpk(y[12], y[13]); o1.w = cvtpk(y[14], y[15]);
        *(LAS u32x4*)(img + offb(row0 + c, 2 * seg)) = o0; *(LAS u32x4*)(img + offb(row0 + c, 2 * seg + 1)) = o1; }
}
__device__ __forceinline__ void phase_ssd_local(Frame& F, const Args& a, int l) {
    const bf16_t* PROJ = (const bf16_t*)(F.ws + WS_PROJ); const float* SMALL = (const float*)(F.ws + WS_SMALL);
    bf16_t* STATES = (bf16_t*)(F.ws + WS_STATES); float* ALAST = (float*)(F.ws + WS_ALAST);
    const int w = F.wave;
    SsdRows R;
    if (F.bid < 512) { const int u0 = F.bid; ssd_conv_load<0>(R, PROJ, u0 & 3, (u0 >> 2) & 31, (size_t)(u0 >> 7) * SEQ + 128 * ((u0 >> 2) & 31), F.tid); }
    for (int u = F.bid; u < 512; u += F.G) {
        const int b = u >> 7, n = (u >> 2) & 31, g = u & 3; const size_t t0 = (size_t)b * SEQ + 128 * n;
        int tid_ = F.tid; asm volatile("" : "+v"(tid_));
        __syncthreads();
        ssd_tables(F, a, l, SMALL, g, t0, tid_);
        ssd_conv<0>(F, a, l, R, g, tid_);
        { const int un = (u + F.G < 512) ? u + F.G : u; ssd_conv_load<0>(R, PROJ, un & 3, (un >> 2) & 31, (size_t)(un >> 7) * SEQ + 128 * ((un >> 2) & 31), tid_); }
        if (F.tid < 4) ALAST[((size_t)b * 32 + n) * 16 + 4 * g + F.tid] = ((const LAS float*)(F.lds + SD_ACS))[F.tid * 128 + 127];
        __syncthreads();
        int ln = F.lane; asm volatile("" : "+v"(ln));
        const int lane = ln, r32 = lane & 31, hh = lane >> 5;
        const int hd = w >> 1, pb = w & 1;
        f32x16 acc[4];
#pragma unroll
        for (int sb = 0; sb < 4; ++sb)
#pragma unroll
            for (int i = 0; i < 16; ++i) acc[sb][i] = 0.f;
#pragma unroll
        for (int ks = 0; ks < 8; ++ks) { const bf16x8 xa = frag_row(F.lds + SD_XT, 64 * hd + 32 * pb, ks, lane);
#pragma unroll
            for (int sb = 0; sb < 4; ++sb) { const bf16x8 bb = frag_row(F.lds + SD_BT, 32 * sb, ks, lane); acc[sb] = MFMA32(xa, bb, acc[sb]); } }
        bf16_t* sp = STATES + ((((size_t)b * 32 + n) * 16 + 4 * g + hd) * 64) * 128;
#pragma unroll
        for (int sb = 0; sb < 4; ++sb)
#pragma unroll
            for (int i = 0; i < 16; ++i) sp[(size_t)(32 * pb + crow(i, hh)) * 128 + 32 * sb + r32] = (bf16_t)(cvtpk(acc[sb][i], 0.f) & 0xffffu);
    }
}
__device__ __forceinline__ void phase_ssd_scan(Frame& F) {
    const bf16_t* STATES = (const bf16_t*)(F.ws + WS_STATES); const float* ALAST = (const float*)(F.ws + WS_ALAST); bf16_t* SPV = (bf16_t*)(F.ws + WS_SPREV);
    for (int idx = F.bid * NTHR + F.tid; idx < 4 * 16 * 64 * 32; idx += F.G * NTHR) {
        const int b = idx >> 15, hd = (idx >> 11) & 15, ps = idx & 2047;
        f32x4 st = {0.f, 0.f, 0.f, 0.f};
#pragma unroll 8
        for (int n = 0; n < 32; ++n) { const size_t off = ((((size_t)b * 32 + n) * 16 + hd) * 64) * 128 + 4 * ps;
            const u32x2 up2 = *(const u32x2*)(STATES + off); const f32x4 uu = {bflo(up2.x), bfhi(up2.x), bflo(up2.y), bfhi(up2.y)}; const float dc = fast_exp(ALAST[((size_t)b * 32 + n) * 16 + hd]);
            u32x2 o; o.x = cvtpk(st.x, st.y); o.y = cvtpk(st.z, st.w); *(u32x2*)(SPV + off) = o;
            st = st * dc + uu; }
    }
}
__device__ __forceinline__ void phase_ssd_out(Frame& F, const Args& a, int l) {
    const bf16_t* PROJ = (const bf16_t*)(F.ws + WS_PROJ); const float* SMALL = (const float*)(F.ws + WS_SMALL); const bf16_t* SPV = (const bf16_t*)(F.ws + WS_SPREV);
    fp8_t* BRCAT = (fp8_t*)(F.ws + WS_BRCAT);
    const float* normg = a.in[12] + (size_t)l * 1024;
    const int w = F.wave, lb = w & 3, hp = w >> 2;
    const LAS float* DT = (const LAS float*)(F.lds + SD_DT); const LAS float* ACS = (const LAS float*)(F.lds + SD_ACS); LAS float* SSX = (LAS float*)(F.lds + SD_SSX);
    for (int u = F.bid; u < 512; u += F.G) {
        const int b = u >> 7, n = (u >> 2) & 31, g = u & 3; const size_t t0 = (size_t)b * SEQ + 128 * n;
        int tid_ = F.tid; asm volatile("" : "+v"(tid_));
        SsdRows R; ssd_conv_load<1>(R, PROJ, g, n, t0, tid_);
        __syncthreads();
        ssd_tables(F, a, l, SMALL, g, t0, tid_);
        ssd_conv<1>(F, a, l, R, g, tid_);
        __syncthreads();
        int ln = F.lane; asm volatile("" : "+v"(ln));
        const int lane = ln, r32 = lane & 31, hh = lane >> 5, lpos = 32 * lb + r32;
        f32x16 y[2][2];
#pragma unroll
        for (int hi = 0; hi < 2; ++hi)
#pragma unroll
            for (int pb = 0; pb < 2; ++pb)
#pragma unroll
                for (int i = 0; i < 16; ++i) y[hi][pb][i] = 0.f;
        {   const bf16_t* sp0 = SPV + (((((size_t)b * 32 + n) * 16 + 4 * g + 2 * hp) * 64) + r32) * 128 + 8 * hh;
#pragma unroll
            for (int ks = 0; ks < 8; ++ks) { const bf16x8 cf = frag_tr<false>(F.lds + SD_CT, lb, 16 * ks, lane);
#pragma unroll
                for (int hi = 0; hi < 2; ++hi)
#pragma unroll
                    for (int pb = 0; pb < 2; ++pb) { const bf16x8 sa = *(const bf16x8*)(sp0 + (size_t)(hi * 64 + 32 * pb) * 128 + 16 * ks); y[hi][pb] = MFMA32(sa, cf, y[hi][pb]); } }
        }
        float acl[2];
#pragma unroll
        for (int hi = 0; hi < 2; ++hi) { acl[hi] = ACS[(2 * hp + hi) * 128 + lpos]; const float ea = fast_exp(acl[hi]);
#pragma unroll
            for (int pb = 0; pb < 2; ++pb)
#pragma unroll
                for (int i = 0; i < 16; ++i) y[hi][pb][i] *= ea; }
#pragma unroll 1
        for (int mb = 0; mb <= lb; ++mb) {
            f32x16 cbt;
#pragma unroll
            for (int i = 0; i < 16; ++i) cbt[i] = 0.f;
#pragma unroll
            for (int ks = 0; ks < 8; ++ks) { const bf16x8 bf = frag_tr<false>(F.lds + SD_BT, mb, 16 * ks, lane), cf = frag_tr<false>(F.lds + SD_CT, lb, 16 * ks, lane); cbt = MFMA32(bf, cf, cbt); }
#pragma unroll
            for (int hi = 0; hi < 2; ++hi) { const int hq = 2 * hp + hi;
                f32x16 mt;
#pragma unroll
                for (int i = 0; i < 16; ++i) { const int m = 32 * mb + crow(i, hh); const float am = ACS[hq * 128 + m]; mt[i] = (m <= lpos) ? cbt[i] * fast_exp(acl[hi] - am) : 0.f; }
#pragma unroll
                for (int half = 0; half < 2; ++half) { const bf16x8 mf = pack_acc(mt, half);
                    const int ksx = 2 * mb + half;
#pragma unroll
                    for (int pb = 0; pb < 2; ++pb) { const int row = 64 * hq + 32 * pb + r32;
                        const s16x4 lo = *(const LAS s16x4*)(F.lds + SD_XT + offb(row, 2 * ksx) + 8 * hh), hi4 = *(const LAS s16x4*)(F.lds + SD_XT + offb(row, 2 * ksx + 1) + 8 * hh);
                        const bf16x8 xa = __builtin_shufflevector(lo, hi4, 0, 1, 2, 3, 4, 5, 6, 7);
                        y[hi][pb] = MFMA32(xa, mf, y[hi][pb]); } } }
        }
        float ssq = 0.f;
#pragma unroll
        for (int hi = 0; hi < 2; ++hi) { const int hq = 2 * hp + hi, hd = 4 * g + hq;
            const float dsk = a.in[11][l * 16 + hd] * __builtin_amdgcn_rcpf(DT[hq * 128 + lpos]);
#pragma unroll
            for (int pb = 0; pb < 2; ++pb)
#pragma unroll
                for (int gq = 0; gq < 4; ++gq) { const int p0 = 32 * pb + 8 * gq + 4 * hh;
                    const u32x2 zv = *(const u32x2*)(PROJ + (t0 + lpos) * NPROJ + PQ_SZ + hd * 64 + p0);
                    const float zz[4] = {bflo(zv.x), bfhi(zv.x), bflo(zv.y), bfhi(zv.y)};
#pragma unroll
                    for (int jj = 0; jj < 4; ++jj) { const int row = 64 * hq + p0 + jj;
                        const float xd = bf2f(*(const LAS unsigned short*)(F.lds + SD_XT + offb(row, lpos >> 3) + 2 * (lpos & 7)));
                        float v = y[hi][pb][4 * gq + jj] + xd * dsk; v *= siluf_(zz[jj]); y[hi][pb][4 * gq + jj] = v; ssq += v * v; } }
        }
        ssq = x32_sum(ssq);
        if (hh == 0) SSX[(hp * 4 + lb) * 32 + r32] = ssq;
        __syncthreads();
        const float rstd = __builtin_amdgcn_rsqf((SSX[lb * 32 + r32] + SSX[(4 + lb) * 32 + r32]) * (1.0f / 256.0f) + EPS);
#pragma unroll
        for (int hi = 0; hi < 2; ++hi) { const int hq = 2 * hp + hi;
#pragma unroll
            for (int pb = 0; pb < 2; ++pb)
#pragma unroll
                for (int gq = 0; gq < 4; ++gq) { const int p0 = 32 * pb + 8 * gq + 4 * hh, ch = g * 256 + hq * 64 + p0; const f32x4 gn = *(const f32x4*)(normg + ch);
                    *(unsigned*)(BRCAT + (t0 + lpos) * 3072 + 2048 + ch) = pk4_fp8(y[hi][pb][4 * gq] * rstd * gn.x, y[hi][pb][4 * gq + 1] * rstd * gn.y, y[hi][pb][4 * gq + 2] * rstd * gn.z, y[hi][pb][4 * gq + 3] * rstd * gn.w); } }
    }
}

__device__ __forceinline__ void phase_small(Frame& F, const bf16_t* xsb) {
    const bf16_t* SM = (const bf16_t*)(F.ws + WS_SM); float* SMALL = (float*)(F.ws + WS_SMALL);
    const int li = F.lane & 15, lq = F.lane >> 4, w = F.wave, kh = w >> 2;
    LAS float* red = (LAS float*)F.lds;
    for (int tb = F.bid; tb < T / 64; tb += F.G) {
        const int task = 4 * tb + (w & 3);
        const bf16_t* w0 = SM + (size_t)li * D + 1024 * kh + 8 * lq; const bf16_t* w1 = SM + (size_t)(16 + li) * D + 1024 * kh + 8 * lq; const bf16_t* xp = xsb + (size_t)(task * 16 + li) * D + 1024 * kh + 8 * lq;
        f32x4 c0 = {0.f, 0.f, 0.f, 0.f}, c1 = {0.f, 0.f, 0.f, 0.f};
#pragma unroll 8
        for (int ks = 0; ks < 32; ++ks) { const bf16x8 av = *(const bf16x8*)(xp + 32 * ks), b0 = *(const bf16x8*)(w0 + 32 * ks), b1 = *(const bf16x8*)(w1 + 32 * ks);
            c0 = __builtin_amdgcn_mfma_f32_16x16x32_bf16(av, b0, c0, 0, 0, 0); c1 = __builtin_amdgcn_mfma_f32_16x16x32_bf16(av, b1, c1, 0, 0, 0); }
        __syncthreads();
        if (kh == 1) { *(LAS f32x4*)(red + ((w & 3) * 64 + F.lane) * 8) = c0; *(LAS f32x4*)(red + ((w & 3) * 64 + F.lane) * 8 + 4) = c1; }
        __syncthreads();
        if (kh == 0) { c0 += *(const LAS f32x4*)(red + (w * 64 + F.lane) * 8); c1 += *(const LAS f32x4*)(red + (w * 64 + F.lane) * 8 + 4);
#pragma unroll
            for (int r = 0; r < 4; ++r) { SMALL[(size_t)(task * 16 + 4 * lq + r) * 32 + li] = c0[r]; SMALL[(size_t)(task * 16 + 4 * lq + r) * 32 + 16 + li] = c1[r]; } }
    }
    __syncthreads();
}

constexpr int PPL = 13, NPH = PPL * DEPTH;
constexpr int NCVT = 96;
#ifndef CV_DEFER
#define CV_DEFER 49920
#endif
#ifndef MK_ONE_LAUNCH
#define MK_ONE_LAUNCH 1
#endif
#ifndef PH_MASK
#define PH_MASK 0x1fff
#endif
#ifndef REP_MASK
#define REP_MASK 0
#endif
#ifndef REP_SUB
#define REP_SUB 0
#endif
#ifndef SUB_MASK
#define SUB_MASK 0xff
#endif
__global__ void __launch_bounds__(NTHR, 2) fwd(Args a) {
    extern __shared__ __attribute__((aligned(16))) unsigned char lds_raw[];
    Frame F;
    const int wave0 = __builtin_amdgcn_readfirstlane((int)threadIdx.x >> 6);
    F.lds = (LAS unsigned char*)lds_raw; F.ws = a.ws; F.G = gridDim.x; F.bid = blockIdx.x; F.wave = wave0; F.lane = lane_id(); F.tid = wave0 * 64 + F.lane;
    volatile LAS unsigned* MISCW = (volatile LAS unsigned*)(F.lds + MISC_OFF);
    for (int u = F.tid; u < (LDS_BYTES - LDSCTL_OFF) / 4; u += NTHR) ((LAS unsigned*)(F.lds + LDSCTL_OFF))[u] = 0u;
    __syncthreads();
    unsigned* barw = (unsigned*)(a.ws + WS_CTL) + CW_BAR;
    XcdBarrier bar; bar.bar = barw; bar.x = 0; bar.st = MISCW + 8;
    const int lo = a.ph_lo, hi = a.ph_hi;
    if (hi - lo > 1) bar = xcd_barrier_post(barw, MISCW + 8, F.tid == 0);
#define SUB(k) ((SUB_MASK >> (k)) & 1)
#define IN(k) (((PH_MASK >> (k)) & 1) && lo <= p0 + (k) && p0 + (k) < hi)
#define PH_BEGIN() int ln_ = lane_id(), b_ = blockIdx.x; asm volatile("" : "+v"(ln_), "+s"(b_)); F.lane = ln_; F.wave = wave0; F.tid = wave0 * 64 + ln_; F.bid = b_; \
    const Args al = load_args(a); F.ws = al.ws
#define SEAM(k) do { if (IN(k) && p0 + (k) + 1 < hi) xcd_barrier(bar, wave0 == 0 && lane_id() == 0); } while (0)
#define WSP(T_, off) ((T_*)(F.ws + (off)))
    for (int l = 0; l < DEPTH; ++l) {
        const int p0 = l * PPL;
        if (IN(0)) { PH_BEGIN(); phase_convert(F, al, l, 0, CV_NITEMS - CV_DEFER, F.bid * NWAVES + F.wave, F.G * NWAVES, l == 0); }
        SEAM(0);
        if (IN(1)) {
            PH_BEGIN();
            if (SUB(5)) phase_small(F, WSP(const bf16_t, WS_XRES));
            {   pg8::Gemm g{WSP(const fp8_t, WS_XB), WSP(const fp8_t, WS_WIN), D, nullptr}; pg8::StaticOrder S; S.init(T, NPROJ, F.G, F.bid);
                pg8::EpiBf16 E{WSP(bf16_t, WS_PROJ), NPROJ, 0};
                pg8::gemm_phase<pg8::EpiBf16, pg8::StaticOrder, false>(F.lds, g, S, E, F.tid); }
            {   pg8::Gemm g{WSP(const fp8_t, WS_XB), WSP(const fp8_t, WS_WIN) + (size_t)NPROJ * D, D, nullptr}; pg8::StaticOrder S; S.init(T, NGATE, F.G, F.bid);
                pg8::EpiGate E{WSP(unsigned char, WS_G8)};
                pg8::gemm_phase<pg8::EpiGate, pg8::StaticOrder, false>(F.lds, g, S, E, F.tid); }
        }
        SEAM(1);
        if (IN(2)) { PH_BEGIN();
            if (SUB(0) && (al.sub & 1)) {
                if (CV_DEFER > 0 && F.bid >= F.G - NCVT) phase_convert_experts(F, al, l, 65 * 768 - CV_DEFER, 65 * 768, (F.bid - (F.G - NCVT)) * NWAVES + F.wave, NCVT * NWAVES);
                phase_attn(F, al, l);
                { int ln2 = lane_id(); asm volatile("" : "+v"(ln2)); F.lane = ln2; F.tid = wave0 * 64 + ln2; } }
            if (SUB(1) && (al.sub & 2)) phase_gla_local(F, al, l); if (SUB(2) && (al.sub & 4)) phase_ssd_local(F, al, l); }
        SEAM(2);
        if (IN(3)) { PH_BEGIN(); phase_gla_scan(F); phase_ssd_scan(F); }
        SEAM(3);
        if (IN(4)) { PH_BEGIN(); if (SUB(3) && (al.sub & 8)) phase_gla_out(F, al, l); if (SUB(4) && (al.sub & 16)) phase_ssd_out(F, al, l); }
        SEAM(4);
        if (IN(5)) {
            PH_BEGIN();
            pg8::Gemm g{WSP(const fp8_t, WS_BRCAT), WSP(const fp8_t, WS_WBR), 3072, nullptr}; pg8::StaticOrder S; S.init(T, D, F.G, F.bid);
            pg8::EpiMerge E{WSP(const unsigned char, WS_G8), WSP(fp8_t, WS_MERGED)};
            pg8::gemm_phase<pg8::EpiMerge, pg8::StaticOrder, false>(F.lds, g, S, E, F.tid);
        }
        SEAM(5);
        if (IN(6)) {
            PH_BEGIN();
            pg8::Gemm g{WSP(const fp8_t, WS_MERGED), WSP(const fp8_t, WS_WOUT), D, nullptr}; pg8::StaticOrder S; S.init(T, D, F.G, F.bid);
            pg8::EpiWout E{WSP(const bf16_t, WS_XRES), WSP(bf16_t, WS_H)};
            pg8::gemm_phase<pg8::EpiWout, pg8::StaticOrder, false>(F.lds, g, S, E, F.tid);
        }
        SEAM(6);
        if (!FUSE_LN1) { if (IN(7)) { PH_BEGIN(); phase_ln1(F, al, l); }
            SEAM(7); }
        if (IN(8)) { PH_BEGIN(); phase_router(F, al, l); }
        SEAM(8);
        if (IN(9)) { PH_BEGIN(); phase_lists(F); }
        SEAM(9);
        if (IN(10)) {
            PH_BEGIN();
            const int nblk = __builtin_amdgcn_readfirstlane(WSP(const int, WS_MISC + MS_NBLK)[0]);
            moe_fill<true>(F, nblk, 4);
            pg8::Gemm g{WSP(const fp8_t, WS_X1B), WSP(const fp8_t, WS_EXP1), D, (const LAS int*)(F.lds + MOE_TOKL)}; MoeOrder2 S{(const LAS int*)(F.lds + MOE_BLKL), nblk, 4, F.G, F.bid};
            pg8::EpiSwiglu E{WSP(fp8_t, WS_HS), EDIM};
            pg8::gemm_phase<pg8::EpiSwiglu, MoeOrder2, true>(F.lds, g, S, E, F.tid);
        }
        SEAM(10);
        if (IN(11)) {
            PH_BEGIN();
            const int nblk = __builtin_amdgcn_readfirstlane(WSP(const int, WS_MISC + MS_NBLK)[0]);
            moe_fill<false>(F, nblk, 8);
            pg8::Gemm g{WSP(const fp8_t, WS_HS), WSP(const fp8_t, WS_EXP2), EDIM, nullptr}; MoeOrder2 S{(const LAS int*)(F.lds + MOE_BLKL), nblk, 8, F.G, F.bid};
            pg8::EpiFp8 E{WSP(fp8_t, WS_OS), D, 8};
            pg8::gemm_phase<pg8::EpiFp8, MoeOrder2, false>(F.lds, g, S, E, F.tid);
        }
        SEAM(11);
        if (IN(12)) { PH_BEGIN(); phase_combine(F, al, l); }
        SEAM(12);
    }
#undef IN
#undef SEAM
}

extern "C" void kernel_launch(void* const* d_in, const int* in_sizes, int n_in, void* d_out, int out_size, void* d_ws, size_t ws_size, hipStream_t stream) {
    static int grid = 0;
    if (grid == 0) {
        if (n_in != 27 || out_size != T * D || ws_size < WS_END) { fprintf(stderr, "kernel_launch: unexpected sizes n_in %d out %d ws %zu (need %zu)\n", n_in, out_size, ws_size, (size_t)WS_END); grid = -1; return; }
        int dev = 0, cus = 0, per_cu = 0;
        if (hipGetDevice(&dev) != hipSuccess || hipDeviceGetAttribute(&cus, hipDeviceAttributeMultiprocessorCount, dev) != hipSuccess) { grid = -1; return; }
        if (hipFuncSetAttribute((const void*)fwd, hipFuncAttributeMaxDynamicSharedMemorySize, LDS_BYTES) != hipSuccess) { fprintf(stderr, "kernel_launch: hipFuncSetAttribute failed\n"); grid = -1; return; }
        if (hipOccupancyMaxActiveBlocksPerMultiprocessor(&per_cu, (const void*)fwd, NTHR, LDS_BYTES) != hipSuccess || per_cu < 1) fprintf(stderr, "kernel_launch: occupancy query says %d\n", per_cu);
        (void)hipGetLastError();
        grid = cus;
    }
    if (grid < 0) return;
    if (hipMemsetAsync((char*)d_ws + WS_CTL, 0, CTL_ZERO_BYTES, stream) != hipSuccess) return;
    Args a{};
    for (int i = 0; i < 27; ++i) a.in[i] = (const float*)d_in[i];
    a.out = (float*)d_out; a.ws = (unsigned char*)d_ws; a.sub = 0xff; a.pad = 0;
#if MK_ONE_LAUNCH
    a.ph_lo = 0; a.ph_hi = NPH;
    hipLaunchKernelGGL(fwd, dim3(grid), dim3(NTHR), LDS_BYTES, stream, a);
#else
    for (int k = 0; k < NPH; ++k) { a.ph_lo = k; a.ph_hi = k + 1;
#ifdef HOTPROBE
#ifndef HOTPHASE
#define HOTPHASE 1
#endif
        if ((k % PPL) == HOTPHASE) { a.pad = HOTPROBE; hipLaunchKernelGGL(fwd, dim3(grid), dim3(NTHR), LDS_BYTES, stream, a); a.pad = 0; }
#endif
        const int reps = ((REP_MASK >> (k % PPL)) & 1) ? 2 : 1;
        for (int r = 0; r < reps; ++r) hipLaunchKernelGGL(fwd, dim3(grid), dim3(NTHR), LDS_BYTES, stream, a);
        if (REP_SUB && ((k % PPL) == 2 || (k % PPL) == 4)) { a.sub = REP_SUB; hipLaunchKernelGGL(fwd, dim3(grid), dim3(NTHR), LDS_BYTES, stream, a); a.sub = 0xff; } }
#endif
}
```

```cpp
#include <hip/hip_runtime.h>
#include <cstdio>
#include <cstdint>

#define LAS __attribute__((address_space(3)))
#define GAS __attribute__((address_space(1)))
typedef unsigned short bf16_t;
typedef short bf16x8 __attribute__((ext_vector_type(8)));
typedef short s16x4 __attribute__((ext_vector_type(4)));
typedef float f32x4 __attribute__((ext_vector_type(4)));
typedef float f32x2 __attribute__((ext_vector_type(2)));
typedef float f32x16 __attribute__((ext_vector_type(16)));
typedef unsigned u32x4 __attribute__((ext_vector_type(4)));
typedef unsigned u32x2 __attribute__((ext_vector_type(2)));
typedef GAS unsigned gu32;
typedef int i32x4 __attribute__((ext_vector_type(4)));
typedef int i32x8 __attribute__((ext_vector_type(8)));
typedef unsigned char fp8_t;
typedef float f32x2_ __attribute__((ext_vector_type(2)));
__device__ __forceinline__ void unpk4_fp8(unsigned w, float (&o)[4]) { const f32x2_ a = __builtin_amdgcn_cvt_pk_f32_fp8((int)w, false), b = __builtin_amdgcn_cvt_pk_f32_fp8((int)w, true); o[0] = a.x; o[1] = a.y; o[2] = b.x; o[3] = b.y; }
__device__ __forceinline__ float clamp448(float x) { return __builtin_amdgcn_fmed3f(x, -448.0f, 448.0f); }
__device__ __forceinline__ unsigned pk4_fp8(float a, float b, float c, float d) { int r = 0; r = __builtin_amdgcn_cvt_pk_fp8_f32(clamp448(a), clamp448(b), r, false); r = __builtin_amdgcn_cvt_pk_fp8_f32(clamp448(c), clamp448(d), r, true); return (unsigned)r; }
constexpr float OSCALE = 16.0f;
constexpr float WSCALE = 64.0f; constexpr int SC_W = 0x7c7c7c7c, SC_A = 0x7c7c7c7c;

__device__ __forceinline__ unsigned cvt_pk_bf16(float lo, float hi) { unsigned r; asm volatile("v_cvt_pk_bf16_f32 %0, %1, %2" : "=v"(r) : "v"(lo), "v"(hi)); return r; }
typedef __bf16 bf16x2_t __attribute__((ext_vector_type(2)));
__device__ __forceinline__ unsigned cvtpk(float lo, float hi) { f32x2 v = {lo, hi}; bf16x2_t b = __builtin_convertvector(v, bf16x2_t); return __builtin_bit_cast(unsigned, b); }
__device__ __forceinline__ float bf2f(unsigned short b) { return __uint_as_float(((unsigned)b) << 16); }
__device__ __forceinline__ float bflo(unsigned w) { return __uint_as_float(w << 16); }
__device__ __forceinline__ float bfhi(unsigned w) { return __uint_as_float(w & 0xffff0000u); }
__device__ __forceinline__ unsigned short f2bf(float f) { unsigned u = __float_as_uint(f); return (unsigned short)((u + 0x7fffu + ((u >> 16) & 1u)) >> 16); }
__device__ __forceinline__ float fast_exp(float x) { return __builtin_amdgcn_exp2f(x * 1.4426950408889634f); }
__device__ __forceinline__ float fast_log(float x) { return __builtin_amdgcn_logf(x) * 0.6931471805599453f; }
__device__ __forceinline__ float sigmoidf_(float x) { return __builtin_amdgcn_rcpf(1.0f + fast_exp(-x)); }
__device__ __forceinline__ float siluf_(float x) { return x * sigmoidf_(x); }

namespace pg8 {
constexpr int BM = 256, BK = 64, HALF = 128, HTB = HALF * BK * 2  , STAGE_BYTES = 8 * HTB, NXCD = 8, WGM = 8;

__host__ __device__ __forceinline__ int lds_byte(int r, int c) { const int st = (r >> 4) * 2 + (c >> 5), rr = r & 15, cc = c & 31, ob = rr * 64 + cc * 2; return st * 1024 + (ob ^ (((ob >> 9) & 1) << 5)); }
__host__ __device__ __forceinline__ void stage_rc(int b, int& R, int& C) { const int st = b / 1024, sb = b % 1024, swz = sb ^ (((sb >> 9) & 1) << 5); R = (st >> 1) * 16 + swz / 64; C = (st & 1) * 32 + (swz % 64) / 2; }
__host__ __device__ __forceinline__ int perm32(int rho) { const int n = rho >> 4, i = rho & 15; return 8 * (i >> 2) + 4 * n + (i & 3); }

struct Unit { int pm, pn; };
struct Gemm { const fp8_t* A; const fp8_t* Bt; int KB; const LAS int* gidx; };

struct StaticOrder {
    int nM, nN, nwg, G, c;
    __host__ __device__ void init(int M, int N, int G_, int c_) { nM = M / BM; nN = N / BM; nwg = nM * nN; G = G_; c = c_; }
    __host__ __device__ bool next(int i, Unit& u) const {
        const long L = (long)i * G + c; if (L >= nwg) return false;
        int wgid = (int)L; { const int q = nwg / NXCD, r = nwg % NXCD, xcd = wgid % NXCD, off = wgid / NXCD; wgid = (xcd < r ? xcd * (q + 1) : r * (q + 1) + (xcd - r) * q) + off; }
        const int nig = WGM * nN, gid = wgid / nig, fm = gid * WGM, gsz = (nM - fm) < WGM ? (nM - fm) : WGM;
        u.pm = fm + ((wgid % nig) % gsz); u.pn = (wgid % nig) / gsz; return true;
    }
};
struct MoeOrder {
    const int* blk_e; int nunits, NT, G, c;
    __device__ bool next(int i, Unit& u) const {
        const int L = i * G + c; if (L >= nunits) return false;
        const int j = L / NT, pl = L - j * NT; u.pm = j; u.pn = __builtin_amdgcn_readfirstlane(blk_e[j]) * NT + pl; return true;
    }
};

#ifndef PG8_ALIGN
#define PG8_ALIGN true
#endif
template <class E, class = void> struct epi_perm16 { static constexpr bool value = false; };
template <class E> struct epi_perm16<E, decltype((void)E::PERM16)> { static constexpr bool value = E::PERM16; };
template <class Epi, class Sched, bool GATHER, bool ALIGN_EPI = PG8_ALIGN>
__device__ __forceinline__ void gemm_phase(LAS unsigned char* lds, const Gemm g, const Sched& S, const Epi& E, int tid_in) {
    int tid_ = tid_in; asm volatile("" : "+v"(tid_));
    const int tid = tid_, wid = __builtin_amdgcn_readfirstlane(tid >> 6), lane = tid & 63, wr = wid >> 2, wc = wid & 3, fr = lane & 15, fq = lane >> 4;
    int KB_ = g.KB; asm volatile("" : "+s"(KB_));
    const int KB = KB_, nt = KB / 128;
    unsigned vA[2][2], vAn[2][2], voffB[2]; int Rl[2], Cl[2];
    const size_t hstep = (size_t)HALF * KB, q64 = (size_t)64 * KB;
    constexpr bool P16 = epi_perm16<Epi>::value;
    const size_t bhstep = P16 ? (size_t)8 * KB : hstep, qB = P16 ? (size_t)128 * KB : (size_t)64 * KB;
    const size_t tstep = 2 * hstep;
#pragma unroll
    for (int i = 0; i < 2; ++i) { int R, C; stage_rc(tid * 16 + i * 8192, R, C); const int Rb = P16 ? (64 * (R >> 5) + 16 * ((R & 15) >> 2) + 4 * ((R >> 4) & 1) + (R & 3)) : (Epi::PERM ? ((R & ~31) + perm32(R & 31)) : R); Rl[i] = R; Cl[i] = C;
        voffB[i] = (unsigned)(Rb * KB + 2 * C);
        vA[0][i] = (unsigned)(R * KB + 2 * C); vA[1][i] = (unsigned)((R + HALF) * KB + 2 * C); vAn[0][i] = vA[0][i]; vAn[1][i] = vA[1][i]; }
    const size_t kstep = (size_t)(BK * 2);
    const unsigned ldsw = (unsigned)wid * 1024u;
    const int aoff = lds_byte(wr * 64 + fr, fq * 8), boff = lds_byte(wc * 32 + fr, fq * 8);
#define PG8_SA(b, h) (((b) * 2 + (h)) * HTB)
#define PG8_SB(b, h) ((4 + (b) * 2 + (h)) * HTB)
#define PG8_STAGE(bufoff, gbase, voff) do { _Pragma("unroll") for (int _i = 0; _i < 2; ++_i) \
        __builtin_amdgcn_global_load_lds((const unsigned*)((const char*)(gbase) + (size_t)_i * q64 + (voff)[0]), (LAS unsigned*)(lds + (bufoff) + ldsw + _i * 8192), 16, 0, 0); } while (0)
#define PG8_STAGE_B(bufoff, gbase, voff) do { _Pragma("unroll") for (int _i = 0; _i < 2; ++_i) \
        __builtin_amdgcn_global_load_lds((const unsigned*)((const char*)(gbase) + (size_t)_i * qB + (voff)[0]), (LAS unsigned*)(lds + (bufoff) + ldsw + _i * 8192), 16, 0, 0); } while (0)
#define PG8_STAGE_G(bufoff, gbase, voff) do { _Pragma("unroll") for (int _i = 0; _i < 2; ++_i) \
        __builtin_amdgcn_global_load_lds((const unsigned*)((const char*)(gbase) + (voff)[_i]), (LAS unsigned*)(lds + (bufoff) + ldsw + _i * 8192), 16, 0, 0); } while (0)
#define PG8_STAGE_A(bufoff, gbase, vv, h) do { if constexpr (GATHER) PG8_STAGE_G(bufoff, gbase, (vv)[h]); else PG8_STAGE(bufoff, (gbase) + (size_t)(h) * hstep, (vv)[0]); } while (0)
#define PG8_CAT(x0, x1) __builtin_shufflevector((x0), (x1), 0, 1, 2, 3, 4, 5, 6, 7)
#define PG8_LDA(dst, b, h) do { _Pragma("unroll") for (int m = 0; m < 4; ++m) dst[m] = PG8_CAT(*(const LAS i32x4*)(lds + PG8_SA(b, h) + aoff + m * 2048), *(const LAS i32x4*)(lds + PG8_SA(b, h) + aoff + m * 2048 + 1024)); } while (0)
#define PG8_LDB(dst, b, h) do { _Pragma("unroll") for (int n = 0; n < 2; ++n) dst[n] = PG8_CAT(*(const LAS i32x4*)(lds + PG8_SB(b, h) + boff + n * 2048), *(const LAS i32x4*)(lds + PG8_SB(b, h) + boff + n * 2048 + 1024)); } while (0)
#define PG8_MMA(ai, bj, At, Bt) do { __builtin_amdgcn_s_setprio(1); _Pragma("unroll") for (int m = 0; m < 4; ++m) _Pragma("unroll") for (int n = 0; n < 2; ++n) \
        asm volatile("v_mfma_scale_f32_16x16x128_f8f6f4 %0, %1, %2, %0, %3, %3 op_sel_hi:[0,0,0]" : "+v"(acc[ai][bj][m][n]) : "v"(Bt[n]), "v"(At[m]), "v"(scv)); __builtin_amdgcn_s_setprio(0); } while (0)
#define PG8_WAIT_V(n) asm volatile("s_waitcnt vmcnt(" #n ")" ::: "memory")
#define PG8_WAIT_L(n) asm volatile("s_waitcnt lgkmcnt(" #n ")" ::: "memory")
#define PG8_BAR __builtin_amdgcn_s_barrier()
#define PG8_SCHED __builtin_amdgcn_sched_barrier(0)
#define PG8_GIDX(dst, ord) do { if constexpr (GATHER) { _Pragma("unroll") for (int _h = 0; _h < 2; ++_h) _Pragma("unroll") for (int _i = 0; _i < 2; ++_i) \
        dst[_h][_i] = (unsigned)g.gidx[(ord) * BM + _h * HALF + Rl[_i]] * (unsigned)KB + 2u * (unsigned)Cl[_i]; } } while (0)
    Unit cur, nxt; int ui = 0;
    if (!S.next(0, cur)) return;
    f32x4 acc[2][2][4][2];
#pragma unroll
    for (int a = 0; a < 2; ++a)
#pragma unroll
        for (int b = 0; b < 2; ++b)
#pragma unroll
            for (int m = 0; m < 4; ++m)
#pragma unroll
                for (int n = 0; n < 2; ++n) acc[a][b][m][n] = (f32x4){0.f, 0.f, 0.f, 0.f};
    i32x8 At[4], B0[2], B1[2];
    int scv = SC_W; asm volatile("" : "+v"(scv));
    PG8_GIDX(vA, 0);
    const char* cA = (const char*)g.A + (GATHER ? (size_t)0 : (size_t)cur.pm * tstep); const char* cB = (const char*)g.Bt + (size_t)cur.pn * tstep;
    PG8_STAGE_B(PG8_SB(0, 0), cB, voffB); PG8_STAGE_B(PG8_SB(0, 1), cB + bhstep, voffB); PG8_STAGE_A(PG8_SA(0, 0), cA, vA, 0); PG8_STAGE_A(PG8_SA(0, 1), cA, vA, 1);
    if (wr == 1) PG8_BAR;
    PG8_WAIT_V(2); PG8_BAR;
    PG8_STAGE_B(PG8_SB(1, 0), cB + kstep, voffB); PG8_STAGE_A(PG8_SA(1, 0), cA + kstep, vA, 0); PG8_STAGE_B(PG8_SB(1, 1), cB + bhstep + kstep, voffB);
    PG8_WAIT_V(6); PG8_BAR;
    for (;;) {
        const bool has_next = S.next(ui + 1, nxt);
        if (has_next) PG8_GIDX(vAn, ui + 1);
        const char* nA = has_next ? (const char*)g.A + (GATHER ? (size_t)0 : (size_t)nxt.pm * tstep) : cA; const char* nB = has_next ? (const char*)g.Bt + (size_t)nxt.pn * tstep : cB;
        constexpr int NSEG = Epi::HAS_MID ? 3 : 1; const int seglen = nt / NSEG;
        for (int seg = 0; seg < NSEG; ++seg) {
        if constexpr (Epi::HAS_MID) { if (seg > 0) { asm volatile("s_nop 15\n\ts_nop 15" ::: "memory"); E.mid(acc, cur, seg * Epi::MID0, wr, wc, fr, fq); asm volatile("s_nop 7" ::: "memory"); } }
        for (int t = seg * seglen; t < (seg + 1) * seglen; t += 2) {
            const bool last = (t == nt - 2);
            const char* a1 = cA + (size_t)(t + 1) * kstep;
            const char* a2 = last ? nA : cA + (size_t)(t + 2) * kstep; const char* b2 = last ? nB : cB + (size_t)(t + 2) * kstep;
            const char* a3 = a2 + kstep; const char* b3 = b2 + kstep;
            unsigned v2[2][2];
#pragma unroll
            for (int h = 0; h < 2; ++h)
#pragma unroll
                for (int i = 0; i < 2; ++i) v2[h][i] = (GATHER && last) ? vAn[h][i] : vA[h][i];
            PG8_LDB(B0, 0, 0); PG8_LDB(B1, 0, 1); PG8_SCHED; PG8_LDA(At, 0, 0); PG8_STAGE_A(PG8_SA(1, 1), a1, vA, 1);
            PG8_WAIT_V(8); PG8_WAIT_L(0); PG8_BAR; PG8_MMA(0, 0, At, B0); PG8_MMA(0, 1, At, B1); PG8_BAR; PG8_SCHED;
            PG8_LDA(At, 0, 1); PG8_STAGE_B(PG8_SB(0, 0), b2, voffB); PG8_STAGE_B(PG8_SB(0, 1), b2 + bhstep, voffB); PG8_STAGE_A(PG8_SA(0, 0), a2, v2, 0);
            PG8_WAIT_V(8); PG8_WAIT_L(0); PG8_BAR; PG8_MMA(1, 0, At, B0); PG8_MMA(1, 1, At, B1); PG8_BAR; PG8_SCHED;
            PG8_LDB(B0, 1, 0); PG8_LDB(B1, 1, 1); PG8_SCHED; PG8_LDA(At, 1, 0); PG8_STAGE_A(PG8_SA(0, 1), a2, v2, 1);
            PG8_WAIT_V(8); PG8_WAIT_L(0); PG8_BAR; PG8_MMA(0, 0, At, B0); PG8_MMA(0, 1, At, B1); PG8_BAR; PG8_SCHED;
            PG8_LDA(At, 1, 1); PG8_STAGE_B(PG8_SB(1, 0), b3, voffB); PG8_STAGE_B(PG8_SB(1, 1), b3 + bhstep, voffB); PG8_STAGE_A(PG8_SA(1, 0), a3, v2, 0);
            PG8_WAIT_V(8); PG8_WAIT_L(0); PG8_BAR; PG8_MMA(1, 0, At, B0); PG8_MMA(1, 1, At, B1); PG8_BAR; PG8_SCHED;
        }
        }
        if constexpr (ALIGN_EPI) { if (wr == 0) PG8_BAR; }
        asm volatile("s_nop 15\n\ts_nop 15" ::: "memory");
        {   int l2_ = lane; asm volatile("" : "+v"(l2_));
            E(acc, cur, wr, wc, l2_ & 15, l2_ >> 4); }
        if (!has_next) break;
#pragma unroll
        for (int a = 0; a < 2; ++a)
#pragma unroll
            for (int b = 0; b < 2; ++b)
#pragma unroll
                for (int m = 0; m < 4; ++m)
#pragma unroll
                    for (int n = 0; n < 2; ++n) acc[a][b][m][n] = (f32x4){0.f, 0.f, 0.f, 0.f};
        cur = nxt; cA = nA; cB = nB; ++ui;
#pragma unroll
        for (int h = 0; h < 2; ++h)
#pragma unroll
            for (int i = 0; i < 2; ++i) vA[h][i] = vAn[h][i];
        if constexpr (ALIGN_EPI) { if (wr == 1) PG8_BAR; }
    }
    PG8_WAIT_V(0);
    if constexpr (!ALIGN_EPI) { if (wr == 0) PG8_BAR; }
    PG8_BAR;
#undef PG8_SA
#undef PG8_SB
#undef PG8_STAGE
#undef PG8_STAGE_A
#undef PG8_STAGE_G
#undef PG8_LDA
#undef PG8_LDB
#undef PG8_MMA
#undef PG8_CAT
#undef PG8_WAIT_V
#undef PG8_WAIT_L
#undef PG8_BAR
#undef PG8_SCHED
#undef PG8_GIDX
}
}

constexpr int NWAVES = 8, NTHR = 512;
constexpr int BATCH = 4, SEQ = 4096, T = BATCH * SEQ, D = 2048, DEPTH = 2;
constexpr int IN_WIDTH = 15392, NPROJ = 9216, NGATE = 6144, NPROJ_ALL = NPROJ + NGATE;
constexpr int PQ_DAQ = 0, PQ_DAK = 1024, PQ_DAV = 2048, PQ_GQ = 3072, PQ_GK = 3584, PQ_GV = 4096, PQ_GR = 5120, PQ_SZ = 6144, PQ_SX = 7168, PQ_SB = 8192, PQ_SC = 8704, PQ_MG = 9216;
constexpr int NEXP = 64, TOPK = 8, EDIM = 512;
constexpr int MAXSLOT = T * TOPK + NEXP * 256;
constexpr int NSLOT_ALL = MAXSLOT + T;
constexpr int MAXBLK = NSLOT_ALL / 256;
constexpr float ALPHA = 1.4142135623730951f;
constexpr float EPS = 1e-5f;

constexpr size_t MiB = 1u << 20;
constexpr size_t WS_CTL = 0, CTL_ZERO_BYTES = 1 * MiB;
constexpr size_t WS_MISC = 1 * MiB;
constexpr size_t WS_WIN = 10 * MiB, WS_SM = 70 * MiB, WS_WBR = 71 * MiB, WS_WOUT = 83 * MiB, WS_RT = 91 * MiB, WS_EXP1 = 92 * MiB, WS_EXP2 = 352 * MiB;
constexpr size_t WS_XB = 482 * MiB, WS_XRES = 546 * MiB;
constexpr size_t WS_R1 = 674 * MiB, WS_PROJ = WS_R1, WS_G8 = WS_PROJ + (size_t)T * NPROJ * 2, WS_BRCAT = 1154 * MiB, WS_OS = WS_R1;
constexpr size_t WS_R2 = 1314 * MiB, WS_UPDT = WS_R2, WS_SPREVT = 1442 * MiB, WS_STATES = 1506 * MiB, WS_SPREV = 1570 * MiB, WS_HS = WS_R2;
constexpr size_t WS_MERGED = 1602 * MiB, WS_X1B = WS_MERGED, WS_H = 1666 * MiB, WS_SMALL = 1794 * MiB, WS_GDEC = 1796 * MiB, WS_ALAST = WS_GDEC + 512 * 1024, WS_END = 1797 * MiB;
static_assert(WS_WIN + (size_t)NPROJ_ALL * D * 2 <= WS_SM && WS_EXP1 + (size_t)65 * 1024 * 2048 * 2 <= WS_EXP2 && WS_EXP2 + (size_t)65 * 2048 * 512 * 2 <= WS_XB, "weights map");
static_assert(WS_G8 + (size_t)T * NGATE <= WS_BRCAT && WS_BRCAT + (size_t)T * 3072 * 2 <= WS_R2 && WS_OS + (size_t)NSLOT_ALL * D * 2 <= WS_R2, "R1 map");
static_assert(WS_HS + (size_t)NSLOT_ALL * EDIM * 2 <= WS_MERGED && WS_SPREV + (size_t)4 * 32 * 16 * 64 * 128 * 2 <= WS_MERGED, "R2 map");
constexpr size_t MS_SELMASK = 0, MS_SELW = 256 * 1024, MS_CNT = 1024 * 1024, MS_TOK2SLOT = 1280 * 1024, MS_SLOTTOK = 2 * MiB, MS_BLKE = 3 * MiB, MS_NBLK = 3 * MiB + 4096;
constexpr int CW_BAR = 4096, CW_ATTQ = 16384;

constexpr int RING_BYTES = 131072;
constexpr int LDSCTL_OFF = 155648, MISC_OFF = LDSCTL_OFF + 64;
constexpr int LDS_BYTES = 155648 + 256;

#define RLX_AGENT __ATOMIC_RELAXED, __HIP_MEMORY_SCOPE_AGENT
#define LDS_WAIT() asm volatile("s_waitcnt lgkmcnt(0)" ::: "memory")
#define VM_WAIT() asm volatile("s_waitcnt vmcnt(0)" ::: "memory")

#define XB_TMO      128
#define XB_XCNT(j)  (256  + 64 * (j))
#define XB_XSUB(j)  (1280 + 64 * (j))
#define XB_XGEN(j)  (2304 + 64 * (j))
#define XB_TOP      3328
#define XB_TOPGEN   3392
#define XCD_BAR_WORDS 3456
#define XB_SPIN_CAP (1u << 20)
__device__ __forceinline__ unsigned xb_ld(unsigned* p)              { return __hip_atomic_load(p, __ATOMIC_RELAXED, __HIP_MEMORY_SCOPE_AGENT); }
__device__ __forceinline__ unsigned xb_add(unsigned* p, unsigned v) { return __hip_atomic_fetch_add(p, v, __ATOMIC_RELAXED, __HIP_MEMORY_SCOPE_AGENT); }
__device__ __forceinline__ unsigned xb_xcc_id() { return (unsigned)__builtin_amdgcn_s_getreg((3 << 11) | 20) & 0xFu; }
#define XB_SPIN(cond, bar) do { unsigned _sp = 0; while (cond) { __builtin_amdgcn_s_sleep(1); \
    if ((++_sp & 255u) == 0u) { if (xb_ld(&(bar)[XB_TMO])) break; if (_sp > XB_SPIN_CAP) { atomicAdd(&(bar)[XB_TMO], 1u); break; } } } } while (0)
struct XcdBarrier { unsigned* bar; unsigned x; volatile LAS unsigned* st; };
__device__ __forceinline__ XcdBarrier xcd_barrier_post(unsigned* bar, volatile LAS unsigned* st, bool leader) {
    XcdBarrier b; b.bar = bar; b.x = xb_xcc_id(); b.st = st;
    if (leader) (void)xb_add(&bar[XB_XCNT(b.x)], 1u);
    return b;
}
__device__ __forceinline__ void xcd_barrier_complete(unsigned* bar, unsigned x, unsigned& nloc, unsigned& nx) {
    const unsigned G = gridDim.x * gridDim.y * gridDim.z;
    unsigned sum, cnt, mine, sp = 0u;
    for (;;) {
        sum = 0u; cnt = 0u; mine = 0u;
#pragma unroll
        for (unsigned j = 0; j < 16; ++j) { const unsigned c = xb_ld(&bar[XB_XCNT(j)]); sum += c; cnt += (c > 0u) ? 1u : 0u; mine = (j == x) ? c : mine; }
        if (sum == G) break;
        __builtin_amdgcn_s_sleep(1);
        if ((++sp & 255u) == 0u) { if (xb_ld(&bar[XB_TMO])) break; if (sp > XB_SPIN_CAP) { atomicAdd(&bar[XB_TMO], 1u); break; } }
    }
    nloc = mine > 0u ? mine : 1u; nx = cnt > 0u ? cnt : 1u;
}
__device__ __forceinline__ void xcd_barrier(const XcdBarrier& b, bool leader) {
    asm volatile("s_waitcnt vmcnt(0)" ::: "memory");
    __syncthreads();
    if (leader) {
        unsigned* bar = b.bar;
        __builtin_amdgcn_s_waitcnt(0);
        unsigned nloc = b.st[0], nx = b.st[1];
        if (nloc == 0u) { xcd_barrier_complete(bar, b.x, nloc, nx); b.st[0] = nloc; b.st[1] = nx; }
        const unsigned old = xb_add(&bar[XB_XSUB(b.x)], 1u);
        const unsigned gen = old / nloc;
        if (old + 1u == (gen + 1u) * nloc) {
            __builtin_amdgcn_fence(__ATOMIC_RELEASE, "agent");
            asm volatile("s_waitcnt vmcnt(0)" ::: "memory");
            const unsigned og = xb_add(&bar[XB_TOP], 1u);
            const unsigned tg = og / nx;
            if (og + 1u == (tg + 1u) * nx) xb_add(&bar[XB_TOPGEN], 1u);
            else XB_SPIN(xb_ld(&bar[XB_TOPGEN]) == tg, bar);
            __builtin_amdgcn_fence(__ATOMIC_ACQUIRE, "agent");
            xb_add(&bar[XB_XGEN(b.x)], 1u);
            asm volatile("s_waitcnt vmcnt(0)" ::: "memory");
        } else {
            XB_SPIN(xb_ld(&bar[XB_XGEN(b.x)]) == gen, bar);
            __builtin_amdgcn_fence(__ATOMIC_ACQUIRE, "agent");
            asm volatile("s_waitcnt vmcnt(0)" ::: "memory");
        }
    }
    __syncthreads();
}

struct Args { const float* in[27]; float* out; unsigned char* ws; int ph_lo, ph_hi; int sub, pad; };
__device__ __forceinline__ int lane_id() { int r; asm volatile("v_mbcnt_lo_u32_b32 %0, -1, 0\n\tv_mbcnt_hi_u32_b32 %0, -1, %0" : "=v"(r)); return r; }
__device__ __forceinline__ Args load_args(const Args& a) {
#if defined(__HIP_DEVICE_COMPILE__)
    typedef const __attribute__((address_space(4))) unsigned long long* kptr;
    kptr p = (kptr)__builtin_amdgcn_kernarg_segment_ptr(); asm volatile("" : "+s"(p));
    Args r;
#pragma unroll
    for (int i = 0; i < 27; ++i) r.in[i] = (const float*)(const GAS float*)p[i];
    r.out = (float*)(GAS float*)p[27]; r.ws = (unsigned char*)(GAS unsigned char*)p[28]; const unsigned long long q = p[29], q2 = p[30]; r.ph_lo = (int)(unsigned)q; r.ph_hi = (int)(unsigned)(q >> 32); r.sub = (int)(unsigned)q2; r.pad = (int)(unsigned)(q2 >> 32);
    return r;
#else
    return a;
#endif
}
struct Frame {
    LAS unsigned char* lds;
    unsigned char* ws;
    int tid, lane, wave, G, bid;
};

template <int K> __device__ __forceinline__ float swz_xor(float v) { return __builtin_bit_cast(float, __builtin_amdgcn_ds_swizzle(__builtin_bit_cast(int, v), 0x1f | (K << 10))); }
__device__ __forceinline__ float x32_sum(float v) { auto r = __builtin_amdgcn_permlane32_swap(__float_as_uint(v), __float_as_uint(v), false, false); return __uint_as_float(r[0]) + __uint_as_float(r[1]); }
__device__ __forceinline__ float x32_max(float v) { auto r = __builtin_amdgcn_permlane32_swap(__float_as_uint(v), __float_as_uint(v), false, false); return fmaxf(__uint_as_float(r[0]), __uint_as_float(r[1])); }
__device__ __forceinline__ float wave_sum(float v) { v += swz_xor<1>(v); v += swz_xor<2>(v); v += swz_xor<4>(v); v += swz_xor<8>(v); v += swz_xor<16>(v); return x32_sum(v); }
__device__ __forceinline__ float wave_max(float v) { v = fmaxf(v, swz_xor<1>(v)); v = fmaxf(v, swz_xor<2>(v)); v = fmaxf(v, swz_xor<4>(v)); v = fmaxf(v, swz_xor<8>(v)); v = fmaxf(v, swz_xor<16>(v)); return x32_max(v); }
__device__ __forceinline__ float wave_scan_f(float v, int ln) {
#pragma unroll
    for (int o = 1; o < 64; o <<= 1) { const float t = __builtin_bit_cast(float, __builtin_amdgcn_ds_bpermute((ln - o) << 2, __builtin_bit_cast(int, v))); if (ln >= o) v += t; }
    return v;
}
__device__ __forceinline__ int wave_scan_i(int v, int ln) {
#pragma unroll
    for (int o = 1; o < 64; o <<= 1) { const int t = __builtin_amdgcn_ds_bpermute((ln - o) << 2, v); if (ln >= o) v += t; }
    return v;
}

constexpr int CV_NITEMS = 32 * 80 + 32 * 64 + 32 * 96 + 32 + 3 * 16 * 32 + 32 * 32 + 32 * 2 + 65 * (2 * 32 * 8 + 8 * 32);
__device__ __forceinline__ void cv_item(const float* W, int ldn, int k0, int ns0, bf16_t* dst, int ld_dst, int drow0, int dk0, LAS float* scr, int lane) {
#pragma unroll 8
    for (int i = 0; i < 32; ++i) { const int kk = 2 * i + (lane >> 5); scr[kk * 33 + (lane & 31)] = W[(size_t)(k0 + kk) * ldn + ns0 + (lane & 31)]; }
    LDS_WAIT(); asm volatile("" ::: "memory");
    const int c = lane & 7;
#pragma unroll
    for (int j = 0; j < 4; ++j) { const int n = (lane >> 3) + 8 * j; const LAS float* s = scr + (8 * c) * 33 + n;
        u32x4 o; o.x = cvt_pk_bf16(s[0 * 33], s[1 * 33]); o.y = cvt_pk_bf16(s[2 * 33], s[3 * 33]); o.z = cvt_pk_bf16(s[4 * 33], s[5 * 33]); o.w = cvt_pk_bf16(s[6 * 33], s[7 * 33]);
        *(GAS u32x4*)(dst + (size_t)(drow0 + n) * ld_dst + dk0 + k0 + 8 * c) = o; }
    LDS_WAIT(); asm volatile("" ::: "memory");
}
__device__ __forceinline__ void cv_item64(const float* W, int ldn, int k0, int ns0, fp8_t* dst, int ld_dst, int drow0, int dk0, LAS float* scr, int lane) {
    const float* wp = W + (size_t)(k0 + (lane >> 4)) * ldn + ns0 + 4 * (lane & 15);
    f32x4 v[16];
#pragma unroll
    for (int i = 0; i < 16; ++i) v[i] = *(const GAS f32x4*)(wp + (size_t)(4 * i) * ldn);
#pragma unroll
    for (int i = 0; i < 16; ++i) { LAS float* sp = scr + (4 * i + (lane >> 4)) * 65 + 4 * (lane & 15); sp[0] = v[i].x * WSCALE; sp[1] = v[i].y * WSCALE; sp[2] = v[i].z * WSCALE; sp[3] = v[i].w * WSCALE; }
    LDS_WAIT(); asm volatile("" ::: "memory");
    const int c = lane & 3;
#pragma unroll
    for (int j = 0; j < 4; ++j) { const int n = (lane >> 2) + 16 * j; const LAS float* s = scr + (16 * c) * 65 + n;
        u32x4 o; o.x = pk4_fp8(s[0 * 65], s[1 * 65], s[2 * 65], s[3 * 65]); o.y = pk4_fp8(s[4 * 65], s[5 * 65], s[6 * 65], s[7 * 65]);
        o.z = pk4_fp8(s[8 * 65], s[9 * 65], s[10 * 65], s[11 * 65]); o.w = pk4_fp8(s[12 * 65], s[13 * 65], s[14 * 65], s[15 * 65]);
        *(GAS u32x4*)(dst + (size_t)(drow0 + n) * ld_dst + dk0 + k0 + 16 * c) = o; }
    LDS_WAIT(); asm volatile("" ::: "memory");
}
__device__ __forceinline__ void cv_item_small(const float* W, int k0, bf16_t* dst, LAS float* scr, int lane) {
    const int c32 = lane & 31, sc = c32 < 16 ? 5120 + c32 : 9232 + (c32 - 16);
#pragma unroll 8
    for (int i = 0; i < 32; ++i) { const int kk = 2 * i + (lane >> 5); scr[kk * 33 + c32] = W[(size_t)(k0 + kk) * IN_WIDTH + sc]; }
    LDS_WAIT(); asm volatile("" ::: "memory");
    const int c = lane & 7;
#pragma unroll
    for (int j = 0; j < 4; ++j) { const int n = (lane >> 3) + 8 * j; const LAS float* s = scr + (8 * c) * 33 + n;
        u32x4 o; o.x = cvt_pk_bf16(s[0 * 33], s[1 * 33]); o.y = cvt_pk_bf16(s[2 * 33], s[3 * 33]); o.z = cvt_pk_bf16(s[4 * 33], s[5 * 33]); o.w = cvt_pk_bf16(s[6 * 33], s[7 * 33]);
        *(GAS u32x4*)(dst + (size_t)n * D + k0 + 8 * c) = o; }
    LDS_WAIT(); asm volatile("" ::: "memory");
}
__device__ __forceinline__ void cv_item_router(const float* W, int k0, int ns0, bf16_t* dhi, bf16_t* dlo, LAS float* scr, int lane) {
#pragma unroll 8
    for (int i = 0; i < 32; ++i) { const int kk = 2 * i + (lane >> 5); scr[kk * 33 + (lane & 31)] = W[(size_t)(k0 + kk) * NEXP + ns0 + (lane & 31)]; }
    LDS_WAIT(); asm volatile("" ::: "memory");
    const int c = lane & 7;
#pragma unroll
    for (int j = 0; j < 4; ++j) { const int n = (lane >> 3) + 8 * j; const LAS float* s = scr + (8 * c) * 33 + n;
        float v[8], r[8]; unsigned short hb[8];
#pragma unroll
        for (int q = 0; q < 8; ++q) { v[q] = s[q * 33]; hb[q] = f2bf(v[q]); r[q] = v[q] - bf2f(hb[q]); }
        u32x4 o; o.x = hb[0] | ((unsigned)hb[1] << 16); o.y = hb[2] | ((unsigned)hb[3] << 16); o.z = hb[4] | ((unsigned)hb[5] << 16); o.w = hb[6] | ((unsigned)hb[7] << 16);
        u32x4 l; l.x = cvt_pk_bf16(r[0], r[1]); l.y = cvt_pk_bf16(r[2], r[3]); l.z = cvt_pk_bf16(r[4], r[5]); l.w = cvt_pk_bf16(r[6], r[7]);
        *(GAS u32x4*)(dhi + (size_t)(ns0 + n) * D + k0 + 8 * c) = o;
        *(GAS u32x4*)(dlo + (size_t)(ns0 + n) * D + k0 + 8 * c) = l; }
    LDS_WAIT(); asm volatile("" ::: "memory");
}

struct CvDesc { const float* W; fp8_t* dst; int ldn, ld_dst; };
__device__ __forceinline__ void cv_load64(const CvDesc& d, int lane, f32x4 (&v)[16]) {
    const unsigned voff = (unsigned)(((lane >> 4) * d.ldn + 4 * (lane & 15)) * 4);
#pragma unroll
    for (int i = 0; i < 16; ++i) { const GAS float* rp = (const GAS float*)(d.W + (size_t)(4 * i) * d.ldn);
        asm volatile("s_nop 4\n\tglobal_load_dwordx4 %0, %1, %2" : "=&v"(v[i]) : "v"(voff), "s"(rp) : "memory"); }
}
template <int N> __device__ __forceinline__ void cv_wait(f32x4 (&v)[16]) {
    asm volatile("s_waitcnt vmcnt(%16)" : "+v"(v[0]), "+v"(v[1]), "+v"(v[2]), "+v"(v[3]), "+v"(v[4]), "+v"(v[5]), "+v"(v[6]), "+v"(v[7]), "+v"(v[8]), "+v"(v[9]), "+v"(v[10]), "+v"(v[11]), "+v"(v[12]), "+v"(v[13]), "+v"(v[14]), "+v"(v[15]) : "n"(N) : "memory");
}
__device__ __forceinline__ void cv_proc64(const CvDesc& d, f32x4 (&v)[16], LAS float* scr, int lane) {
#pragma unroll
    for (int i = 0; i < 16; ++i) { LAS float* sp = scr + (4 * i + (lane >> 4)) * 65 + 4 * (lane & 15); sp[0] = v[i].x * WSCALE; sp[1] = v[i].y * WSCALE; sp[2] = v[i].z * WSCALE; sp[3] = v[i].w * WSCALE; }
    LDS_WAIT(); asm volatile("" ::: "memory");
    const int c = lane & 3;
#pragma unroll
    for (int j = 0; j < 4; ++j) { const int n = (lane >> 2) + 16 * j; const LAS float* s = scr + (16 * c) * 65 + n;
        u32x4 o; o.x = pk4_fp8(s[0 * 65], s[1 * 65], s[2 * 65], s[3 * 65]); o.y = pk4_fp8(s[4 * 65], s[5 * 65], s[6 * 65], s[7 * 65]);
        o.z = pk4_fp8(s[8 * 65], s[9 * 65], s[10 * 65], s[11 * 65]); o.w = pk4_fp8(s[12 * 65], s[13 * 65], s[14 * 65], s[15 * 65]);
        *(GAS u32x4*)(d.dst + (size_t)n * d.ld_dst + 16 * c) = o; }
    LDS_WAIT(); asm volatile("" ::: "memory");
}
__device__ __forceinline__ void cv_load_k128(const CvDesc& d, int lane, f32x4 (&v)[16]) {
    const unsigned voff = (unsigned)(((lane >> 3) * d.ldn + 4 * (lane & 7)) * 4);
#pragma unroll
    for (int i = 0; i < 16; ++i) { const GAS float* rp = (const GAS float*)(d.W + (size_t)(8 * i) * d.ldn);
        asm volatile("s_nop 4\n\tglobal_load_dwordx4 %0, %1, %2" : "=&v"(v[i]) : "v"(voff), "s"(rp) : "memory"); }
}
__device__ __forceinline__ void cv_proc_k128(const CvDesc& d, f32x4 (&v)[16], LAS float* scr, int lane) {
#pragma unroll
    for (int i = 0; i < 16; ++i) { LAS float* sp = scr + (8 * i + (lane >> 3)) * 33 + 4 * (lane & 7); sp[0] = v[i].x * WSCALE; sp[1] = v[i].y * WSCALE; sp[2] = v[i].z * WSCALE; sp[3] = v[i].w * WSCALE; }
    LDS_WAIT(); asm volatile("" ::: "memory");
    const int c = lane & 7;
#pragma unroll
    for (int j = 0; j < 4; ++j) { const int n = (lane >> 3) + 8 * j; const LAS float* s = scr + (16 * c) * 33 + n;
        u32x4 o; o.x = pk4_fp8(s[0 * 33], s[1 * 33], s[2 * 33], s[3 * 33]); o.y = pk4_fp8(s[4 * 33], s[5 * 33], s[6 * 33], s[7 * 33]);
        o.z = pk4_fp8(s[8 * 33], s[9 * 33], s[10 * 33], s[11 * 33]); o.w = pk4_fp8(s[12 * 33], s[13 * 33], s[14 * 33], s[15 * 33]);
        __builtin_nontemporal_store(o, (GAS u32x4*)(d.dst + (size_t)n * d.ld_dst + 16 * c)); }
    LDS_WAIT(); asm volatile("" ::: "memory");
}
__device__ __forceinline__ void cv_item_k128(const float* W, int ldn, int k0, int n0, fp8_t* dst, int ld_dst, int drow0, int dk0, LAS float* scr, int lane) {
    const float* wp = W + (size_t)(k0 + (lane >> 3)) * ldn + n0 + 4 * (lane & 7);
    f32x4 v[16];
#pragma unroll
    for (int i = 0; i < 16; ++i) v[i] = *(const GAS f32x4*)(wp + (size_t)(8 * i) * ldn);
    CvDesc d; d.W = W; d.ldn = ldn; d.dst = dst + (size_t)drow0 * ld_dst + dk0 + k0; d.ld_dst = ld_dst;
    cv_proc_k128(d, v, scr, lane);
}
__device__ __forceinline__ void phase_convert_experts(Frame& F, const Args& a, int l, int r0, int r1, int gw, int NGW) {
    LAS float* scr = (LAS float*)(F.lds + F.wave * 16896);
    fp8_t* EXP1 = (fp8_t*)(F.ws + WS_EXP1); fp8_t* EXP2 = (fp8_t*)(F.ws + WS_EXP2);
    const float* e_g = a.in[19] + (size_t)l * NEXP * D * EDIM; const float* e_u = a.in[20] + (size_t)l * NEXP * D * EDIM; const float* e_d = a.in[21] + (size_t)l * NEXP * EDIM * D;
    const float* s_g = a.in[22] + (size_t)l * D * EDIM; const float* s_u = a.in[23] + (size_t)l * D * EDIM; const float* s_d = a.in[24] + (size_t)l * EDIM * D;
    auto desc = [&](int r) -> CvDesc {
        const int e = r / 768, q0 = r % 768, kind = q0 >> 8, q = q0 & 255;
        const float* W = (kind == 0 ? (e < 64 ? e_g + (size_t)e * D * EDIM : s_g) : kind == 1 ? (e < 64 ? e_u + (size_t)e * D * EDIM : s_u) : (e < 64 ? e_d + (size_t)e * D * EDIM : s_d));
        const int ldn = kind == 2 ? D : EDIM, nb = kind == 2 ? 64 : 16, k0 = 128 * (q / nb), n0 = 32 * (q % nb);
        fp8_t* dst = kind == 2 ? EXP2 + (size_t)e * D * EDIM : EXP1 + (size_t)e * 1024 * D;
        const int ld_dst = kind == 2 ? EDIM : D, drow0 = kind == 2 ? n0 : (n0 / 128) * 256 + (kind == 1 ? 128 : 0) + (n0 % 128);
        CvDesc d; d.W = W + (size_t)k0 * ldn + n0; d.ldn = ldn; d.dst = dst + (size_t)drow0 * ld_dst + k0; d.ld_dst = ld_dst; return d; };
    int r = r0 + gw;
    if (r < r1) {
        f32x4 va[16], vb[16]; CvDesc da = desc(r), db = da; cv_load_k128(da, F.lane, va);
        {   const int rn = r + NGW; db = desc(rn < r1 ? rn : r); cv_load_k128(db, F.lane, vb); cv_wait<16>(va); cv_proc_k128(da, va, scr, F.lane); r = rn; }
        while (r < r1) {
            {   const int rn = r + NGW; da = desc(rn < r1 ? rn : r); cv_load_k128(da, F.lane, va); cv_wait<20>(vb); cv_proc_k128(db, vb, scr, F.lane); r = rn; }
            if (r >= r1) break;
            {   const int rn = r + NGW; db = desc(rn < r1 ? rn : r); cv_load_k128(db, F.lane, vb); cv_wait<20>(va); cv_proc_k128(da, va, scr, F.lane); r = rn; }
        }
        asm volatile("s_waitcnt vmcnt(0)" ::: "memory");
    }
}
__device__ __forceinline__ void phase_convert(Frame& F, const Args& a, int l, int it0, int it1, int gw, int NGW, bool do_x) {
    LAS float* scr = (LAS float*)(F.lds + F.wave * 16896);
    const float* w_in = a.in[1] + (size_t)l * D * IN_WIDTH;
    const float* w_br = a.in[13] + (size_t)l * 3 * 1024 * D;
    const float* w_out = a.in[14] + (size_t)l * D * D;
    const float* w_rt = a.in[17] + (size_t)l * D * NEXP;
    const float* e_g = a.in[19] + (size_t)l * NEXP * D * EDIM;
    const float* e_u = a.in[20] + (size_t)l * NEXP * D * EDIM;
    const float* e_d = a.in[21] + (size_t)l * NEXP * EDIM * D;
    const float* s_g = a.in[22] + (size_t)l * D * EDIM;
    const float* s_u = a.in[23] + (size_t)l * D * EDIM;
    const float* s_d = a.in[24] + (size_t)l * EDIM * D;
    fp8_t* WIN = (fp8_t*)(F.ws + WS_WIN); bf16_t* SM = (bf16_t*)(F.ws + WS_SM); fp8_t* WBR = (fp8_t*)(F.ws + WS_WBR); fp8_t* WOUT = (fp8_t*)(F.ws + WS_WOUT);
    bf16_t* RTH = (bf16_t*)(F.ws + WS_RT); bf16_t* RTL = RTH + 64 * D; fp8_t* EXP1 = (fp8_t*)(F.ws + WS_EXP1); fp8_t* EXP2 = (fp8_t*)(F.ws + WS_EXP2);
    constexpr int I_A = 32 * 80, I_B = 32 * 64, I_C = 32 * 96, I_SM = 32, I_BR = 16 * 32, I_WO = 32 * 32, I_RT = 32 * 2, I_EG = 32 * 8, I_ED = 8 * 32;
    for (int it = it0 + gw; it < it1; it += NGW) {
        int r = it;
        if (r < I_A) { cv_item_k128(w_in, IN_WIDTH, 128 * (r / 160), 0 + 32 * (r % 160), WIN, D, 0 + 32 * (r % 160), 0, scr, F.lane); continue; } r -= I_A;
        if (r < I_B) { cv_item_k128(w_in, IN_WIDTH, 128 * (r / 128), 5136 + 32 * (r % 128), WIN, D, 5120 + 32 * (r % 128), 0, scr, F.lane); continue; } r -= I_B;
        if (r < I_C) { cv_item_k128(w_in, IN_WIDTH, 128 * (r / 192), 9248 + 32 * (r % 192), WIN, D, 9216 + 32 * (r % 192), 0, scr, F.lane); continue; } r -= I_C;
        if (r < I_SM) { cv_item_small(w_in, 64 * r, SM, scr, F.lane); continue; } r -= I_SM;
        if (r < 3 * I_BR) { const int br = r / I_BR, q = r % I_BR; cv_item_k128(w_br + (size_t)br * 1024 * D, D, 128 * (q / 64), 32 * (q % 64), WBR, 3072, 32 * (q % 64), 1024 * br, scr, F.lane); continue; } r -= 3 * I_BR;
        if (r < I_WO) { cv_item_k128(w_out, D, 128 * (r / 64), 32 * (r % 64), WOUT, D, 32 * (r % 64), 0, scr, F.lane); continue; } r -= I_WO;
        if (r < I_RT) { cv_item_router(w_rt, 64 * (r / 2), 32 * (r % 2), RTH, RTL, scr, F.lane); continue; } r -= I_RT;
        {
            constexpr int PER = 2 * I_EG + I_ED; const int e = r / PER; int q = r % PER;
            const float* wg = e < 64 ? e_g + (size_t)e * D * EDIM : s_g; const float* wu = e < 64 ? e_u + (size_t)e * D * EDIM : s_u; const float* wd = e < 64 ? e_d + (size_t)e * EDIM * D : s_d;
            fp8_t* d1 = EXP1 + (size_t)e * 1024 * D; fp8_t* d2 = EXP2 + (size_t)e * D * EDIM;
            if (q < I_EG) { const int n0 = 64 * (q % 8); cv_item64(wg, EDIM, 64 * (q / 8), n0, d1, D, (n0 / 128) * 256 + (n0 % 128), 0, scr, F.lane); continue; } q -= I_EG;
            if (q < I_EG) { const int n0 = 64 * (q % 8); cv_item64(wu, EDIM, 64 * (q / 8), n0, d1, D, (n0 / 128) * 256 + 128 + (n0 % 128), 0, scr, F.lane); continue; } q -= I_EG;
            cv_item64(wd, D, 64 * (q / 32), 64 * (q % 32), d2, EDIM, 64 * (q % 32), 0, scr, F.lane);
        }
    }
    if (do_x) {
        const float* x = a.in[0]; fp8_t* XB = (fp8_t*)(F.ws + WS_XB); bf16_t* XR = (bf16_t*)(F.ws + WS_XRES);
        for (int m = gw; m < T; m += NGW) { const GAS f32x4* xr = (const GAS f32x4*)(x + (size_t)m * D) + 2 * F.lane; GAS u32x2* o = (GAS u32x2*)(XB + (size_t)m * D) + F.lane; GAS u32x4* ob = (GAS u32x4*)(XR + (size_t)m * D) + F.lane;
            f32x4 v0[4], v1[4];
#pragma unroll
            for (int j = 0; j < 4; ++j) { v0[j] = xr[128 * j]; v1[j] = xr[128 * j + 1]; }
#pragma unroll
            for (int j = 0; j < 4; ++j) { u32x2 q8; q8.x = pk4_fp8(v0[j].x, v0[j].y, v0[j].z, v0[j].w); q8.y = pk4_fp8(v1[j].x, v1[j].y, v1[j].z, v1[j].w); o[64 * j] = q8;
                u32x4 wb; wb.x = cvt_pk_bf16(v0[j].x, v0[j].y); wb.y = cvt_pk_bf16(v0[j].z, v0[j].w); wb.z = cvt_pk_bf16(v1[j].x, v1[j].y); wb.w = cvt_pk_bf16(v1[j].z, v1[j].w); ob[64 * j] = wb; } }
    }
}

namespace pg8 {
struct EpiBf16 {
    static constexpr bool PERM = true, HAS_MID = false; static constexpr int MID0 = -1, MID1 = -1;
    bf16_t* O; int ldc; int nmod;
    __device__ __forceinline__ void mid(f32x4 (&)[2][2][4][2], const Unit&, int, int, int, int, int) const {}
    __device__ __forceinline__ void operator()(const f32x4 (&acc)[2][2][4][2], const Unit& u, int wr, int wc, int fr, int fq) const {
        const int pl = nmod ? (u.pn % nmod) : u.pn;
        const int row0 = u.pm * BM + wr * 64 + fr, col0 = pl * BM + wc * 32 + 8 * fq;
#pragma unroll
        for (int ai = 0; ai < 2; ++ai)
#pragma unroll
            for (int m = 0; m < 4; ++m) { bf16_t* rowp = O + (size_t)(row0 + ai * HALF + m * 16) * ldc + col0;
#pragma unroll
                for (int bj = 0; bj < 2; ++bj) { const f32x4 v0 = acc[ai][bj][m][0], v1 = acc[ai][bj][m][1];
                    u32x4 w; w.x = cvt_pk_bf16(v0[0], v0[1]); w.y = cvt_pk_bf16(v0[2], v0[3]); w.z = cvt_pk_bf16(v1[0], v1[1]); w.w = cvt_pk_bf16(v1[2], v1[3]);
                    *(u32x4*)(rowp + bj * HALF) = w; } }
    }
};
struct EpiGate {
    static constexpr bool PERM = true, PERM16 = true, HAS_MID = false; static constexpr int MID0 = -1, MID1 = -1;
    unsigned char* G;
    __device__ __forceinline__ void mid(f32x4 (&)[2][2][4][2], const Unit&, int, int, int, int, int) const {}
    __device__ __forceinline__ void operator()(const f32x4 (&acc)[2][2][4][2], const Unit& u, int wr, int wc, int fr, int fq) const {
        const int row0 = u.pm * BM + wr * 64 + fr, col0 = u.pn * BM + wc * 64 + 16 * fq;
#pragma unroll
        for (int ai = 0; ai < 2; ++ai)
#pragma unroll
            for (int m = 0; m < 4; ++m) { unsigned char* rowp = G + (size_t)(row0 + ai * HALF + m * 16) * NGATE + col0; u32x4 w;
#pragma unroll
                for (int bj = 0; bj < 2; ++bj)
#pragma unroll
                    for (int n = 0; n < 2; ++n) { unsigned pk = 0;
#pragma unroll
                        for (int q = 0; q < 4; ++q) pk = __builtin_amdgcn_cvt_pk_u8_f32(fmaxf(__builtin_rintf(255.0f * sigmoidf_(acc[ai][bj][m][n][q])), 1.0f), q, pk);
                        w[2 * bj + n] = pk; }
                *(u32x4*)rowp = w; }
    }
};

struct EpiFp8 {
    static constexpr bool PERM = true, PERM16 = true, HAS_MID = false; static constexpr int MID0 = -1, MID1 = -1;
    fp8_t* O; int ldc; int nmod;
    __device__ __forceinline__ void mid(f32x4 (&)[2][2][4][2], const Unit&, int, int, int, int, int) const {}
    __device__ __forceinline__ void operator()(const f32x4 (&acc)[2][2][4][2], const Unit& u, int wr, int wc, int fr, int fq) const {
        const int pl = nmod ? (u.pn % nmod) : u.pn;
        const int row0 = u.pm * BM + wr * 64 + fr, col0 = pl * BM + wc * 64 + 16 * fq;
#pragma unroll
        for (int ai = 0; ai < 2; ++ai)
#pragma unroll
            for (int m = 0; m < 4; ++m) { fp8_t* rowp = O + (size_t)(row0 + ai * HALF + m * 16) * ldc + col0; u32x4 w;
#pragma unroll
                for (int bj = 0; bj < 2; ++bj)
#pragma unroll
                    for (int n = 0; n < 2; ++n) { const f32x4 v = acc[ai][bj][m][n] * OSCALE; w[2 * bj + n] = pk4_fp8(v[0], v[1], v[2], v[3]); }
                *(u32x4*)rowp = w; }
    }
};
struct EpiSwiglu {
    static constexpr bool PERM = true, HAS_MID = false; static constexpr int MID0 = -1, MID1 = -1;
    fp8_t* O; int ldc;
    __device__ __forceinline__ void mid(f32x4 (&)[2][2][4][2], const Unit&, int, int, int, int, int) const {}
    __device__ __forceinline__ void operator()(const f32x4 (&acc)[2][2][4][2], const Unit& u, int wr, int wc, int fr, int fq) const {
        const int pl = u.pn & 3;
        const int row0 = u.pm * BM + wr * 64 + fr, col0 = pl * HALF + wc * 32 + 8 * fq;
#pragma unroll
        for (int ai = 0; ai < 2; ++ai)
#pragma unroll
            for (int m = 0; m < 4; ++m) { fp8_t* rowp = O + (size_t)(row0 + ai * HALF + m * 16) * ldc + col0;
                float h[8];
#pragma unroll
                for (int n = 0; n < 2; ++n)
#pragma unroll
                    for (int j = 0; j < 4; ++j) { const float gt = acc[ai][0][m][n][j], up = acc[ai][1][m][n][j]; h[4 * n + j] = siluf_(gt) * up; }
                u32x2 w; w.x = pk4_fp8(h[0], h[1], h[2], h[3]); w.y = pk4_fp8(h[4], h[5], h[6], h[7]);
                *(u32x2*)(rowp) = w; }
    }
};
struct EpiMerge {
    static constexpr bool PERM = true, PERM16 = true, HAS_MID = true; static constexpr int MID0 = 8, MID1 = 16;
    const unsigned char* P; fp8_t* O;
    __device__ __forceinline__ void mid(f32x4 (&acc)[2][2][4][2], const Unit& u, int t, int wr, int wc, int fr, int fq) const {
        const int i = t >> 3;
        unsigned o0 = (unsigned)(u.pm * BM + wr * 64 + fr) * (unsigned)NGATE + (unsigned)((i - 1) * 2048 + u.pn * BM + wc * 64 + 16 * fq);
        asm volatile("" : "+v"(o0));
        const char* Pb = (const char*)P;
#pragma unroll
        for (int ai = 0; ai < 2; ++ai)
#pragma unroll
            for (int m = 0; m < 4; ++m) { const unsigned orow = o0 + (unsigned)((ai * HALF + m * 16) * NGATE);
                const u32x4 ga = *(const u32x4*)(Pb + orow), gb = *(const u32x4*)(Pb + orow + 2048);
#pragma unroll
                for (int bj = 0; bj < 2; ++bj)
#pragma unroll
                    for (int n = 0; n < 2; ++n)
#pragma unroll
                        for (int q = 0; q < 4; ++q) acc[ai][bj][m][n][q] *= (float)((ga[2 * bj + n] >> (8 * q)) & 255u) * __builtin_amdgcn_rcpf((float)((gb[2 * bj + n] >> (8 * q)) & 255u));
                asm volatile("" : "+v"(acc[ai][0][m][0]), "+v"(acc[ai][0][m][1]), "+v"(acc[ai][1][m][0]), "+v"(acc[ai][1][m][1]) :: "memory"); }
    }
    __device__ __forceinline__ void operator()(const f32x4 (&acc)[2][2][4][2], const Unit& u, int wr, int wc, int fr, int fq) const {
        unsigned o0 = (unsigned)(u.pm * BM + wr * 64 + fr) * (unsigned)NGATE + (unsigned)(2 * 2048 + u.pn * BM + wc * 64 + 16 * fq);
        unsigned q0 = (unsigned)(u.pm * BM + wr * 64 + fr) * (unsigned)D + (unsigned)(u.pn * BM + wc * 64 + 16 * fq);
        asm volatile("" : "+v"(o0), "+v"(q0));
        const char* Pb = (const char*)P; char* Ob = (char*)O;
#pragma unroll
        for (int ai = 0; ai < 2; ++ai)
#pragma unroll
            for (int m = 0; m < 4; ++m) { const unsigned orow = o0 + (unsigned)((ai * HALF + m * 16) * NGATE), qrow = q0 + (unsigned)((ai * HALF + m * 16) * D);
                const u32x4 gg = *(const u32x4*)(Pb + orow); u32x4 w;
#pragma unroll
                for (int bj = 0; bj < 2; ++bj)
#pragma unroll
                    for (int n = 0; n < 2; ++n) { float v[4];
#pragma unroll
                        for (int q = 0; q < 4; ++q) v[q] = acc[ai][bj][m][n][q] * ((float)((gg[2 * bj + n] >> (8 * q)) & 255u) * (1.0f / 255.0f));
                        w[2 * bj + n] = pk4_fp8(v[0], v[1], v[2], v[3]); }
                *(u32x4*)(Ob + qrow) = w;
                asm volatile("" ::: "memory"); }
    }
};
struct EpiWout {
    static constexpr bool PERM = true, HAS_MID = false; static constexpr int MID0 = -1, MID1 = -1;
    const bf16_t* Xb; bf16_t* H;
    __device__ __forceinline__ void mid(f32x4 (&)[2][2][4][2], const Unit&, int, int, int, int, int) const {}
    __device__ __forceinline__ void operator()(const f32x4 (&acc)[2][2][4][2], const Unit& u, int wr, int wc, int fr, int fq) const {
        const int row0 = u.pm * BM + wr * 64 + fr, col0 = u.pn * BM + wc * 32 + 8 * fq;
#pragma unroll
        for (int ai = 0; ai < 2; ++ai)
#pragma unroll
            for (int m = 0; m < 4; ++m) { const unsigned off = (unsigned)((row0 + ai * HALF + m * 16) * D + col0);
#pragma unroll
                for (int bj = 0; bj < 2; ++bj) { const u32x4 xp = *(const u32x4*)(Xb + off + bj * HALF);
                    const f32x4 x0 = {bflo(xp.x), bfhi(xp.x), bflo(xp.y), bfhi(xp.y)}, x1 = {bflo(xp.z), bfhi(xp.z), bflo(xp.w), bfhi(xp.w)};
                    const f32x4 h0 = x0 * ALPHA + acc[ai][bj][m][0], h1 = x1 * ALPHA + acc[ai][bj][m][1];
                    u32x4 w; w.x = cvt_pk_bf16(h0[0], h0[1]); w.y = cvt_pk_bf16(h0[2], h0[3]); w.z = cvt_pk_bf16(h1[0], h1[1]); w.w = cvt_pk_bf16(h1[2], h1[3]);
                    *(u32x4*)(H + off + bj * HALF) = w; } }
    }
};
}

#ifndef FUSE_LN1
#define FUSE_LN1 1
#endif
__device__ __forceinline__ void phase_ln1(Frame& F, const Args& a, int l) {
    const int gw = F.bid * NWAVES + F.wave, NGW = F.G * NWAVES;
    bf16_t* H = (bf16_t*)(F.ws + WS_H); fp8_t* X1B = (fp8_t*)(F.ws + WS_X1B);
    const GAS f32x4* gp = (const GAS f32x4*)(a.in[15] + (size_t)l * D) + 2 * F.lane; const GAS f32x4* bp = (const GAS f32x4*)(a.in[16] + (size_t)l * D) + 2 * F.lane;
    for (int m = gw; m < T; m += NGW) {
        GAS u32x4* xr = (GAS u32x4*)(H + (size_t)m * D) + F.lane;
        u32x4 p[4]; float v[4][8]; float s = 0.f;
#pragma unroll
        for (int j = 0; j < 4; ++j) p[j] = xr[64 * j];
#pragma unroll
        for (int j = 0; j < 4; ++j) { v[j][0] = bflo(p[j].x); v[j][1] = bfhi(p[j].x); v[j][2] = bflo(p[j].y); v[j][3] = bfhi(p[j].y); v[j][4] = bflo(p[j].z); v[j][5] = bfhi(p[j].z); v[j][6] = bflo(p[j].w); v[j][7] = bfhi(p[j].w);
            s += ((v[j][0] + v[j][1]) + (v[j][2] + v[j][3])) + ((v[j][4] + v[j][5]) + (v[j][6] + v[j][7])); }
        const float mean = wave_sum(s) * (1.f / D); float s2 = 0.f;
#pragma unroll
        for (int j = 0; j < 4; ++j)
#pragma unroll
            for (int q = 0; q < 8; ++q) { v[j][q] -= mean; s2 += v[j][q] * v[j][q]; }
        const float rstd = 1.f / sqrtf(wave_sum(s2) * (1.f / D) + EPS);
        GAS u32x2* o8 = (GAS u32x2*)(X1B + (size_t)m * D) + F.lane;
#pragma unroll
        for (int j = 0; j < 4; ++j) { const f32x4 g0 = gp[128 * j], g1 = gp[128 * j + 1], b0 = bp[128 * j], b1 = bp[128 * j + 1];
            const f32x4 y0 = {v[j][0] * rstd * g0.x + b0.x, v[j][1] * rstd * g0.y + b0.y, v[j][2] * rstd * g0.z + b0.z, v[j][3] * rstd * g0.w + b0.w};
            const f32x4 y1 = {v[j][4] * rstd * g1.x + b1.x, v[j][5] * rstd * g1.y + b1.y, v[j][6] * rstd * g1.z + b1.z, v[j][7] * rstd * g1.w + b1.w};
            u32x4 w; w.x = cvt_pk_bf16(y0.x, y0.y); w.y = cvt_pk_bf16(y0.z, y0.w); w.z = cvt_pk_bf16(y1.x, y1.y); w.w = cvt_pk_bf16(y1.z, y1.w); xr[64 * j] = w;
            u32x2 q8; q8.x = pk4_fp8(y0.x, y0.y, y0.z, y0.w); q8.y = pk4_fp8(y1.x, y1.y, y1.z, y1.w); o8[64 * j] = q8; }
    }
}

__device__ __forceinline__ void ln1_rows8(Frame& F, const Args& a, int l, int m0) {
    bf16_t* H = (bf16_t*)(F.ws + WS_H); fp8_t* X1B = (fp8_t*)(F.ws + WS_X1B);
    const GAS f32x4* gp = (const GAS f32x4*)(a.in[15] + (size_t)l * D) + 2 * F.lane; const GAS f32x4* bp = (const GAS f32x4*)(a.in[16] + (size_t)l * D) + 2 * F.lane;
    for (int hb = 0; hb < 2; ++hb) {
        u32x4 p[4][4];
#pragma unroll
        for (int r = 0; r < 4; ++r) { const GAS u32x4* xr = (const GAS u32x4*)(H + (size_t)(m0 + 4 * hb + r) * D) + F.lane;
#pragma unroll
            for (int j = 0; j < 4; ++j) p[r][j] = xr[64 * j]; }
#pragma unroll
        for (int r = 0; r < 4; ++r) { const int m = m0 + 4 * hb + r;
            float v[4][8]; float s = 0.f;
#pragma unroll
            for (int j = 0; j < 4; ++j) { v[j][0] = bflo(p[r][j].x); v[j][1] = bfhi(p[r][j].x); v[j][2] = bflo(p[r][j].y); v[j][3] = bfhi(p[r][j].y); v[j][4] = bflo(p[r][j].z); v[j][5] = bfhi(p[r][j].z); v[j][6] = bflo(p[r][j].w); v[j][7] = bfhi(p[r][j].w);
                s += ((v[j][0] + v[j][1]) + (v[j][2] + v[j][3])) + ((v[j][4] + v[j][5]) + (v[j][6] + v[j][7])); }
            const float mean = wave_sum(s) * (1.f / D); float s2 = 0.f;
#pragma unroll
            for (int j = 0; j < 4; ++j)
#pragma unroll
                for (int q = 0; q < 8; ++q) { v[j][q] -= mean; s2 += v[j][q] * v[j][q]; }
            const float rstd = 1.f / sqrtf(wave_sum(s2) * (1.f / D) + EPS);
            GAS u32x4* xw = (GAS u32x4*)(H + (size_t)m * D) + F.lane; GAS u32x2* o8 = (GAS u32x2*)(X1B + (size_t)m * D) + F.lane;
#pragma unroll
            for (int j = 0; j < 4; ++j) { const f32x4 g0 = gp[128 * j], g1 = gp[128 * j + 1], b0 = bp[128 * j], b1 = bp[128 * j + 1];
                const f32x4 y0 = {v[j][0] * rstd * g0.x + b0.x, v[j][1] * rstd * g0.y + b0.y, v[j][2] * rstd * g0.z + b0.z, v[j][3] * rstd * g0.w + b0.w};
                const f32x4 y1 = {v[j][4] * rstd * g1.x + b1.x, v[j][5] * rstd * g1.y + b1.y, v[j][6] * rstd * g1.z + b1.z, v[j][7] * rstd * g1.w + b1.w};
                u32x4 w; w.x = cvt_pk_bf16(y0.x, y0.y); w.y = cvt_pk_bf16(y0.z, y0.w); w.z = cvt_pk_bf16(y1.x, y1.y); w.w = cvt_pk_bf16(y1.z, y1.w); xw[64 * j] = w;
                u32x2 q8; q8.x = pk4_fp8(y0.x, y0.y, y0.z, y0.w); q8.y = pk4_fp8(y1.x, y1.y, y1.z, y1.w); o8[64 * j] = q8; } }
    }
}

__device__ __forceinline__ bf16x8 pack8(const float* v) { u32x4 p; p.x = cvt_pk_bf16(v[0], v[1]); p.y = cvt_pk_bf16(v[2], v[3]); p.z = cvt_pk_bf16(v[4], v[5]); p.w = cvt_pk_bf16(v[6], v[7]); return __builtin_bit_cast(bf16x8, p); }
__device__ __forceinline__ float grp8_max(float v) { v = fmaxf(v, swz_xor<1>(v)); v = fmaxf(v, swz_xor<2>(v)); v = fmaxf(v, swz_xor<4>(v)); return v; }
__device__ __forceinline__ void phase_router(Frame& F, const Args& a, int l) {
    const bf16_t* X1 = (const bf16_t*)(F.ws + WS_H);
    const bf16_t* RTH = (const bf16_t*)(F.ws + WS_RT); const bf16_t* RTL = RTH + 64 * D;
    unsigned long long* SELMASK = (unsigned long long*)(F.ws + WS_MISC + MS_SELMASK); float* SELW = (float*)(F.ws + WS_MISC + MS_SELW); int* CNT = (int*)(F.ws + WS_MISC + MS_CNT);
    LAS float* PART = (LAS float*)F.lds;
    LAS float* LG = (LAS float*)(F.lds + 131072);
    LAS int* CNTL = (LAS int*)(F.lds + 131072 + 16384);
    const int lane = F.lane, w = F.wave, li = lane & 15, lq = lane >> 4;
    const float bias = a.in[18][l * NEXP + lane];
    for (int blk = F.bid; blk < T / 64; blk += F.G) {
#if FUSE_LN1
        ln1_rows8(F, a, l, blk * 64 + w * 8);
        __syncthreads();
#endif
        if (F.tid < 64) CNTL[F.tid] = 0;
        {
            f32x4 acc[4][4];
#pragma unroll
            for (int rt = 0; rt < 4; ++rt)
#pragma unroll
                for (int nb = 0; nb < 4; ++nb) acc[rt][nb] = (f32x4){0.f, 0.f, 0.f, 0.f};
            const bf16_t* xp = X1 + (size_t)(blk * 64 + li) * D + 256 * w + 8 * lq;
            const bf16_t* whp = RTH + (size_t)li * D + 256 * w + 8 * lq;
#pragma unroll 4
            for (int ks = 0; ks < 8; ++ks) {
                bf16x8 xh[4], bh[4];
#pragma unroll
                for (int rt = 0; rt < 4; ++rt) xh[rt] = *(const bf16x8*)(xp + (size_t)(16 * rt) * D + 32 * ks);
#pragma unroll
                for (int nb = 0; nb < 4; ++nb) bh[nb] = *(const bf16x8*)(whp + (size_t)(16 * nb) * D + 32 * ks);
#pragma unroll
                for (int rt = 0; rt < 4; ++rt)
#pragma unroll
                    for (int nb = 0; nb < 4; ++nb) acc[rt][nb] = __builtin_amdgcn_mfma_f32_16x16x32_bf16(xh[rt], bh[nb], acc[rt][nb], 0, 0, 0);
            }
#pragma unroll
            for (int rt = 0; rt < 4; ++rt)
#pragma unroll
                for (int nb = 0; nb < 4; ++nb)
#pragma unroll
                    for (int r = 0; r < 4; ++r) PART[(w * 64 + 16 * rt + 4 * lq + r) * 64 + 16 * nb + li] = acc[rt][nb][r];
        }
        __syncthreads();
#pragma unroll
        for (int i = 0; i < 8; ++i) { const int id = F.tid + 512 * i; float sacc = 0.f;
#pragma unroll
            for (int q = 0; q < 8; ++q) sacc += PART[q * 4096 + id];
            LG[id] = sacc; }
        __syncthreads();
        int mycnt = 0;
        for (int i = 0; i < 8; ++i) {
            const int tl = w * 8 + i, t = blk * 64 + tl;
            const float logit = LG[tl * 64 + lane];
            const float score = 1.0f / (1.0f + expf(-logit));
            const float sel = score + bias;
            const float m1 = grp8_max(sel);
            const unsigned long long eqm = __ballot(sel == m1);
            const unsigned gb = (unsigned)(eqm >> (lane & ~7)) & 0xffu;
            const int first = __builtin_ctz(gb);
            const float v2 = ((lane & 7) == first) ? -INFINITY : sel;
            const float gs = m1 + grp8_max(v2);
            const int g = lane >> 3; int grank = 0;
#pragma unroll
            for (int g2 = 0; g2 < 8; ++g2) { const float o = __builtin_bit_cast(float, __builtin_amdgcn_readlane(__builtin_bit_cast(int, gs), 8 * g2)); grank += (o > gs || (o == gs && g2 < g)) ? 1 : 0; }
            const float mv = grank < 4 ? sel : -INFINITY;
            int rank = 0;
#pragma unroll 4
            for (int e2 = 0; e2 < 64; ++e2) { const float o = __builtin_bit_cast(float, __builtin_amdgcn_readlane(__builtin_bit_cast(int, mv), e2)); rank += (o > mv || (o == mv && e2 < lane)) ? 1 : 0; }
            const bool chosen = rank < 8;
            const unsigned long long mask = __ballot(chosen);
            const float wsum = wave_sum(chosen ? score : 0.f);
            const float wgt = score / wsum * 2.5f;
            if (chosen) { const int j = __builtin_popcountll(mask & ((1ull << lane) - 1ull)); SELW[(size_t)t * 8 + j] = wgt; }
            if (lane == 0) SELMASK[t] = mask;
            mycnt += chosen ? 1 : 0;
        }
        __hip_atomic_fetch_add(&CNTL[lane], mycnt, __ATOMIC_RELAXED, __HIP_MEMORY_SCOPE_WORKGROUP);
        __syncthreads();
        if (F.tid < 64) CNT[blk * 64 + F.tid] = CNTL[F.tid];
        __syncthreads();
    }
}

__device__ __forceinline__ void phase_lists(Frame& F) {
    const unsigned long long* SELMASK = (const unsigned long long*)(F.ws + WS_MISC + MS_SELMASK); const int* CNT = (const int*)(F.ws + WS_MISC + MS_CNT);
    int* TOK2SLOT = (int*)(F.ws + WS_MISC + MS_TOK2SLOT); int* SLOTTOK = (int*)(F.ws + WS_MISC + MS_SLOTTOK); int* BLKE = (int*)(F.ws + WS_MISC + MS_BLKE); int* NBLK = (int*)(F.ws + WS_MISC + MS_NBLK);
    LAS int* P = (LAS int*)F.lds;
    LAS int* TOT = P + 1024;
    LAS int* PST = TOT + 64; LAS int* BASE = TOT + 192;
    const int lane = F.lane, e = F.tid & 63, part = F.tid >> 6;
    for (int blk = F.bid; blk < T / 64; blk += F.G) {
        int tot = 0, pre = 0;
        for (int b2 = part; b2 < T / 64; b2 += 8) { const int c = CNT[b2 * 64 + e]; tot += c; pre += (b2 < blk) ? c : 0; }
        P[part * 64 + e] = tot; P[512 + part * 64 + e] = pre;
        __syncthreads();
        if (F.tid < 64) { int t2 = 0, p2 = 0;
#pragma unroll
            for (int q = 0; q < 8; ++q) { t2 += P[q * 64 + e]; p2 += P[512 + q * 64 + e]; }
            TOT[e] = t2; BASE[e] = p2;
            const int padded = (t2 + 255) & ~255;
            const int incl = wave_scan_i(padded, lane);
            PST[e] = incl - padded; if (e == 63) PST[64] = incl;
        }
        __syncthreads();
        if (F.wave == 0) {
            int running = PST[lane] + BASE[lane];
            const unsigned long long mymask = SELMASK[blk * 64 + lane];
            const unsigned mlo = (unsigned)mymask, mhi = (unsigned)(mymask >> 32);
            for (int i = 0; i < 64; ++i) {
                const unsigned long long mk = ((unsigned long long)(unsigned)__builtin_amdgcn_readlane((int)mhi, i) << 32) | (unsigned)__builtin_amdgcn_readlane((int)mlo, i);
                if ((mk >> lane) & 1ull) { const int t = blk * 64 + i, j = __builtin_popcountll(mk & ((1ull << lane) - 1ull)); TOK2SLOT[t * 8 + j] = running; SLOTTOK[running] = t; ++running; }
            }
        }
        if (blk == 0) {
            const int nblk = PST[64] >> 8;
            if (F.tid == 0) NBLK[0] = nblk;
            for (int ee = F.wave; ee < 64; ee += NWAVES) { const int s0 = PST[ee] + TOT[ee], s1 = PST[ee + 1]; for (int s = s0 + lane; s < s1; s += 64) SLOTTOK[s] = 0;
                for (int j = (PST[ee] >> 8) + lane; j < (PST[ee + 1] >> 8); j += 64) BLKE[j] = ee; }
            for (int j = F.tid; j < 64; j += NTHR) BLKE[MAXSLOT / 256 + j] = 64;
        }
        for (int i = F.tid; i < 64; i += NTHR) SLOTTOK[MAXSLOT + blk * 64 + i] = blk * 64 + i;
        __syncthreads();
    }
}

constexpr int MOE_TOKL = 131072, MOE_BLKL = 131072 + 12288;
struct MoeOrder2 {
    const LAS int* blke_l; int nblk, NT, G, c;
    __device__ bool next(int i, pg8::Unit& u) const {
        const int L = i * G + c; if (L >= (nblk + 64) * NT) return false;
        const int j = L / NT, pl = L - j * NT, jj = j < nblk ? j : (MAXSLOT / 256 + (j - nblk));
        u.pm = jj; u.pn = __builtin_amdgcn_readfirstlane(blke_l[i]) * NT + pl; return true;
    }
};
template <bool GATHER> __device__ __forceinline__ void moe_fill(Frame& F, int nblk, int NT) {
    const int* BLKE = (const int*)(F.ws + WS_MISC + MS_BLKE); const int* SLOTTOK = (const int*)(F.ws + WS_MISC + MS_SLOTTOK);
    LAS int* TOKL = (LAS int*)(F.lds + MOE_TOKL); LAS int* BLKL = (LAS int*)(F.lds + MOE_BLKL);
    const int total = (nblk + 64) * NT;
    for (int i = 0; i < (GATHER ? 12 : 64); ++i) { const int L = i * F.G + F.bid; if (L >= total) break;
        const int j = L / NT, jj = j < nblk ? j : (MAXSLOT / 256 + (j - nblk));
        if (F.tid == 0) BLKL[i] = BLKE[jj];
        if (GATHER && F.tid < 256) TOKL[i * 256 + F.tid] = SLOTTOK[jj * 256 + F.tid]; }
    __syncthreads();
}

__device__ __forceinline__ void phase_combine(Frame& F, const Args& a, int l) {
    const int gw = F.bid * NWAVES + F.wave, NGW = F.G * NWAVES;
    const GAS char* X1 = (const GAS char*)(F.ws + WS_H); const GAS char* OS = (const GAS char*)(F.ws + WS_OS);
    const int* TOK2SLOT = (const int*)(F.ws + WS_MISC + MS_TOK2SLOT); const float* SELW = (const float*)(F.ws + WS_MISC + MS_SELW);
    GAS char* XRES = (GAS char*)((l == DEPTH - 1) ? a.out : (float*)(F.ws + WS_XRES)); GAS char* XB = (GAS char*)(F.ws + WS_XB);
    const GAS char* gp = (const GAS char*)(a.in[25] + (size_t)l * D); const GAS char* bp = (const GAS char*)(a.in[26] + (size_t)l * D);
    for (int m = gw; m < T; m += NGW) {
        int ln = F.lane; asm volatile("" : "+v"(ln));
        const unsigned o32 = (unsigned)ln * 32u, o8 = (unsigned)ln * 8u;
        int slot[8]; float wt[8];
#pragma unroll
        for (int k = 0; k < 8; ++k) { slot[k] = __builtin_amdgcn_readfirstlane(TOK2SLOT[m * 8 + k]); wt[k] = __builtin_bit_cast(float, __builtin_amdgcn_readfirstlane(__builtin_bit_cast(int, SELW[m * 8 + k]))) * (1.0f / OSCALE); }
        const GAS char* xr = X1 + (size_t)m * (D * 2); const GAS char* shr = OS + (size_t)(MAXSLOT + m) * D;
        float v[4][8];
#pragma unroll
        for (int j = 0; j < 4; ++j) {
            const u32x4 xp8 = *(const GAS u32x4*)(xr + 2u * o8 + 1024 * j);
            const u32x2 sh = *(const GAS u32x2*)(shr + o8 + 512 * j);
            u32x2 ex[8];
#pragma unroll
            for (int k = 0; k < 8; ++k) ex[k] = *(const GAS u32x2*)(OS + (size_t)slot[k] * D + o8 + 512 * j);
            float acc[8] = {bflo(xp8.x) * ALPHA, bfhi(xp8.x) * ALPHA, bflo(xp8.y) * ALPHA, bfhi(xp8.y) * ALPHA, bflo(xp8.z) * ALPHA, bfhi(xp8.z) * ALPHA, bflo(xp8.w) * ALPHA, bfhi(xp8.w) * ALPHA};
            {   float f0[4], f1[4]; unpk4_fp8(sh.x, f0); unpk4_fp8(sh.y, f1);
#pragma unroll
                for (int q = 0; q < 4; ++q) { acc[q] += f0[q] * (1.0f / OSCALE); acc[4 + q] += f1[q] * (1.0f / OSCALE); } }
#pragma unroll
            for (int k = 0; k < 8; ++k) { float f0[4], f1[4]; unpk4_fp8(ex[k].x, f0); unpk4_fp8(ex[k].y, f1);
#pragma unroll
                for (int q = 0; q < 4; ++q) { acc[q] += wt[k] * f0[q]; acc[4 + q] += wt[k] * f1[q]; } }
#pragma unroll
            for (int q = 0; q < 8; ++q) v[j][q] = acc[q];
        }
        float s = 0.f;
#pragma unroll
        for (int j = 0; j < 4; ++j)
#pragma unroll
            for (int q = 0; q < 8; ++q) s += v[j][q];
        const float mean = wave_sum(s) * (1.f / D); float s2 = 0.f;
#pragma unroll
        for (int j = 0; j < 4; ++j)
#pragma unroll
            for (int q = 0; q < 8; ++q) { v[j][q] -= mean; s2 += v[j][q] * v[j][q]; }
        const float rstd = 1.f / sqrtf(wave_sum(s2) * (1.f / D) + EPS);
        GAS char* orow = XRES + (size_t)m * (D * 4); GAS char* orow16 = XRES + (size_t)m * (D * 2); GAS char* xbr = XB + (size_t)m * D;
#pragma unroll
        for (int j = 0; j < 4; ++j) { const f32x4 g0 = *(const GAS f32x4*)(gp + o32 + 2048 * j), g1 = *(const GAS f32x4*)(gp + o32 + 2048 * j + 16), b0 = *(const GAS f32x4*)(bp + o32 + 2048 * j), b1 = *(const GAS f32x4*)(bp + o32 + 2048 * j + 16);
            const f32x4 y0 = {v[j][0] * rstd * g0.x + b0.x, v[j][1] * rstd * g0.y + b0.y, v[j][2] * rstd * g0.z + b0.z, v[j][3] * rstd * g0.w + b0.w};
            const f32x4 y1 = {v[j][4] * rstd * g1.x + b1.x, v[j][5] * rstd * g1.y + b1.y, v[j][6] * rstd * g1.z + b1.z, v[j][7] * rstd * g1.w + b1.w};
            if (l == DEPTH - 1) { *(GAS f32x4*)(orow + o32 + 2048 * j) = y0; *(GAS f32x4*)(orow + o32 + 2048 * j + 16) = y1; }
            else {
                u32x4 wb; wb.x = cvt_pk_bf16(y0.x, y0.y); wb.y = cvt_pk_bf16(y0.z, y0.w); wb.z = cvt_pk_bf16(y1.x, y1.y); wb.w = cvt_pk_bf16(y1.z, y1.w); *(GAS u32x4*)(orow16 + 2u * o8 + 1024 * j) = wb;
                u32x2 w; w.x = pk4_fp8(y0.x, y0.y, y0.z, y0.w); w.y = pk4_fp8(y1.x, y1.y, y1.z, y1.w); *(GAS u32x2*)(xbr + o8 + 512 * j) = w; } }
    }
}

typedef short v4i16_t __attribute__((ext_vector_type(4)));
__device__ __forceinline__ unsigned offb(unsigned row, unsigned ch) { return 256u * row + 16u * (ch ^ (((row & 3u) << 2) | ((row >> 2) & 3u))); }
__device__ __forceinline__ s16x4 trr(const LAS unsigned char* p) { return __builtin_bit_cast(s16x4, __builtin_amdgcn_ds_read_tr16_b64_v4i16((LAS v4i16_t*)p)); }
#define MFMA32(a, b, c) __builtin_amdgcn_mfma_f32_32x32x16_bf16((a), (b), (c), 0, 0, 0)
__device__ __forceinline__ int crow(int i, int hh) { return (i & 3) + 8 * (i >> 2) + 4 * hh; }
__device__ __forceinline__ bf16x8 frag_row(const LAS unsigned char* img, int row0, int s, int lane) { return *(const LAS bf16x8*)(img + offb(row0 + (lane & 31), 2 * s + (lane >> 5))); }
template <bool PERMK> __device__ __forceinline__ bf16x8 frag_tr(const LAS unsigned char* img, int cb, int k0, int lane) {
    const int hh = lane >> 5, blk = (lane >> 4) & 1, q = (lane & 15) >> 2, p = lane & 3;
    const int r0 = PERMK ? (k0 + 4 * hh + q) : (k0 + 8 * hh + q), r1 = PERMK ? (r0 + 8) : (r0 + 4);
    const int ch = 4 * cb + 2 * blk + (p >> 1);
    const s16x4 lo = trr(img + offb(r0, ch) + 8 * (p & 1)), hi = trr(img + offb(r1, ch) + 8 * (p & 1));
    return __builtin_shufflevector(lo, hi, 0, 1, 2, 3, 4, 5, 6, 7);
}
__device__ __forceinline__ bf16x8 pack_acc(const f32x16& x, int half) {
    u32x4 p;
    if (half == 0) { p.x = cvtpk(x[0], x[1]); p.y = cvtpk(x[2], x[3]); p.z = cvtpk(x[4], x[5]); p.w = cvtpk(x[6], x[7]); }
    else { p.x = cvtpk(x[8], x[9]); p.y = cvtpk(x[10], x[11]); p.z = cvtpk(x[12], x[13]); p.w = cvtpk(x[14], x[15]); }
    return __builtin_bit_cast(bf16x8, p);
}

__device__ __forceinline__ void attn_unit(Frame& F, const bf16_t* PROJ, fp8_t* BRCAT, const float* normg, int b, int h, int j, float lam, float lam_init) {
    int tid_ = F.tid; asm volatile("" : "+v"(tid_));
    const int tid = tid_, lane = tid & 63, w = F.wave, c = w >> 2, r0 = 32 * (w & 3), r32 = lane & 31, hh = lane >> 5;
    LAS unsigned char* lds = F.lds;
    unsigned rowa = offb(r32, hh), tb[4][2];
    {   const int blk = (lane >> 4) & 1, q = (lane & 15) >> 2, p = lane & 3; const unsigned tra = 32768u + offb(4 * hh + q, 2 * blk + (p >> 1)) + 8 * (p & 1);
#pragma unroll
        for (int cb = 0; cb < 4; ++cb) { tb[cb][0] = tra ^ (64u * cb); tb[cb][1] = ((tra ^ (64u * cb)) ^ 32u) + 2048u; asm volatile("" : "+v"(tb[cb][0]), "+v"(tb[cb][1])); } }
    asm volatile("" : "+v"(rowa));
    const unsigned kq = (unsigned)(c * 16384), qq = (unsigned)(65536 + w * 8192);
    unsigned ko = (unsigned)(((tid >> 4) * NPROJ + PQ_DAK + h * 256 + 8 * (tid & 15)) * 2), vo = (unsigned)(((tid >> 5) * NPROJ + PQ_DAV + h * 256 + 8 * (tid & 31)) * 2);
    unsigned kl = offb(tid >> 4, tid & 15), vl = 32768u + ((tid >> 4) & 1) * 16384u + offb(tid >> 5, tid & 15);
    asm volatile("" : "+v"(ko), "+v"(vo), "+v"(kl), "+v"(vl));
    const float c1 = 0.08838834764831845f * 1.4426950408889634f;
    __syncthreads();
    {   int ln = lane; asm volatile("" : "+v"(ln));
        const char* qp = (const char*)(PROJ + ((size_t)b * SEQ + 128 * j + r0) * NPROJ + PQ_DAQ + h * 256 + c * 128);
#pragma unroll
        for (int i = 0; i < 8; ++i) { const int id = ln + 64 * i, row = id >> 4, ch = id & 15; const u32x4 qv = *(const u32x4*)(qp + (unsigned)((row * NPROJ + 8 * ch) * 2));
            u32x4 qs; qs.x = cvtpk(bflo(qv.x) * c1, bfhi(qv.x) * c1); qs.y = cvtpk(bflo(qv.y) * c1, bfhi(qv.y) * c1); qs.z = cvtpk(bflo(qv.z) * c1, bfhi(qv.z) * c1); qs.w = cvtpk(bflo(qv.w) * c1, bfhi(qv.w) * c1);
            *(LAS u32x4*)(lds + qq + offb(row, ch)) = qs; } }
    f32x16 o[8];
#pragma unroll
    for (int eb = 0; eb < 8; ++eb)
#pragma unroll
        for (int i = 0; i < 16; ++i) o[eb][i] = 0.f;
    float mrun = 0.f, lrun = 0.f;
    const int qpos = 128 * j + r0 + r32;
    const float c2 = __builtin_amdgcn_exp2f(-2.0f * (float)(h + 1)) * 1.4426950408889634f;
    const int nt = 2 * (j + 1);
    u32x4 k1a, k2a, k1b, k2b, v0, v1, v2, v3;
#define ATT_LOAD(kt_) do { const char* kb_ = (const char*)(PROJ + ((size_t)b * SEQ + 64 * (kt_)) * NPROJ); \
        k1a = *(const u32x4*)(kb_ + ko); k2a = *(const u32x4*)(kb_ + ko + 256); k1b = *(const u32x4*)(kb_ + ko + 32 * NPROJ * 2); k2b = *(const u32x4*)(kb_ + ko + 32 * NPROJ * 2 + 256); \
        v0 = *(const u32x4*)(kb_ + vo); v1 = *(const u32x4*)(kb_ + vo + 16 * NPROJ * 2); v2 = *(const u32x4*)(kb_ + vo + 32 * NPROJ * 2); v3 = *(const u32x4*)(kb_ + vo + 48 * NPROJ * 2); } while (0)
    ATT_LOAD(0);
    for (int kt = 0; kt < nt; ++kt) {
        __syncthreads();
        *(LAS u32x4*)(lds + kl) = k1a; *(LAS u32x4*)(lds + kl + 16384) = k2a; *(LAS u32x4*)(lds + kl + 8192) = k1b; *(LAS u32x4*)(lds + kl + 8192 + 16384) = k2b;
        *(LAS u32x4*)(lds + vl) = v0; *(LAS u32x4*)(lds + vl + 4096) = v1; *(LAS u32x4*)(lds + vl + 8192) = v2; *(LAS u32x4*)(lds + vl + 12288) = v3;
        __syncthreads();
        if (kt + 1 < nt) ATT_LOAD(kt + 1);
        const int kbase = 64 * kt + 4 * hh - qpos;
        const float fkb = c2 * (float)kbase - (kt == 0 ? 0.f : mrun);
        f32x16 p0, p1;
#pragma unroll
        for (int i = 0; i < 16; ++i) { p0[i] = fmaf(c2, (float)((i & 3) + 8 * (i >> 2)), fkb); p1[i] = fmaf(c2, (float)(32 + (i & 3) + 8 * (i >> 2)), fkb); }
#pragma unroll
        for (int s = 0; s < 8; ++s) { const unsigned ra = rowa ^ (32u * s); const bf16x8 a0 = *(const LAS bf16x8*)(lds + kq + ra), a1 = *(const LAS bf16x8*)(lds + kq + ra + 8192), qv = *(const LAS bf16x8*)(lds + qq + ra);
            p0 = MFMA32(a0, qv, p0); p1 = MFMA32(a1, qv, p1); }
        if (kt >= 2 * j) {
#pragma unroll
            for (int i = 0; i < 16; ++i) { const int dk = kbase + (i & 3) + 8 * (i >> 2); if (dk > 0) p0[i] = -INFINITY; if (dk + 32 > 0) p1[i] = -INFINITY; } }
        float mx = fmaxf(p0[0], p1[0]);
#pragma unroll
        for (int i = 1; i < 16; ++i) mx = fmaxf(fmaxf(mx, p0[i]), p1[i]);
        mx = x32_max(mx);
        if (kt == 0) {
#pragma unroll
            for (int i = 0; i < 16; ++i) { p0[i] -= mx; p1[i] -= mx; }
            mrun = mx; mx = 0.f; }
        float psum = 0.f;
#pragma unroll
        for (int i = 0; i < 16; ++i) { p0[i] = __builtin_amdgcn_exp2f(p0[i]); p1[i] = __builtin_amdgcn_exp2f(p1[i]); psum += p0[i] + p1[i]; }
        lrun += psum;
        bf16x8 pf[4]; pf[0] = pack_acc(p0, 0); pf[1] = pack_acc(p0, 1); pf[2] = pack_acc(p1, 0); pf[3] = pack_acc(p1, 1);
#pragma unroll
        for (int ks = 0; ks < 4; ++ks)
#pragma unroll
            for (int eb = 0; eb < 8; ++eb) { const unsigned ab = (eb >> 2) * 16384 + ks * 4096;
                const s16x4 lo = trr(lds + tb[eb & 3][0] + ab), hi = trr(lds + tb[eb & 3][1] + ab);
                const bf16x8 va = __builtin_shufflevector(lo, hi, 0, 1, 2, 3, 4, 5, 6, 7); o[eb] = MFMA32(va, pf[ks], o[eb]); }
        const float dm = fmaxf(mx, 0.f);
        if (__builtin_amdgcn_ballot_w64(dm > 0.f) != 0ull) { const float sc = __builtin_amdgcn_exp2f(-dm);
#pragma unroll
            for (int eb = 0; eb < 8; ++eb) o[eb] = o[eb] * sc;
            lrun *= sc; mrun += dm; }
    }
#undef ATT_LOAD
    asm volatile("" : "+s"(normg), "+s"(BRCAT) :: "memory");
    const GAS float* normg_g = (const GAS float*)normg; GAS fp8_t* brcat_g = (GAS fp8_t*)BRCAT;
    const float lsum = x32_sum(lrun), inv = 1.0f / lsum;
    LAS float* XCH = (LAS float*)lds;
    int ln2 = lane; asm volatile("" : "+v"(ln2));
    const int hh2 = ln2 >> 5;
    __syncthreads();
    if (c == 1) {
        const float sc = inv * lam;
#pragma unroll
        for (int eb = 0; eb < 8; ++eb)
#pragma unroll
            for (int i = 0; i < 16; ++i) XCH[(((w & 3) * 128 + eb * 16 + i) << 6) + ln2] = o[eb][i] * sc;
    }
    __syncthreads();
    if (c == 0) {
        float ss = 0.f;
#pragma unroll
        for (int eb = 0; eb < 8; ++eb)
#pragma unroll
            for (int i = 0; i < 16; ++i) { const float v = o[eb][i] * inv - XCH[(((w & 3) * 128 + eb * 16 + i) << 6) + ln2]; o[eb][i] = v; ss += v * v; }
        ss = x32_sum(ss);
        const float rstd = (1.0f - lam_init) / sqrtf(ss * (1.0f / 256.0f) + EPS);
        GAS char* op = (GAS char*)(brcat_g + ((size_t)b * SEQ + 128 * j + r0) * 3072 + h * 256);
        const unsigned oo = (unsigned)((ln2 & 31) * 3072 + 4 * hh2);
#pragma unroll
        for (int eb = 0; eb < 8; ++eb)
#pragma unroll
            for (int g = 0; g < 4; ++g) { const int e0 = 32 * eb + 8 * g; const f32x4 gn = *(const GAS f32x4*)(normg_g + e0 + 4 * hh2);
                *(GAS unsigned*)(op + oo + e0) = pk4_fp8(o[eb][4 * g] * rstd * gn.x, o[eb][4 * g + 1] * rstd * gn.y, o[eb][4 * g + 2] * rstd * gn.z, o[eb][4 * g + 3] * rstd * gn.w); }
    }
}
__device__ __forceinline__ void phase_attn(Frame& F, const Args& a, int l) {
    const bf16_t* PROJ = (const bf16_t*)(F.ws + WS_PROJ); fp8_t* BRCAT = (fp8_t*)(F.ws + WS_BRCAT);
    const float* lp = a.in[2] + (size_t)l * 4 * 128; const float* normg = a.in[3] + (size_t)l * 256;
    const float s01 = wave_sum(lp[F.lane] * lp[128 + F.lane] + lp[64 + F.lane] * lp[192 + F.lane]);
    const float s23 = wave_sum(lp[256 + F.lane] * lp[384 + F.lane] + lp[320 + F.lane] * lp[448 + F.lane]);
    const float lam_init = 0.8f - 0.6f * expf(-0.3f * (float)l);
    const float lam = __builtin_bit_cast(float, __builtin_amdgcn_readfirstlane(__builtin_bit_cast(int, expf(s01) - expf(s23) + lam_init)));
    volatile LAS unsigned* qslot = (volatile LAS unsigned*)(F.lds + MISC_OFF + 128);
    for (;;) {
        __syncthreads();
        if (F.tid == 0) *qslot = __hip_atomic_fetch_add((unsigned*)(F.ws + WS_CTL) + CW_ATTQ + 64 * l, 1u, __ATOMIC_RELAXED, __HIP_MEMORY_SCOPE_AGENT);
        __syncthreads();
        const int k = __builtin_amdgcn_readfirstlane((int)*qslot);
        if (k >= 512) break;
        const int bh = k & 15, b = bh >> 2, h = bh & 3;
        attn_unit(F, PROJ, BRCAT, normg, b, h, 31 - (k >> 4), lam, lam_init);
    }
}


__device__ __forceinline__ void gla_gates(Frame& F, const float* SMALL, const float* w2, const float* b2, int h, size_t t0, float (&bc)[16], float& btot) {
    LAS float* LR = (LAS float*)F.lds; LAS float* GT = (LAS float*)(F.lds + 4096);
    const int tid = F.tid, d = tid & 127, g4 = tid >> 7;
#pragma unroll
    for (int i = 0; i < 2; ++i) { const int id = tid + 512 * i, pos = id >> 4, r = id & 15; LR[id] = SMALL[(t0 + pos) * 32 + r]; }
    float wv[16];
#pragma unroll
    for (int r = 0; r < 16; ++r) wv[r] = w2[r * 512 + h * 128 + d];
    const float bb = b2[h * 128 + d];
    __syncthreads();
    float run = 0.f;
#pragma unroll
    for (int i = 0; i < 16; ++i) { const int pos = 16 * g4 + i; float z = bb;
#pragma unroll
        for (int r4 = 0; r4 < 4; ++r4) { const f32x4 lv = *(const LAS f32x4*)(LR + pos * 16 + 4 * r4); z += lv.x * wv[4 * r4] + lv.y * wv[4 * r4 + 1] + lv.z * wv[4 * r4 + 2] + lv.w * wv[4 * r4 + 3]; }
        const float ls = fminf(z, 0.f) - fast_log(1.0f + fast_exp(-fabsf(z)));
        run += ls * (1.0f / 16.0f); bc[i] = run; }
    GT[g4 * 128 + d] = run;
    __syncthreads();
    float pre = 0.f, tot = 0.f;
#pragma unroll
    for (int q = 0; q < 4; ++q) { const float v = GT[q * 128 + d]; tot += v; pre += (q < g4) ? v : 0.f; }
#pragma unroll
    for (int i = 0; i < 16; ++i) bc[i] += pre;
    btot = tot;
}
__device__ __forceinline__ void gla_stage_v(Frame& F, const bf16_t* PROJ, int h, size_t t0, int voff) {
#pragma unroll
    for (int i = 0; i < 4; ++i) { const int cid = F.tid + 512 * i, row = cid >> 5, c32 = cid & 31;
        const u32x4 v = *(const u32x4*)(PROJ + (t0 + row) * NPROJ + PQ_GV + h * 256 + 8 * c32);
        *(LAS u32x4*)(F.lds + voff + (c32 >> 4) * 16384 + offb(row, c32 & 15)) = v; }
}
__device__ __forceinline__ void gla_stage128(Frame& F, const bf16_t* PROJ, int col0, size_t t0, int off) {
#pragma unroll
    for (int i = 0; i < 2; ++i) { const int cid = F.tid + 512 * i, row = cid >> 4, ch = cid & 15;
        *(LAS u32x4*)(F.lds + off + offb(row, ch)) = *(const u32x4*)(PROJ + (t0 + row) * NPROJ + col0 + 8 * ch); }
}
__device__ __forceinline__ void phase_gla_local(Frame& F, const Args& a, int l) {
    const bf16_t* PROJ = (const bf16_t*)(F.ws + WS_PROJ); const float* SMALL = (const float*)(F.ws + WS_SMALL);
    bf16_t* UPDT = (bf16_t*)(F.ws + WS_UPDT); float* GDEC = (float*)(F.ws + WS_GDEC);
    const float* w2 = a.in[4] + (size_t)l * 16 * 512; const float* b2 = a.in[5] + (size_t)l * 512;
    const int w = F.wave;
    constexpr int KDT = 8192, VOFF = 40960, KRAW = 73728;
    u32x4 pk[2], pv[4];
    auto ldkv = [&](int uu) { const int bh2 = uu >> 6, n2 = uu & 63, b2i = bh2 >> 2, h2 = bh2 & 3; const size_t tt = (size_t)b2i * SEQ + 64 * n2;
#pragma unroll
        for (int i = 0; i < 2; ++i) { const int cid = F.tid + 512 * i, row = cid >> 4, ch = cid & 15; pk[i] = *(const u32x4*)(PROJ + (tt + row) * NPROJ + PQ_GK + h2 * 128 + 8 * ch); }
#pragma unroll
        for (int i = 0; i < 4; ++i) { const int cid = F.tid + 512 * i, row = cid >> 5, c32 = cid & 31; pv[i] = *(const u32x4*)(PROJ + (tt + row) * NPROJ + PQ_GV + h2 * 256 + 8 * c32); } };
    if (F.bid < 1024) ldkv(F.bid);
    for (int u = F.bid; u < 1024; u += F.G) {
        const int bh = u >> 6, n = u & 63, b = bh >> 2, h = bh & 3; const size_t t0 = (size_t)b * SEQ + 64 * n;
        int tid_ = F.tid; asm volatile("" : "+v"(tid_));
        const int tid = tid_, lane = tid & 63, d = tid & 127, g4 = tid >> 7, r32 = lane & 31, hh = lane >> 5;
        __syncthreads();
        float bc[16], btot;
#pragma unroll
        for (int i = 0; i < 2; ++i) { const int cid = F.tid + 512 * i, row = cid >> 4, ch = cid & 15; *(LAS u32x4*)(F.lds + KRAW + offb(row, ch)) = pk[i]; }
#pragma unroll
        for (int i = 0; i < 4; ++i) { const int cid = F.tid + 512 * i, row = cid >> 5, c32 = cid & 31; *(LAS u32x4*)(F.lds + VOFF + (c32 >> 4) * 16384 + offb(row, c32 & 15)) = pv[i]; }
        gla_gates(F, SMALL, w2, b2, h, t0, bc, btot);
        { const int un = u + F.G; ldkv(un < 1024 ? un : u); }
        {   float kd[16];
#pragma unroll
            for (int i = 0; i < 16; ++i) kd[i] = bf2f(*(const LAS unsigned short*)(F.lds + KRAW + offb(16 * g4 + i, d >> 3) + 2 * (d & 7))) * fast_exp(btot - bc[i]);
            u32x4 w0, w1; w0.x = cvtpk(kd[0], kd[1]); w0.y = cvtpk(kd[2], kd[3]); w0.z = cvtpk(kd[4], kd[5]); w0.w = cvtpk(kd[6], kd[7]);
            w1.x = cvtpk(kd[8], kd[9]); w1.y = cvtpk(kd[10], kd[11]); w1.z = cvtpk(kd[12], kd[13]); w1.w = cvtpk(kd[14], kd[15]);
            *(LAS u32x4*)(F.lds + KDT + offb(d, 2 * g4)) = w0; *(LAS u32x4*)(F.lds + KDT + offb(d, 2 * g4 + 1)) = w1;
            if (g4 == 0) GDEC[((size_t)bh * 64 + n) * 128 + d] = fast_exp(btot);
        }
        __syncthreads();
        f32x16 acc[4];
#pragma unroll
        for (int db = 0; db < 4; ++db)
#pragma unroll
            for (int i = 0; i < 16; ++i) acc[db][i] = 0.f;
#pragma unroll
        for (int s = 0; s < 4; ++s) { const bf16x8 va = frag_tr<false>(F.lds + VOFF + (w >> 2) * 16384, w & 3, 16 * s, lane);
#pragma unroll
            for (int db = 0; db < 4; ++db) { const bf16x8 kb = frag_row(F.lds + KDT, 32 * db, s, lane); acc[db] = MFMA32(va, kb, acc[db]); } }
        bf16_t* up = UPDT + ((size_t)bh * 64 + n) * 256 * 128;
#pragma unroll
        for (int db = 0; db < 4; ++db)
#pragma unroll
            for (int i = 0; i < 16; ++i) up[(size_t)(32 * w + crow(i, hh)) * 128 + 32 * db + r32] = (bf16_t)(cvtpk(acc[db][i], 0.f) & 0xffffu);
    }
}
__device__ __forceinline__ void phase_gla_scan(Frame& F) {
    const bf16_t* UPDT = (const bf16_t*)(F.ws + WS_UPDT); const float* GDEC = (const float*)(F.ws + WS_GDEC); bf16_t* SPT = (bf16_t*)(F.ws + WS_SPREVT);
    for (int idx = F.bid * NTHR + F.tid; idx < 16 * 256 * 32; idx += F.G * NTHR) {
        const int bh = idx >> 13, e = (idx >> 5) & 255, d4 = idx & 31;
        f32x4 st = {0.f, 0.f, 0.f, 0.f};
        const size_t base = ((size_t)bh * 64) * 256 * 128 + (size_t)e * 128 + 4 * d4;
#pragma unroll 8
        for (int n = 0; n < 64; ++n) {
            const u32x2 up2 = *(const u32x2*)(UPDT + base + (size_t)n * 256 * 128); const f32x4 uu = {bflo(up2.x), bfhi(up2.x), bflo(up2.y), bfhi(up2.y)}; const f32x4 dc = *(const f32x4*)(GDEC + ((size_t)bh * 64 + n) * 128 + 4 * d4);
            u32x2 o; o.x = cvtpk(st.x, st.y); o.y = cvtpk(st.z, st.w); *(u32x2*)(SPT + base + (size_t)n * 256 * 128) = o;
            st = dc * st + uu; }
    }
}
__device__ __forceinline__ void phase_gla_out(Frame& F, const Args& a, int l) {
    const bf16_t* PROJ = (const bf16_t*)(F.ws + WS_PROJ); const float* SMALL = (const float*)(F.ws + WS_SMALL); const bf16_t* SPT = (const bf16_t*)(F.ws + WS_SPREVT);
    fp8_t* BRCAT = (fp8_t*)(F.ws + WS_BRCAT);
    const float* w2 = a.in[4] + (size_t)l * 16 * 512; const float* b2 = a.in[5] + (size_t)l * 512; const float* normg = a.in[6] + (size_t)l * 256;
    const int w = F.wave;
    constexpr int SSO = 6144, QE = 8192, KE = 24576, VOFF = 40960;
    LAS float* SS = (LAS float*)(F.lds + SSO);
    u32x4 pq[2], pk[2], pv[4];
    auto ldqkv = [&](int uu) { const int bh2 = uu >> 6, n2 = uu & 63, bi2 = bh2 >> 2, h2 = bh2 & 3; const size_t tt = (size_t)bi2 * SEQ + 64 * n2;
#pragma unroll
        for (int i = 0; i < 2; ++i) { const int cid = F.tid + 512 * i, row = cid >> 4, ch = cid & 15; pq[i] = *(const u32x4*)(PROJ + (tt + row) * NPROJ + PQ_GQ + h2 * 128 + 8 * ch); pk[i] = *(const u32x4*)(PROJ + (tt + row) * NPROJ + PQ_GK + h2 * 128 + 8 * ch); }
#pragma unroll
        for (int i = 0; i < 4; ++i) { const int cid = F.tid + 512 * i, row = cid >> 5, c32 = cid & 31; pv[i] = *(const u32x4*)(PROJ + (tt + row) * NPROJ + PQ_GV + h2 * 256 + 8 * c32); } };
    if (F.bid < 1024) ldqkv(F.bid);
    for (int u = F.bid; u < 1024; u += F.G) {
        const int bh = u >> 6, n = u & 63, b = bh >> 2, h = bh & 3; const size_t t0 = (size_t)b * SEQ + 64 * n;
        int tid_ = F.tid; asm volatile("" : "+v"(tid_));
        const int tid = tid_, lane = tid & 63, d = tid & 127, g4 = tid >> 7, r32 = lane & 31, hh = lane >> 5;
        bf16x8 spf[8]; u32x2 rvp[2][4];
        {   const bf16_t* sp = SPT + (((size_t)bh * 64 + n) * 256 + 32 * w + r32) * 128 + 8 * hh;
#pragma unroll
            for (int ks = 0; ks < 8; ++ks) spf[ks] = *(const bf16x8*)(sp + 16 * ks);
#pragma unroll
            for (int qb = 0; qb < 2; ++qb)
#pragma unroll
                for (int g = 0; g < 4; ++g) rvp[qb][g] = *(const u32x2*)(PROJ + (t0 + 32 * qb + r32) * NPROJ + PQ_GR + h * 256 + 32 * w + 8 * g + 4 * hh); }
        __syncthreads();
        float bc[16], btot;
#pragma unroll
        for (int i = 0; i < 2; ++i) { const int cid = F.tid + 512 * i, row = cid >> 4, ch = cid & 15; *(LAS u32x4*)(F.lds + QE + offb(row, ch)) = pq[i]; *(LAS u32x4*)(F.lds + KE + offb(row, ch)) = pk[i]; }
#pragma unroll
        for (int i = 0; i < 4; ++i) { const int cid = F.tid + 512 * i, row = cid >> 5, c32 = cid & 31; *(LAS u32x4*)(F.lds + VOFF + (c32 >> 4) * 16384 + offb(row, c32 & 15)) = pv[i]; }
        gla_gates(F, SMALL, w2, b2, h, t0, bc, btot);
#pragma unroll
        for (int i = 0; i < 16; ++i) { const int pos = 16 * g4 + i; const float eb = fast_exp(bc[i]), reb = __builtin_amdgcn_rcpf(eb);
            LAS unsigned short* qa = (LAS unsigned short*)(F.lds + QE + offb(pos, d >> 3) + 2 * (d & 7)); LAS unsigned short* ka = (LAS unsigned short*)(F.lds + KE + offb(pos, d >> 3) + 2 * (d & 7));
            const float qv = bf2f(*qa) * 0.08838834764831845f * eb, kv = bf2f(*ka) * reb;
            *qa = f2bf(qv); *ka = f2bf(kv); }
        __syncthreads();
        f32x16 att[2][2];
#pragma unroll
        for (int sb = 0; sb < 2; ++sb)
#pragma unroll
            for (int qb = 0; qb < 2; ++qb)
#pragma unroll
                for (int i = 0; i < 16; ++i) att[sb][qb][i] = 0.f;
#pragma unroll
        for (int ks = 0; ks < 8; ++ks) { const bf16x8 k0 = frag_row(F.lds + KE, 0, ks, lane), k1 = frag_row(F.lds + KE, 32, ks, lane), q0 = frag_row(F.lds + QE, 0, ks, lane), q1 = frag_row(F.lds + QE, 32, ks, lane);
            att[0][0] = MFMA32(k0, q0, att[0][0]); att[0][1] = MFMA32(k0, q1, att[0][1]); att[1][0] = MFMA32(k1, q0, att[1][0]); att[1][1] = MFMA32(k1, q1, att[1][1]); }
#pragma unroll
        for (int sb = 0; sb < 2; ++sb)
#pragma unroll
            for (int qb = 0; qb < 2; ++qb)
#pragma unroll
                for (int i = 0; i < 16; ++i) { const int sp = 32 * sb + crow(i, hh), qp = 32 * qb + r32; if (sp > qp) att[sb][qb][i] = 0.f; }
        f32x16 o[2];
#pragma unroll
        for (int qb = 0; qb < 2; ++qb)
#pragma unroll
            for (int i = 0; i < 16; ++i) o[qb][i] = 0.f;
#pragma unroll
        for (int ks = 0; ks < 4; ++ks) { const bf16x8 va = frag_tr<true>(F.lds + VOFF + (w >> 2) * 16384, w & 3, 16 * ks, lane);
#pragma unroll
            for (int qb = 0; qb < 2; ++qb) { const bf16x8 pf = pack_acc(att[ks >> 1][qb], ks & 1); o[qb] = MFMA32(va, pf, o[qb]); } }
#pragma unroll
        for (int ks = 0; ks < 8; ++ks) {
#pragma unroll
            for (int qb = 0; qb < 2; ++qb) { const bf16x8 qf = frag_row(F.lds + QE, 32 * qb, ks, lane); o[qb] = MFMA32(spf[ks], qf, o[qb]); } }
        f32x4 gnv[4];
#pragma unroll
        for (int g = 0; g < 4; ++g) gnv[g] = *(const f32x4*)(normg + 32 * w + 8 * g + 4 * hh);
        { const int un = u + F.G; ldqkv(un < 1024 ? un : u); }
#pragma unroll
        for (int qb = 0; qb < 2; ++qb) { float ss = 0.f;
#pragma unroll
            for (int i = 0; i < 16; ++i) ss += o[qb][i] * o[qb][i];
            ss = x32_sum(ss);
            if (hh == 0) SS[w * 64 + 32 * qb + r32] = ss; }
        __syncthreads();
#pragma unroll
        for (int qb = 0; qb < 2; ++qb) { float tot = 0.f;
#pragma unroll
            for (int q = 0; q < 8; ++q) tot += SS[q * 64 + 32 * qb + r32];
            const float rstd = __builtin_amdgcn_rsqf(tot * (1.0f / 256.0f) + EPS);
            const size_t t = t0 + 32 * qb + r32;
#pragma unroll
            for (int g = 0; g < 4; ++g) { const int e0 = 32 * w + 8 * g + 4 * hh; const f32x4 gn = gnv[g];
                const u32x2 rv = rvp[qb][g];
                const float y0 = o[qb][4 * g] * rstd * gn.x * siluf_(bflo(rv.x)), y1 = o[qb][4 * g + 1] * rstd * gn.y * siluf_(bfhi(rv.x));
                const float y2 = o[qb][4 * g + 2] * rstd * gn.z * siluf_(bflo(rv.y)), y3 = o[qb][4 * g + 3] * rstd * gn.w * siluf_(bfhi(rv.y));
                *(unsigned*)(BRCAT + t * 3072 + 1024 + h * 256 + e0) = pk4_fp8(y0, y1, y2, y3); } }
    }
}

constexpr int SD_DT = 0, SD_ACS = 2048, SD_WT = 4096, SD_SSX = 4352, SD_XT = 8192, SD_BT = 73728, SD_CT = 106496;
__device__ __forceinline__ void ssd_tables(Frame& F, const Args& a, int l, const float* SMALL, int g, size_t t0, int tid) {
    LAS float* DT = (LAS float*)(F.lds + SD_DT); LAS float* ACS = (LAS float*)(F.lds + SD_ACS); LAS float* WT = (LAS float*)(F.lds + SD_WT);
    const int lane = tid & 63, hq = tid >> 7, pos = tid & 127, hd = 4 * g + hq;
    const float raw = SMALL[(t0 + pos) * 32 + 16 + hd] + a.in[9][l * 16 + hd];
    const float dt = raw > 20.f ? raw : logf(1.0f + expf(raw));
    const float A = -expf(a.in[10][l * 16 + hd]);
    float incl = wave_scan_f(dt * A, lane);
    if (lane == 63) WT[F.wave] = incl;
    __syncthreads();
    if (F.wave & 1) incl += WT[F.wave - 1];
    DT[hq * 128 + pos] = dt; ACS[hq * 128 + pos] = incl;
    __syncthreads();
}
struct SsdRows { u32x4 r[19]; };
template <int MODE> __device__ __forceinline__ void ssd_conv_load(SsdRows& R, const bf16_t* PROJ, int g, int n, size_t t0, int tid) {
    const int cg = tid & 63, seg = tid >> 6, pos0 = 16 * seg;
    const int cc0 = cg < 32 ? g * 256 + 8 * cg : (cg < 48 ? 1024 + g * 128 + 8 * (cg - 32) : 1536 + g * 128 + 8 * (cg - 48));
    const bf16_t* src = PROJ + (t0 + pos0) * NPROJ + PQ_SX + cc0;
    const bool havehalo = (n > 0) || (seg > 0);
#pragma unroll
    for (int p = 0; p < 19; ++p) { if ((p >= 3 || havehalo) && !(MODE == 0 && cg >= 48)) R.r[p] = *(const u32x4*)(src + (ptrdiff_t)(p - 3) * NPROJ); else R.r[p] = (u32x4){0u, 0u, 0u, 0u}; }
}
template <int MODE> __device__ __forceinline__ void ssd_conv(Frame& F, const Args& a, int l, const SsdRows& R, int g, int tid) {
    const LAS float* DT = (const LAS float*)(F.lds + SD_DT); const LAS float* ACS = (const LAS float*)(F.lds + SD_ACS);
    const int cg = tid & 63, seg = tid >> 6, pos0 = 16 * seg;
    if (MODE == 0 && cg >= 48) return;
    int cc0, row0; LAS unsigned char* img;
    if (cg < 32) { cc0 = g * 256 + 8 * cg; img = F.lds + SD_XT; row0 = 8 * cg; }
    else if (cg < 48) { cc0 = 1024 + g * 128 + 8 * (cg - 32); img = F.lds + SD_BT; row0 = 8 * (cg - 32); }
    else { cc0 = 1536 + g * 128 + 8 * (cg - 48); img = F.lds + SD_CT; row0 = 8 * (cg - 48); }
    const float* cw = a.in[7] + (size_t)l * 4 * 2048 + cc0; const float* cbp = a.in[8] + (size_t)l * 2048 + cc0;
    float wt[4][8], cb[8];
#pragma unroll
    for (int j = 0; j < 4; ++j) { const f32x4 w0 = *(const f32x4*)(cw + 2048 * j), w1 = *(const f32x4*)(cw + 2048 * j + 4); wt[j][0] = w0.x; wt[j][1] = w0.y; wt[j][2] = w0.z; wt[j][3] = w0.w; wt[j][4] = w1.x; wt[j][5] = w1.y; wt[j][6] = w1.z; wt[j][7] = w1.w; }
    {   const f32x4 b0 = *(const f32x4*)cbp, b1 = *(const f32x4*)(cbp + 4); cb[0] = b0.x; cb[1] = b0.y; cb[2] = b0.z; cb[3] = b0.w; cb[4] = b1.x; cb[5] = b1.y; cb[6] = b1.z; cb[7] = b1.w; }
    const int hq = cg >> 3;
    const float alast = (MODE == 0 && cg < 32) ? ACS[hq * 128 + 127] : 0.f;
    float sc[16];
#pragma unroll
    for (int p = 0; p < 16; ++p) { sc[p] = 1.0f; if (cg < 32) { sc[p] = DT[hq * 128 + pos0 + p]; if (MODE == 0) sc[p] *= fast_exp(alast - ACS[hq * 128 + pos0 + p]); } }
#pragma unroll
    for (int c = 0; c < 8; ++c) {
        float y[16];
#pragma unroll
        for (int p = 0; p < 16; ++p) { float v = cb[c];
#pragma unroll
            for (int j = 0; j < 4; ++j) { const unsigned wv = R.r[p + j][c >> 1]; v += wt[j][c] * ((c & 1) ? bfhi(wv) : bflo(wv)); }
            y[p] = siluf_(v) * sc[p]; }
        u32x4 o0, o1; o0.x = cvtpk(y[0], y[1]); o0.y = cvtpk(y[2], y[3]); o0.z = cvtpk(y[4], y[5]); o0.w = cvtpk(y[6], y[7]);
        o1.x = cvtpk(y[8], y[9]); o1.y = cvtpk(y[10], y[11]); o1.z = cvtpk(y[12], y[13]); o1.w = cvtpk(y[14], y[15]);
        *(LAS u32x4*)(img + offb(row0 + c, 2 * seg)) = o0; *(LAS u32x4*)(img + offb(row0 + c, 2 * seg + 1)) = o1; }
}
__device__ __forceinline__ void phase_ssd_local(Frame& F, const Args& a, int l) {
    const bf16_t* PROJ = (const bf16_t*)(F.ws + WS_PROJ); const float* SMALL = (const float*)(F.ws + WS_SMALL);
    bf16_t* STATES = (bf16_t*)(F.ws + WS_STATES); float* ALAST = (float*)(F.ws + WS_ALAST);
    const int w = F.wave;
    SsdRows R;
    if (F.bid < 512) { const int u0 = F.bid; ssd_conv_load<0>(R, PROJ, u0 & 3, (u0 >> 2) & 31, (size_t)(u0 >> 7) * SEQ + 128 * ((u0 >> 2) & 31), F.tid); }
    for (int u = F.bid; u < 512; u += F.G) {
        const int b = u >> 7, n = (u >> 2) & 31, g = u & 3; const size_t t0 = (size_t)b * SEQ + 128 * n;
        int tid_ = F.tid; asm volatile("" : "+v"(tid_));
        __syncthreads();
        ssd_tables(F, a, l, SMALL, g, t0, tid_);
        ssd_conv<0>(F, a, l, R, g, tid_);
        { const int un = (u + F.G < 512) ? u + F.G : u; ssd_conv_load<0>(R, PROJ, un & 3, (un >> 2) & 31, (size_t)(un >> 7) * SEQ + 128 * ((un >> 2) & 31), tid_); }
        if (F.tid < 4) ALAST[((size_t)b * 32 + n) * 16 + 4 * g + F.tid] = ((const LAS float*)(F.lds + SD_ACS))[F.tid * 128 + 127];
        __syncthreads();
        int ln = F.lane; asm volatile("" : "+v"(ln));
        const int lane = ln, r32 = lane & 31, hh = lane >> 5;
        const int hd = w >> 1, pb = w & 1;
        f32x16 acc[4];
#pragma unroll
        for (int sb = 0; sb < 4; ++sb)
#pragma unroll
            for (int i = 0; i < 16; ++i) acc[sb][i] = 0.f;
#pragma unroll
        for (int ks = 0; ks < 8; ++ks) { const bf16x8 xa = frag_row(F.lds + SD_XT, 64 * hd + 32 * pb, ks, lane);
#pragma unroll
            for (int sb = 0; sb < 4; ++sb) { const bf16x8 bb = frag_row(F.lds + SD_BT, 32 * sb, ks, lane); acc[sb] = MFMA32(xa, bb, acc[sb]); } }
        bf16_t* sp = STATES + ((((size_t)b * 32 + n) * 16 + 4 * g + hd) * 64) * 128;
#pragma unroll
        for (int sb = 0; sb < 4; ++sb)
#pragma unroll
            for (int i = 0; i < 16; ++i) sp[(size_t)(32 * pb + crow(i, hh)) * 128 + 32 * sb + r32] = (bf16_t)(cvtpk(acc[sb][i], 0.f) & 0xffffu);
    }
}
__device__ __forceinline__ void phase_ssd_scan(Frame& F) {
    const bf16_t* STATES = (const bf16_t*)(F.ws + WS_STATES); const float* ALAST = (const float*)(F.ws + WS_ALAST); bf16_t* SPV = (bf16_t*)(F.ws + WS_SPREV);
    for (int idx = F.bid * NTHR + F.tid; idx < 4 * 16 * 64 * 32; idx += F.G * NTHR) {
        const int b = idx >> 15, hd = (idx >> 11) & 15, ps = idx & 2047;
        f32x4 st = {0.f, 0.f, 0.f, 0.f};
#pragma unroll 8
        for (int n = 0; n < 32; ++n) { const size_t off = ((((size_t)b * 32 + n) * 16 + hd) * 64) * 128 + 4 * ps;
            const u32x2 up2 = *(const u32x2*)(STATES + off); const f32x4 uu = {bflo(up2.x), bfhi(up2.x), bflo(up2.y), bfhi(up2.y)}; const float dc = fast_exp(ALAST[((size_t)b * 32 + n) * 16 + hd]);
            u32x2 o; o.x = cvtpk(st.x, st.y); o.y = cvtpk(st.z, st.w); *(u32x2*)(SPV + off) = o;
            st = st * dc + uu; }
    }
}
__device__ __forceinline__ void phase_ssd_out(Frame& F, const Args& a, int l) {
    const bf16_t* PROJ = (const bf16_t*)(F.ws + WS_PROJ); const float* SMALL = (const float*)(F.ws + WS_SMALL); const bf16_t* SPV = (const bf16_t*)(F.ws + WS_SPREV);
    fp8_t* BRCAT = (fp8_t*)(F.ws + WS_BRCAT);
    const float* normg = a.in[12] + (size_t)l * 1024;
    const int w = F.wave, lb = w & 3, hp = w >> 2;
    const LAS float* DT = (const LAS float*)(F.lds + SD_DT); const LAS float* ACS = (const LAS float*)(F.lds + SD_ACS); LAS float* SSX = (LAS float*)(F.lds + SD_SSX);
    for (int u = F.bid; u < 512; u += F.G) {
        const int b = u >> 7, n = (u >> 2) & 31, g = u & 3; const size_t t0 = (size_t)b * SEQ + 128 * n;
        int tid_ = F.tid; asm volatile("" : "+v"(tid_));
        SsdRows R; ssd_conv_load<1>(R, PROJ, g, n, t0, tid_);
        __syncthreads();
        ssd_tables(F, a, l, SMALL, g, t0, tid_);
        ssd_conv<1>(F, a, l, R, g, tid_);
        __syncthreads();
        int ln = F.lane; asm volatile("" : "+v"(ln));
        const int lane = ln, r32 = lane & 31, hh = lane >> 5, lpos = 32 * lb + r32;
        f32x16 y[2][2];
#pragma unroll
        for (int hi = 0; hi < 2; ++hi)
#pragma unroll
            for (int pb = 0; pb < 2; ++pb)
#pragma unroll
                for (int i = 0; i < 16; ++i) y[hi][pb][i] = 0.f;
        {   const bf16_t* sp0 = SPV + (((((size_t)b * 32 + n) * 16 + 4 * g + 2 * hp) * 64) + r32) * 128 + 8 * hh;
#pragma unroll
            for (int ks = 0; ks < 8; ++ks) { const bf16x8 cf = frag_tr<false>(F.lds + SD_CT, lb, 16 * ks, lane);
#pragma unroll
                for (int hi = 0; hi < 2; ++hi)
#pragma unroll
                    for (int pb = 0; pb < 2; ++pb) { const bf16x8 sa = *(const bf16x8*)(sp0 + (size_t)(hi * 64 + 32 * pb) * 128 + 16 * ks); y[hi][pb] = MFMA32(sa, cf, y[hi][pb]); } }
        }
        float acl[2];
#pragma unroll
        for (int hi = 0; hi < 2; ++hi) { acl[hi] = ACS[(2 * hp + hi) * 128 + lpos]; const float ea = fast_exp(acl[hi]);
#pragma unroll
            for (int pb = 0; pb < 2; ++pb)
#pragma unroll
                for (int i = 0; i < 16; ++i) y[hi][pb][i] *= ea; }
#pragma unroll 1
        for (int mb = 0; mb <= lb; ++mb) {
            f32x16 cbt;
#pragma unroll
            for (int i = 0; i < 16; ++i) cbt[i] = 0.f;
#pragma unroll
            for (int ks = 0; ks < 8; ++ks) { const bf16x8 bf = frag_tr<false>(F.lds + SD_BT, mb, 16 * ks, lane), cf = frag_tr<false>(F.lds + SD_CT, lb, 16 * ks, lane); cbt = MFMA32(bf, cf, cbt); }
#pragma unroll
            for (int hi = 0; hi < 2; ++hi) { const int hq = 2 * hp + hi;
                f32x16 mt;
#pragma unroll
                for (int i = 0; i < 16; ++i) { const int m = 32 * mb + crow(i, hh); const float am = ACS[hq * 128 + m]; mt[i] = (m <= lpos) ? cbt[i] * fast_exp(acl[hi] - am) : 0.f; }
#pragma unroll
                for (int half = 0; half < 2; ++half) { const bf16x8 mf = pack_acc(mt, half);
                    const int ksx = 2 * mb + half;
#pragma unroll
                    for (int pb = 0; pb < 2; ++pb) { const int row = 64 * hq + 32 * pb + r32;
                        const s16x4 lo = *(const LAS s16x4*)(F.lds + SD_XT + offb(row, 2 * ksx) + 8 * hh), hi4 = *(const LAS s16x4*)(F.lds + SD_XT + offb(row, 2 * ksx + 1) + 8 * hh);
                        const bf16x8 xa = __builtin_shufflevector(lo, hi4, 0, 1, 2, 3, 4, 5, 6, 7);
                        y[hi][pb] = MFMA32(xa, mf, y[hi][pb]); } } }
        }
        float ssq = 0.f;
#pragma unroll
        for (int hi = 0; hi < 2; ++hi) { const int hq = 2 * hp + hi, hd = 4 * g + hq;
            const float dsk = a.in[11][l * 16 + hd] * __builtin_amdgcn_rcpf(DT[hq * 128 + lpos]);
#pragma unroll
            for (int pb = 0; pb < 2; ++pb)
#pragma unroll
                for (int gq = 0; gq < 4; ++gq) { const int p0 = 32 * pb + 8 * gq + 4 * hh;
                    const u32x2 zv = *(const u32x2*)(PROJ + (t0 + lpos) * NPROJ + PQ_SZ + hd * 64 + p0);
                    const float zz[4] = {bflo(zv.x), bfhi(zv.x), bflo(zv.y), bfhi(zv.y)};
#pragma unroll
                    for (int jj = 0; jj < 4; ++jj) { const int row = 64 * hq + p0 + jj;
                        const float xd = bf2f(*(const LAS unsigned short*)(F.lds + SD_XT + offb(row, lpos >> 3) + 2 * (lpos & 7)));
                        float v = y[hi][pb][4 * gq + jj] + xd * dsk; v *= siluf_(zz[jj]); y[hi][pb][4 * gq + jj] = v; ssq += v * v; } }
        }
        ssq = x32_sum(ssq);
        if (hh == 0) SSX[(hp * 4 + lb) * 32 + r32] = ssq;
        __syncthreads();
        const float rstd = __builtin_amdgcn_rsqf((SSX[lb * 32 + r32] + SSX[(4 + lb) * 32 + r32]) * (1.0f / 256.0f) + EPS);
#pragma unroll
        for (int hi = 0; hi < 2; ++hi) { const int hq = 2 * hp + hi;
#pragma unroll
            for (int pb = 0; pb < 2; ++pb)
#pragma unroll
                for (int gq = 0; gq < 4; ++gq) { const int p0 = 32 * pb + 8 * gq + 4 * hh, ch = g * 256 + hq * 64 + p0; const f32x4 gn = *(const f32x4*)(normg + ch);
                    *(unsigned*)(BRCAT + (t0 + lpos) * 3072 + 2048 + ch) = pk4_fp8(y[hi][pb][4 * gq] * rstd * gn.x, y[hi][pb][4 * gq + 1] * rstd * gn.y, y[hi][pb][4 * gq + 2] * rstd * gn.z, y[hi][pb][4 * gq + 3] * rstd * gn.w); } }
    }
}

__device__ __forceinline__ void phase_small(Frame& F, const bf16_t* xsb) {
    const bf16_t* SM = (const bf16_t*)(F.ws + WS_SM); float* SMALL = (float*)(F.ws + WS_SMALL);
    const int li = F.lane & 15, lq = F.lane >> 4, w = F.wave, kh = w >> 2;
    LAS float* red = (LAS float*)F.lds;
    for (int tb = F.bid; tb < T / 64; tb += F.G) {
        const int task = 4 * tb + (w & 3);
        const bf16_t* w0 = SM + (size_t)li * D + 1024 * kh + 8 * lq; const bf16_t* w1 = SM + (size_t)(16 + li) * D + 1024 * kh + 8 * lq; const bf16_t* xp = xsb + (size_t)(task * 16 + li) * D + 1024 * kh + 8 * lq;
        f32x4 c0 = {0.f, 0.f, 0.f, 0.f}, c1 = {0.f, 0.f, 0.f, 0.f};
#pragma unroll 8
        for (int ks = 0; ks < 32; ++ks) { const bf16x8 av = *(const bf16x8*)(xp + 32 * ks), b0 = *(const bf16x8*)(w0 + 32 * ks), b1 = *(const bf16x8*)(w1 + 32 * ks);
            c0 = __builtin_amdgcn_mfma_f32_16x16x32_bf16(av, b0, c0, 0, 0, 0); c1 = __builtin_amdgcn_mfma_f32_16x16x32_bf16(av, b1, c1, 0, 0, 0); }
        __syncthreads();
        if (kh == 1) { *(LAS f32x4*)(red + ((w & 3) * 64 + F.lane) * 8) = c0; *(LAS f32x4*)(red + ((w & 3) * 64 + F.lane) * 8 + 4) = c1; }
        __syncthreads();
        if (kh == 0) { c0 += *(const LAS f32x4*)(red + (w * 64 + F.lane) * 8); c1 += *(const LAS f32x4*)(red + (w * 64 + F.lane) * 8 + 4);
#pragma unroll
            for (int r = 0; r < 4; ++r) { SMALL[(size_t)(task * 16 + 4 * lq + r) * 32 + li] = c0[r]; SMALL[(size_t)(task * 16 + 4 * lq + r) * 32 + 16 + li] = c1[r]; } }
    }
    __syncthreads();
}

constexpr int PPL = 13, NPH = PPL * DEPTH;
constexpr int NCVT = 96;
#ifndef CV_DEFER
#define CV_DEFER 49920
#endif
#ifndef MK_ONE_LAUNCH
#define MK_ONE_LAUNCH 1
#endif
#ifndef PH_MASK
#define PH_MASK 0x1fff
#endif
#ifndef REP_MASK
#define REP_MASK 0
#endif
#ifndef REP_SUB
#define REP_SUB 0
#endif
#ifndef SUB_MASK
#define SUB_MASK 0xff
#endif
__global__ void __launch_bounds__(NTHR, 2) fwd(Args a) {
    extern __shared__ __attribute__((aligned(16))) unsigned char lds_raw[];
    Frame F;
    const int wave0 = __builtin_amdgcn_readfirstlane((int)threadIdx.x >> 6);
    F.lds = (LAS unsigned char*)lds_raw; F.ws = a.ws; F.G = gridDim.x; F.bid = blockIdx.x; F.wave = wave0; F.lane = lane_id(); F.tid = wave0 * 64 + F.lane;
    volatile LAS unsigned* MISCW = (volatile LAS unsigned*)(F.lds + MISC_OFF);
    for (int u = F.tid; u < (LDS_BYTES - LDSCTL_OFF) / 4; u += NTHR) ((LAS unsigned*)(F.lds + LDSCTL_OFF))[u] = 0u;
    __syncthreads();
    unsigned* barw = (unsigned*)(a.ws + WS_CTL) + CW_BAR;
    XcdBarrier bar; bar.bar = barw; bar.x = 0; bar.st = MISCW + 8;
    const int lo = a.ph_lo, hi = a.ph_hi;
    if (hi - lo > 1) bar = xcd_barrier_post(barw, MISCW + 8, F.tid == 0);
#define SUB(k) ((SUB_MASK >> (k)) & 1)
#define IN(k) (((PH_MASK >> (k)) & 1) && lo <= p0 + (k) && p0 + (k) < hi)
#define PH_BEGIN() int ln_ = lane_id(), b_ = blockIdx.x; asm volatile("" : "+v"(ln_), "+s"(b_)); F.lane = ln_; F.wave = wave0; F.tid = wave0 * 64 + ln_; F.bid = b_; \
    const Args al = load_args(a); F.ws = al.ws
#define SEAM(k) do { if (IN(k) && p0 + (k) + 1 < hi) xcd_barrier(bar, wave0 == 0 && lane_id() == 0); } while (0)
#define WSP(T_, off) ((T_*)(F.ws + (off)))
    for (int l = 0; l < DEPTH; ++l) {
        const int p0 = l * PPL;
        if (IN(0)) { PH_BEGIN(); phase_convert(F, al, l, 0, CV_NITEMS - CV_DEFER, F.bid * NWAVES + F.wave, F.G * NWAVES, l == 0); }
        SEAM(0);
        if (IN(1)) {
            PH_BEGIN();
            if (SUB(5)) phase_small(F, WSP(const bf16_t, WS_XRES));
            {   pg8::Gemm g{WSP(const fp8_t, WS_XB), WSP(const fp8_t, WS_WIN), D, nullptr}; pg8::StaticOrder S; S.init(T, NPROJ, F.G, F.bid);
                pg8::EpiBf16 E{WSP(bf16_t, WS_PROJ), NPROJ, 0};
                pg8::gemm_phase<pg8::EpiBf16, pg8::StaticOrder, false>(F.lds, g, S, E, F.tid); }
            {   pg8::Gemm g{WSP(const fp8_t, WS_XB), WSP(const fp8_t, WS_WIN) + (size_t)NPROJ * D, D, nullptr}; pg8::StaticOrder S; S.init(T, NGATE, F.G, F.bid);
                pg8::EpiGate E{WSP(unsigned char, WS_G8)};
                pg8::gemm_phase<pg8::EpiGate, pg8::StaticOrder, false>(F.lds, g, S, E, F.tid); }
        }
        SEAM(1);
        if (IN(2)) { PH_BEGIN();
            if (SUB(0) && (al.sub & 1)) {
                if (CV_DEFER > 0 && F.bid >= F.G - NCVT) phase_convert_experts(F, al, l, 65 * 768 - CV_DEFER, 65 * 768, (F.bid - (F.G - NCVT)) * NWAVES + F.wave, NCVT * NWAVES);
                phase_attn(F, al, l);
                { int ln2 = lane_id(); asm volatile("" : "+v"(ln2)); F.lane = ln2; F.tid = wave0 * 64 + ln2; } }
            if (SUB(1) && (al.sub & 2)) phase_gla_local(F, al, l); if (SUB(2) && (al.sub & 4)) phase_ssd_local(F, al, l); }
        SEAM(2);
        if (IN(3)) { PH_BEGIN(); phase_gla_scan(F); phase_ssd_scan(F); }
        SEAM(3);
        if (IN(4)) { PH_BEGIN(); if (SUB(3) && (al.sub & 8)) phase_gla_out(F, al, l); if (SUB(4) && (al.sub & 16)) phase_ssd_out(F, al, l); }
        SEAM(4);
        if (IN(5)) {
            PH_BEGIN();
            pg8::Gemm g{WSP(const fp8_t, WS_BRCAT), WSP(const fp8_t, WS_WBR), 3072, nullptr}; pg8::StaticOrder S; S.init(T, D, F.G, F.bid);
            pg8::EpiMerge E{WSP(const unsigned char, WS_G8), WSP(fp8_t, WS_MERGED)};
            pg8::gemm_phase<pg8::EpiMerge, pg8::StaticOrder, false>(F.lds, g, S, E, F.tid);
        }
        SEAM(5);
        if (IN(6)) {
            PH_BEGIN();
            pg8::Gemm g{WSP(const fp8_t, WS_MERGED), WSP(const fp8_t, WS_WOUT), D, nullptr}; pg8::StaticOrder S; S.init(T, D, F.G, F.bid);
            pg8::EpiWout E{WSP(const bf16_t, WS_XRES), WSP(bf16_t, WS_H)};
            pg8::gemm_phase<pg8::EpiWout, pg8::StaticOrder, false>(F.lds, g, S, E, F.tid);
        }
        SEAM(6);
        if (!FUSE_LN1) { if (IN(7)) { PH_BEGIN(); phase_ln1(F, al, l); }
            SEAM(7); }
        if (IN(8)) { PH_BEGIN(); phase_router(F, al, l); }
        SEAM(8);
        if (IN(9)) { PH_BEGIN(); phase_lists(F); }
        SEAM(9);
        if (IN(10)) {
            PH_BEGIN();
            const int nblk = __builtin_amdgcn_readfirstlane(WSP(const int, WS_MISC + MS_NBLK)[0]);
            moe_fill<true>(F, nblk, 4);
            pg8::Gemm g{WSP(const fp8_t, WS_X1B), WSP(const fp8_t, WS_EXP1), D, (const LAS int*)(F.lds + MOE_TOKL)}; MoeOrder2 S{(const LAS int*)(F.lds + MOE_BLKL), nblk, 4, F.G, F.bid};
            pg8::EpiSwiglu E{WSP(fp8_t, WS_HS), EDIM};
            pg8::gemm_phase<pg8::EpiSwiglu, MoeOrder2, true>(F.lds, g, S, E, F.tid);
        }
        SEAM(10);
        if (IN(11)) {
            PH_BEGIN();
            const int nblk = __builtin_amdgcn_readfirstlane(WSP(const int, WS_MISC + MS_NBLK)[0]);
            moe_fill<false>(F, nblk, 8);
            pg8::Gemm g{WSP(const fp8_t, WS_HS), WSP(const fp8_t, WS_EXP2), EDIM, nullptr}; MoeOrder2 S{(const LAS int*)(F.lds + MOE_BLKL), nblk, 8, F.G, F.bid};
            pg8::EpiFp8 E{WSP(fp8_t, WS_OS), D, 8};
            pg8::gemm_phase<pg8::EpiFp8, MoeOrder2, false>(F.lds, g, S, E, F.tid);
        }
        SEAM(11);
        if (IN(12)) { PH_BEGIN(); phase_combine(F, al, l); }
        SEAM(12);
    }
#undef IN
#undef SEAM
}

extern "C" void kernel_launch(void* const* d_in, const int* in_sizes, int n_in, void* d_out, int out_size, void* d_ws, size_t ws_size, hipStream_t stream) {
    static int grid = 0;
    if (grid == 0) {
        if (n_in != 27 || out_size != T * D || ws_size < WS_END) { fprintf(stderr, "kernel_launch: unexpected sizes n_in %d out %d ws %zu (need %zu)\n", n_in, out_size, ws_size, (size_t)WS_END); grid = -1; return; }
        int dev = 0, cus = 0, per_cu = 0;
        if (hipGetDevice(&dev) != hipSuccess || hipDeviceGetAttribute(&cus, hipDeviceAttributeMultiprocessorCount, dev) != hipSuccess) { grid = -1; return; }
        if (hipFuncSetAttribute((const void*)fwd, hipFuncAttributeMaxDynamicSharedMemorySize, LDS_BYTES) != hipSuccess) { fprintf(stderr, "kernel_launch: hipFuncSetAttribute failed\n"); grid = -1; return; }
        if (hipOccupancyMaxActiveBlocksPerMultiprocessor(&per_cu, (const void*)fwd, NTHR, LDS_BYTES) != hipSuccess || per_cu < 1) fprintf(stderr, "kernel_launch: occupancy query says %d\n", per_cu);
        (void)hipGetLastError();
        grid = cus;
    }
    if (grid < 0) return;
    if (hipMemsetAsync((char*)d_ws + WS_CTL, 0, CTL_ZERO_BYTES, stream) != hipSuccess) return;
    Args a{};
    for (int i = 0; i < 27; ++i) a.in[i] = (const float*)d_in[i];
    a.out = (float*)d_out; a.ws = (unsigned char*)d_ws; a.sub = 0xff; a.pad = 0;
#if MK_ONE_LAUNCH
    a.ph_lo = 0; a.ph_hi = NPH;
    hipLaunchKernelGGL(fwd, dim3(grid), dim3(NTHR), LDS_BYTES, stream, a);
#else
    for (int k = 0; k < NPH; ++k) { a.ph_lo = k; a.ph_hi = k + 1;
#ifdef HOTPROBE
#ifndef HOTPHASE
#define HOTPHASE 1
#endif
        if ((k % PPL) == HOTPHASE) { a.pad = HOTPROBE; hipLaunchKernelGGL(fwd, dim3(grid), dim3(NTHR), LDS_BYTES, stream, a); a.pad = 0; }
#endif
        const int reps = ((REP_MASK >> (k % PPL)) & 1) ? 2 : 1;
        for (int r = 0; r < reps; ++r) hipLaunchKernelGGL(fwd, dim3(grid), dim3(NTHR), LDS_BYTES, stream, a);
        if (REP_SUB && ((k % PPL) == 2 || (k % PPL) == 4)) { a.sub = REP_SUB; hipLaunchKernelGGL(fwd, dim3(grid), dim3(NTHR), LDS_BYTES, stream, a); a.sub = 0xff; } }
#endif
}
```

```cpp
#include <hip/hip_runtime.h>
#include <cstdio>
#include <cstdint>

#define LAS __attribute__((address_space(3)))
#define GAS __attribute__((address_space(1)))
typedef unsigned short bf16_t;
typedef short bf16x8 __attribute__((ext_vector_type(8)));
typedef short s16x4 __attribute__((ext_vector_type(4)));
typedef float f32x4 __attribute__((ext_vector_type(4)));
typedef float f32x2 __attribute__((ext_vector_type(2)));
typedef float f32x16 __attribute__((ext_vector_type(16)));
typedef unsigned u32x4 __attribute__((ext_vector_type(4)));
typedef unsigned u32x2 __attribute__((ext_vector_type(2)));
typedef GAS unsigned gu32;
typedef int i32x4 __attribute__((ext_vector_type(4)));
typedef int i32x8 __attribute__((ext_vector_type(8)));
typedef unsigned char fp8_t;
typedef float f32x2_ __attribute__((ext_vector_type(2)));
__device__ __forceinline__ void unpk4_fp8(unsigned w, float (&o)[4]) { const f32x2_ a = __builtin_amdgcn_cvt_pk_f32_fp8((int)w, false), b = __builtin_amdgcn_cvt_pk_f32_fp8((int)w, true); o[0] = a.x; o[1] = a.y; o[2] = b.x; o[3] = b.y; }
__device__ __forceinline__ float clamp448(float x) { return __builtin_amdgcn_fmed3f(x, -448.0f, 448.0f); }
__device__ __forceinline__ unsigned pk4_fp8(float a, float b, float c, float d) { int r = 0; r = __builtin_amdgcn_cvt_pk_fp8_f32(clamp448(a), clamp448(b), r, false); r = __builtin_amdgcn_cvt_pk_fp8_f32(clamp448(c), clamp448(d), r, true); return (unsigned)r; }
constexpr float OSCALE = 16.0f;
constexpr float WSCALE = 64.0f; constexpr int SC_W = 0x7c7c7c7c, SC_A = 0x7c7c7c7c;

__device__ __forceinline__ unsigned cvt_pk_bf16(float lo, float hi) { unsigned r; asm volatile("v_cvt_pk_bf16_f32 %0, %1, %2" : "=v"(r) : "v"(lo), "v"(hi)); return r; }
typedef __bf16 bf16x2_t __attribute__((ext_vector_type(2)));
__device__ __forceinline__ unsigned cvtpk(float lo, float hi) { f32x2 v = {lo, hi}; bf16x2_t b = __builtin_convertvector(v, bf16x2_t); return __builtin_bit_cast(unsigned, b); }
__device__ __forceinline__ float bf2f(unsigned short b) { return __uint_as_float(((unsigned)b) << 16); }
__device__ __forceinline__ float bflo(unsigned w) { return __uint_as_float(w << 16); }
__device__ __forceinline__ float bfhi(unsigned w) { return __uint_as_float(w & 0xffff0000u); }
__device__ __forceinline__ unsigned short f2bf(float f) { unsigned u = __float_as_uint(f); return (unsigned short)((u + 0x7fffu + ((u >> 16) & 1u)) >> 16); }
__device__ __forceinline__ float fast_exp(float x) { return __builtin_amdgcn_exp2f(x * 1.4426950408889634f); }
__device__ __forceinline__ float fast_log(float x) { return __builtin_amdgcn_logf(x) * 0.6931471805599453f; }
__device__ __forceinline__ float sigmoidf_(float x) { return __builtin_amdgcn_rcpf(1.0f + fast_exp(-x)); }
__device__ __forceinline__ float siluf_(float x) { return x * sigmoidf_(x); }

namespace pg8 {
constexpr int BM = 256, BK = 64, HALF = 128, HTB = HALF * BK * 2  , STAGE_BYTES = 8 * HTB, NXCD = 8, WGM = 8;

__host__ __device__ __forceinline__ int lds_byte(int r, int c) { const int st = (r >> 4) * 2 + (c >> 5), rr = r & 15, cc = c & 31, ob = rr * 64 + cc * 2; return st * 1024 + (ob ^ (((ob >> 9) & 1) << 5)); }
__host__ __device__ __forceinline__ void stage_rc(int b, int& R, int& C) { const int st = b / 1024, sb = b % 1024, swz = sb ^ (((sb >> 9) & 1) << 5); R = (st >> 1) * 16 + swz / 64; C = (st & 1) * 32 + (swz % 64) / 2; }
__host__ __device__ __forceinline__ int perm32(int rho) { const int n = rho >> 4, i = rho & 15; return 8 * (i >> 2) + 4 * n + (i & 3); }

struct Unit { int pm, pn; };
struct Gemm { const fp8_t* A; const fp8_t* Bt; int KB; const LAS int* gidx; };

struct StaticOrder {
    int nM, nN, nwg, G, c;
    __host__ __device__ void init(int M, int N, int G_, int c_) { nM = M / BM; nN = N / BM; nwg = nM * nN; G = G_; c = c_; }
    __host__ __device__ bool next(int i, Unit& u) const {
        const long L = (long)i * G + c; if (L >= nwg) return false;
        int wgid = (int)L; { const int q = nwg / NXCD, r = nwg % NXCD, xcd = wgid % NXCD, off = wgid / NXCD; wgid = (xcd < r ? xcd * (q + 1) : r * (q + 1) + (xcd - r) * q) + off; }
        const int nig = WGM * nN, gid = wgid / nig, fm = gid * WGM, gsz = (nM - fm) < WGM ? (nM - fm) : WGM;
        u.pm = fm + ((wgid % nig) % gsz); u.pn = (wgid % nig) / gsz; return true;
    }
};
struct MoeOrder {
    const int* blk_e; int nunits, NT, G, c;
    __device__ bool next(int i, Unit& u) const {
        const int L = i * G + c; if (L >= nunits) return false;
        const int j = L / NT, pl = L - j * NT; u.pm = j; u.pn = __builtin_amdgcn_readfirstlane(blk_e[j]) * NT + pl; return true;
    }
};

#ifndef PG8_ALIGN
#define PG8_ALIGN true
#endif
template <class E, class = void> struct epi_perm16 { static constexpr bool value = false; };
template <class E> struct epi_perm16<E, decltype((void)E::PERM16)> { static constexpr bool value = E::PERM16; };
template <class Epi, class Sched, bool GATHER, bool ALIGN_EPI = PG8_ALIGN>
__device__ __forceinline__ void gemm_phase(LAS unsigned char* lds, const Gemm g, const Sched& S, const Epi& E, int tid_in) {
    int tid_ = tid_in; asm volatile("" : "+v"(tid_));
    const int tid = tid_, wid = __builtin_amdgcn_readfirstlane(tid >> 6), lane = tid & 63, wr = wid >> 2, wc = wid & 3, fr = lane & 15, fq = lane >> 4;
    int KB_ = g.KB; asm volatile("" : "+s"(KB_));
    const int KB = KB_, nt = KB / 128;
    unsigned vA[2][2], vAn[2][2], voffB[2]; int Rl[2], Cl[2];
    const size_t hstep = (size_t)HALF * KB, q64 = (size_t)64 * KB;
    constexpr bool P16 = epi_perm16<Epi>::value;
    const size_t bhstep = P16 ? (size_t)8 * KB : hstep, qB = P16 ? (size_t)128 * KB : (size_t)64 * KB;
    const size_t tstep = 2 * hstep;
#pragma unroll
    for (int i = 0; i < 2; ++i) { int R, C; stage_rc(tid * 16 + i * 8192, R, C); const int Rb = P16 ? (64 * (R >> 5) + 16 * ((R & 15) >> 2) + 4 * ((R >> 4) & 1) + (R & 3)) : (Epi::PERM ? ((R & ~31) + perm32(R & 31)) : R); Rl[i] = R; Cl[i] = C;
        voffB[i] = (unsigned)(Rb * KB + 2 * C);
        vA[0][i] = (unsigned)(R * KB + 2 * C); vA[1][i] = (unsigned)((R + HALF) * KB + 2 * C); vAn[0][i] = vA[0][i]; vAn[1][i] = vA[1][i]; }
    const size_t kstep = (size_t)(BK * 2);
    const unsigned ldsw = (unsigned)wid * 1024u;
    const int aoff = lds_byte(wr * 64 + fr, fq * 8), boff = lds_byte(wc * 32 + fr, fq * 8);
#define PG8_SA(b, h) (((b) * 2 + (h)) * HTB)
#define PG8_SB(b, h) ((4 + (b) * 2 + (h)) * HTB)
#define PG8_STAGE(bufoff, gbase, voff) do { _Pragma("unroll") for (int _i = 0; _i < 2; ++_i) \
        __builtin_amdgcn_global_load_lds((const unsigned*)((const char*)(gbase) + (size_t)_i * q64 + (voff)[0]), (LAS unsigned*)(lds + (bufoff) + ldsw + _i * 8192), 16, 0, 0); } while (0)
#define PG8_STAGE_B(bufoff, gbase, voff) do { _Pragma("unroll") for (int _i = 0; _i < 2; ++_i) \
        __builtin_amdgcn_global_load_lds((const unsigned*)((const char*)(gbase) + (size_t)_i * qB + (voff)[0]), (LAS unsigned*)(lds + (bufoff) + ldsw + _i * 8192), 16, 0, 0); } while (0)
#define PG8_STAGE_G(bufoff, gbase, voff) do { _Pragma("unroll") for (int _i = 0; _i < 2; ++_i) \
        __builtin_amdgcn_global_load_lds((const unsigned*)((const char*)(gbase) + (voff)[_i]), (LAS unsigned*)(lds + (bufoff) + ldsw + _i * 8192), 16, 0, 0); } while (0)
#define PG8_STAGE_A(bufoff, gbase, vv, h) do { if constexpr (GATHER) PG8_STAGE_G(bufoff, gbase, (vv)[h]); else PG8_STAGE(bufoff, (gbase) + (size_t)(h) * hstep, (vv)[0]); } while (0)
#define PG8_CAT(x0, x1) __builtin_shufflevector((x0), (x1), 0, 1, 2, 3, 4, 5, 6, 7)
#define PG8_LDA(dst, b, h) do { _Pragma("unroll") for (int m = 0; m < 4; ++m) dst[m] = PG8_CAT(*(const LAS i32x4*)(lds + PG8_SA(b, h) + aoff + m * 2048), *(const LAS i32x4*)(lds + PG8_SA(b, h) + aoff + m * 2048 + 1024)); } while (0)
#define PG8_LDB(dst, b, h) do { _Pragma("unroll") for (int n = 0; n < 2; ++n) dst[n] = PG8_CAT(*(const LAS i32x4*)(lds + PG8_SB(b, h) + boff + n * 2048), *(const LAS i32x4*)(lds + PG8_SB(b, h) + boff + n * 2048 + 1024)); } while (0)
#define PG8_MMA(ai, bj, At, Bt) do { __builtin_amdgcn_s_setprio(1); _Pragma("unroll") for (int m = 0; m < 4; ++m) _Pragma("unroll") for (int n = 0; n < 2; ++n) \
        asm volatile("v_mfma_scale_f32_16x16x128_f8f6f4 %0, %1, %2, %0, %3, %3 op_sel_hi:[0,0,0]" : "+v"(acc[ai][bj][m][n]) : "v"(Bt[n]), "v"(At[m]), "v"(scv)); __builtin_amdgcn_s_setprio(0); } while (0)
#define PG8_WAIT_V(n) asm volatile("s_waitcnt vmcnt(" #n ")" ::: "memory")
#define PG8_WAIT_L(n) asm volatile("s_waitcnt lgkmcnt(" #n ")" ::: "memory")
#define PG8_BAR __builtin_amdgcn_s_barrier()
#define PG8_SCHED __builtin_amdgcn_sched_barrier(0)
#define PG8_GIDX(dst, ord) do { if constexpr (GATHER) { _Pragma("unroll") for (int _h = 0; _h < 2; ++_h) _Pragma("unroll") for (int _i = 0; _i < 2; ++_i) \
        dst[_h][_i] = (unsigned)g.gidx[(ord) * BM + _h * HALF + Rl[_i]] * (unsigned)KB + 2u * (unsigned)Cl[_i]; } } while (0)
    Unit cur, nxt; int ui = 0;
    if (!S.next(0, cur)) return;
    f32x4 acc[2][2][4][2];
#pragma unroll
    for (int a = 0; a < 2; ++a)
#pragma unroll
        for (int b = 0; b < 2; ++b)
#pragma unroll
            for (int m = 0; m < 4; ++m)
#pragma unroll
                for (int n = 0; n < 2; ++n) acc[a][b][m][n] = (f32x4){0.f, 0.f, 0.f, 0.f};
    i32x8 At[4], B0[2], B1[2];
    int scv = SC_W; asm volatile("" : "+v"(scv));
    PG8_GIDX(vA, 0);
    const char* cA = (const char*)g.A + (GATHER ? (size_t)0 : (size_t)cur.pm * tstep); const char* cB = (const char*)g.Bt + (size_t)cur.pn * tstep;
    PG8_STAGE_B(PG8_SB(0, 0), cB, voffB); PG8_STAGE_B(PG8_SB(0, 1), cB + bhstep, voffB); PG8_STAGE_A(PG8_SA(0, 0), cA, vA, 0); PG8_STAGE_A(PG8_SA(0, 1), cA, vA, 1);
    if (wr == 1) PG8_BAR;
    PG8_WAIT_V(2); PG8_BAR;
    PG8_STAGE_B(PG8_SB(1, 0), cB + kstep, voffB); PG8_STAGE_A(PG8_SA(1, 0), cA + kstep, vA, 0); PG8_STAGE_B(PG8_SB(1, 1), cB + bhstep + kstep, voffB);
    PG8_WAIT_V(6); PG8_BAR;
    for (;;) {
        const bool has_next = S.next(ui + 1, nxt);
        if (has_next) PG8_GIDX(vAn, ui + 1);
        const char* nA = has_next ? (const char*)g.A + (GATHER ? (size_t)0 : (size_t)nxt.pm * tstep) : cA; const char* nB = has_next ? (const char*)g.Bt + (size_t)nxt.pn * tstep : cB;
        constexpr int NSEG = Epi::HAS_MID ? 3 : 1; const int seglen = nt / NSEG;
        for (int seg = 0; seg < NSEG; ++seg) {
        if constexpr (Epi::HAS_MID) { if (seg > 0) { asm volatile("s_nop 15\n\ts_nop 15" ::: "memory"); E.mid(acc, cur, seg * Epi::MID0, wr, wc, fr, fq); asm volatile("s_nop 7" ::: "memory"); } }
        for (int t = seg * seglen; t < (seg + 1) * seglen; t += 2) {
            const bool last = (t == nt - 2);
            const char* a1 = cA + (size_t)(t + 1) * kstep;
            const char* a2 = last ? nA : cA + (size_t)(t + 2) * kstep; const char* b2 = last ? nB : cB + (size_t)(t + 2) * kstep;
            const char* a3 = a2 + kstep; const char* b3 = b2 + kstep;
            unsigned v2[2][2];
#pragma unroll
            for (int h = 0; h < 2; ++h)
#pragma unroll
                for (int i = 0; i < 2; ++i) v2[h][i] = (GATHER && last) ? vAn[h][i] : vA[h][i];
            PG8_LDB(B0, 0, 0); PG8_LDB(B1, 0, 1); PG8_SCHED; PG8_LDA(At, 0, 0); PG8_STAGE_A(PG8_SA(1, 1), a1, vA, 1);
            PG8_WAIT_V(8); PG8_WAIT_L(0); PG8_BAR; PG8_MMA(0, 0, At, B0); PG8_MMA(0, 1, At, B1); PG8_BAR; PG8_SCHED;
            PG8_LDA(At, 0, 1); PG8_STAGE_B(PG8_SB(0, 0), b2, voffB); PG8_STAGE_B(PG8_SB(0, 1), b2 + bhstep, voffB); PG8_STAGE_A(PG8_SA(0, 0), a2, v2, 0);
            PG8_WAIT_V(8); PG8_WAIT_L(0); PG8_BAR; PG8_MMA(1, 0, At, B0); PG8_MMA(1, 1, At, B1); PG8_BAR; PG8_SCHED;
            PG8_LDB(B0, 1, 0); PG8_LDB(B1, 1, 1); PG8_SCHED; PG8_LDA(At, 1, 0); PG8_STAGE_A(PG8_SA(0, 1), a2, v2, 1);
            PG8_WAIT_V(8); PG8_WAIT_L(0); PG8_BAR; PG8_MMA(0, 0, At, B0); PG8_MMA(0, 1, At, B1); PG8_BAR; PG8_SCHED;
            PG8_LDA(At, 1, 1); PG8_STAGE_B(PG8_SB(1, 0), b3, voffB); PG8_STAGE_B(PG8_SB(1, 1), b3 + bhstep, voffB); PG8_STAGE_A(PG8_SA(1, 0), a3, v2, 0);
            PG8_WAIT_V(8); PG8_WAIT_L(0); PG8_BAR; PG8_MMA(1, 0, At, B0); PG8_MMA(1, 1, At, B1); PG8_BAR; PG8_SCHED;
        }
        }
        if constexpr (ALIGN_EPI) { if (wr == 0) PG8_BAR; }
        asm volatile("s_nop 15\n\ts_nop 15" ::: "memory");
        {   int l2_ = lane; asm volatile("" : "+v"(l2_));
            E(acc, cur, wr, wc, l2_ & 15, l2_ >> 4); }
        if (!has_next) break;
#pragma unroll
        for (int a = 0; a < 2; ++a)
#pragma unroll
            for (int b = 0; b < 2; ++b)
#pragma unroll
                for (int m = 0; m < 4; ++m)
#pragma unroll
                    for (int n = 0; n < 2; ++n) acc[a][b][m][n] = (f32x4){0.f, 0.f, 0.f, 0.f};
        cur = nxt; cA = nA; cB = nB; ++ui;
#pragma unroll
        for (int h = 0; h < 2; ++h)
#pragma unroll
            for (int i = 0; i < 2; ++i) vA[h][i] = vAn[h][i];
        if constexpr (ALIGN_EPI) { if (wr == 1) PG8_BAR; }
    }
    PG8_WAIT_V(0);
    if constexpr (!ALIGN_EPI) { if (wr == 0) PG8_BAR; }
    PG8_BAR;
#undef PG8_SA
#undef PG8_SB
#undef PG8_STAGE
#undef PG8_STAGE_A
#undef PG8_STAGE_G
#undef PG8_LDA
#undef PG8_LDB
#undef PG8_MMA
#undef PG8_CAT
#undef PG8_WAIT_V
#undef PG8_WAIT_L
#undef PG8_BAR
#undef PG8_SCHED
#undef PG8_GIDX
}
}

constexpr int NWAVES = 8, NTHR = 512;
constexpr int BATCH = 4, SEQ = 4096, T = BATCH * SEQ, D = 2048, DEPTH = 2;
constexpr int IN_WIDTH = 15392, NPROJ = 9216, NGATE = 6144, NPROJ_ALL = NPROJ + NGATE;
constexpr int PQ_DAQ = 0, PQ_DAK = 1024, PQ_DAV = 2048, PQ_GQ = 3072, PQ_GK = 3584, PQ_GV = 4096, PQ_GR = 5120, PQ_SZ = 6144, PQ_SX = 7168, PQ_SB = 8192, PQ_SC = 8704, PQ_MG = 9216;
constexpr int NEXP = 64, TOPK = 8, EDIM = 512;
constexpr int MAXSLOT = T * TOPK + NEXP * 256;
constexpr int NSLOT_ALL = MAXSLOT + T;
constexpr int MAXBLK = NSLOT_ALL / 256;
constexpr float ALPHA = 1.4142135623730951f;
constexpr float EPS = 1e-5f;

constexpr size_t MiB = 1u << 20;
constexpr size_t WS_CTL = 0, CTL_ZERO_BYTES = 1 * MiB;
constexpr size_t WS_MISC = 1 * MiB;
constexpr size_t WS_WIN = 10 * MiB, WS_SM = 70 * MiB, WS_WBR = 71 * MiB, WS_WOUT = 83 * MiB, WS_RT = 91 * MiB, WS_EXP1 = 92 * MiB, WS_EXP2 = 352 * MiB;
constexpr size_t WS_XB = 482 * MiB, WS_XRES = 546 * MiB;
constexpr size_t WS_R1 = 674 * MiB, WS_PROJ = WS_R1, WS_G8 = WS_PROJ + (size_t)T * NPROJ * 2, WS_BRCAT = 1154 * MiB, WS_OS = WS_R1;
constexpr size_t WS_R2 = 1314 * MiB, WS_UPDT = WS_R2, WS_SPREVT = 1442 * MiB, WS_STATES = 1506 * MiB, WS_SPREV = 1570 * MiB, WS_HS = WS_R2;
constexpr size_t WS_MERGED = 1602 * MiB, WS_X1B = WS_MERGED, WS_H = 1666 * MiB, WS_SMALL = 1794 * MiB, WS_GDEC = 1796 * MiB, WS_ALAST = WS_GDEC + 512 * 1024, WS_END = 1797 * MiB;
static_assert(WS_WIN + (size_t)NPROJ_ALL * D * 2 <= WS_SM && WS_EXP1 + (size_t)65 * 1024 * 2048 * 2 <= WS_EXP2 && WS_EXP2 + (size_t)65 * 2048 * 512 * 2 <= WS_XB, "weights map");
static_assert(WS_G8 + (size_t)T * NGATE <= WS_BRCAT && WS_BRCAT + (size_t)T * 3072 * 2 <= WS_R2 && WS_OS + (size_t)NSLOT_ALL * D * 2 <= WS_R2, "R1 map");
static_assert(WS_HS + (size_t)NSLOT_ALL * EDIM * 2 <= WS_MERGED && WS_SPREV + (size_t)4 * 32 * 16 * 64 * 128 * 2 <= WS_MERGED, "R2 map");
constexpr size_t MS_SELMASK = 0, MS_SELW = 256 * 1024, MS_CNT = 1024 * 1024, MS_TOK2SLOT = 1280 * 1024, MS_SLOTTOK = 2 * MiB, MS_BLKE = 3 * MiB, MS_NBLK = 3 * MiB + 4096;
constexpr int CW_BAR = 4096, CW_ATTQ = 16384;

constexpr int RING_BYTES = 131072;
constexpr int LDSCTL_OFF = 155648, MISC_OFF = LDSCTL_OFF + 64;
constexpr int LDS_BYTES = 155648 + 256;

#define RLX_AGENT __ATOMIC_RELAXED, __HIP_MEMORY_SCOPE_AGENT
#define LDS_WAIT() asm volatile("s_waitcnt lgkmcnt(0)" ::: "memory")
#define VM_WAIT() asm volatile("s_waitcnt vmcnt(0)" ::: "memory")

#define XB_TMO      128
#define XB_XCNT(j)  (256  + 64 * (j))
#define XB_XSUB(j)  (1280 + 64 * (j))
#define XB_XGEN(j)  (2304 + 64 * (j))
#define XB_TOP      3328
#define XB_TOPGEN   3392
#define XCD_BAR_WORDS 3456
#define XB_SPIN_CAP (1u << 20)
__device__ __forceinline__ unsigned xb_ld(unsigned* p)              { return __hip_atomic_load(p, __ATOMIC_RELAXED, __HIP_MEMORY_SCOPE_AGENT); }
__device__ __forceinline__ unsigned xb_add(unsigned* p, unsigned v) { return __hip_atomic_fetch_add(p, v, __ATOMIC_RELAXED, __HIP_MEMORY_SCOPE_AGENT); }
__device__ __forceinline__ unsigned xb_xcc_id() { return (unsigned)__builtin_amdgcn_s_getreg((3 << 11) | 20) & 0xFu; }
#define XB_SPIN(cond, bar) do { unsigned _sp = 0; while (cond) { __builtin_amdgcn_s_sleep(1); \
    if ((++_sp & 255u) == 0u) { if (xb_ld(&(bar)[XB_TMO])) break; if (_sp > XB_SPIN_CAP) { atomicAdd(&(bar)[XB_TMO], 1u); break; } } } } while (0)
struct XcdBarrier { unsigned* bar; unsigned x; volatile LAS unsigned* st; };
__device__ __forceinline__ XcdBarrier xcd_barrier_post(unsigned* bar, volatile LAS unsigned* st, bool leader) {
    XcdBarrier b; b.bar = bar; b.x = xb_xcc_id(); b.st = st;
    if (leader) (void)xb_add(&bar[XB_XCNT(b.x)], 1u);
    return b;
}
__device__ __forceinline__ void xcd_barrier_complete(unsigned* bar, unsigned x, unsigned& nloc, unsigned& nx) {
    const unsigned G = gridDim.x * gridDim.y * gridDim.z;
    unsigned sum, cnt, mine, sp = 0u;
    for (;;) {
        sum = 0u; cnt = 0u; mine = 0u;
#pragma unroll
        for (unsigned j = 0; j < 16; ++j) { const unsigned c = xb_ld(&bar[XB_XCNT(j)]); sum += c; cnt += (c > 0u) ? 1u : 0u; mine = (j == x) ? c : mine; }
        if (sum == G) break;
        __builtin_amdgcn_s_sleep(1);
        if ((++sp & 255u) == 0u) { if (xb_ld(&bar[XB_TMO])) break; if (sp > XB_SPIN_CAP) { atomicAdd(&bar[XB_TMO], 1u); break; } }
    }
    nloc = mine > 0u ? mine : 1u; nx = cnt > 0u ? cnt : 1u;
}
__device__ __forceinline__ void xcd_barrier(const XcdBarrier& b, bool leader) {
    asm volatile("s_waitcnt vmcnt(0)" ::: "memory");
    __syncthreads();
    if (leader) {
        unsigned* bar = b.bar;
        __builtin_amdgcn_s_waitcnt(0);
        unsigned nloc = b.st[0], nx = b.st[1];
        if (nloc == 0u) { xcd_barrier_complete(bar, b.x, nloc, nx); b.st[0] = nloc; b.st[1] = nx; }
        const unsigned old = xb_add(&bar[XB_XSUB(b.x)], 1u);
        const unsigned gen = old / nloc;
        if (old + 1u == (gen + 1u) * nloc) {
            __builtin_amdgcn_fence(__ATOMIC_RELEASE, "agent");
            asm volatile("s_waitcnt vmcnt(0)" ::: "memory");
            const unsigned og = xb_add(&bar[XB_TOP], 1u);
            const unsigned tg = og / nx;
            if (og + 1u == (tg + 1u) * nx) xb_add(&bar[XB_TOPGEN], 1u);
            else XB_SPIN(xb_ld(&bar[XB_TOPGEN]) == tg, bar);
            __builtin_amdgcn_fence(__ATOMIC_ACQUIRE, "agent");
            xb_add(&bar[XB_XGEN(b.x)], 1u);
            asm volatile("s_waitcnt vmcnt(0)" ::: "memory");
        } else {
            XB_SPIN(xb_ld(&bar[XB_XGEN(b.x)]) == gen, bar);
            __builtin_amdgcn_fence(__ATOMIC_ACQUIRE, "agent");
            asm volatile("s_waitcnt vmcnt(0)" ::: "memory");
        }
    }
    __syncthreads();
}

struct Args { const float* in[27]; float* out; unsigned char* ws; int ph_lo, ph_hi; int sub, pad; };
__device__ __forceinline__ int lane_id() { int r; asm volatile("v_mbcnt_lo_u32_b32 %0, -1, 0\n\tv_mbcnt_hi_u32_b32 %0, -1, %0" : "=v"(r)); return r; }
__device__ __forceinline__ Args load_args(const Args& a) {
#if defined(__HIP_DEVICE_COMPILE__)
    typedef const __attribute__((address_space(4))) unsigned long long* kptr;
    kptr p = (kptr)__builtin_amdgcn_kernarg_segment_ptr(); asm volatile("" : "+s"(p));
    Args r;
#pragma unroll
    for (int i = 0; i < 27; ++i) r.in[i] = (const float*)(const GAS float*)p[i];
    r.out = (float*)(GAS float*)p[27]; r.ws = (unsigned char*)(GAS unsigned char*)p[28]; const unsigned long long q = p[29], q2 = p[30]; r.ph_lo = (int)(unsigned)q; r.ph_hi = (int)(unsigned)(q >> 32); r.sub = (int)(unsigned)q2; r.pad = (int)(unsigned)(q2 >> 32);
    return r;
#else
    return a;
#endif
}
struct Frame {
    LAS unsigned char* lds;
    unsigned char* ws;
    int tid, lane, wave, G, bid;
};

template <int K> __device__ __forceinline__ float swz_xor(float v) { return __builtin_bit_cast(float, __builtin_amdgcn_ds_swizzle(__builtin_bit_cast(int, v), 0x1f | (K << 10))); }
__device__ __forceinline__ float x32_sum(float v) { auto r = __builtin_amdgcn_permlane32_swap(__float_as_uint(v), __float_as_uint(v), false, false); return __uint_as_float(r[0]) + __uint_as_float(r[1]); }
__device__ __forceinline__ float x32_max(float v) { auto r = __builtin_amdgcn_permlane32_swap(__float_as_uint(v), __float_as_uint(v), false, false); return fmaxf(__uint_as_float(r[0]), __uint_as_float(r[1])); }
__device__ __forceinline__ float wave_sum(float v) { v += swz_xor<1>(v); v += swz_xor<2>(v); v += swz_xor<4>(v); v += swz_xor<8>(v); v += swz_xor<16>(v); return x32_sum(v); }
__device__ __forceinline__ float wave_max(float v) { v = fmaxf(v, swz_xor<1>(v)); v = fmaxf(v, swz_xor<2>(v)); v = fmaxf(v, swz_xor<4>(v)); v = fmaxf(v, swz_xor<8>(v)); v = fmaxf(v, swz_xor<16>(v)); return x32_max(v); }
__device__ __forceinline__ float wave_scan_f(float v, int ln) {
#pragma unroll
    for (int o = 1; o < 64; o <<= 1) { const float t = __builtin_bit_cast(float, __builtin_amdgcn_ds_bpermute((ln - o) << 2, __builtin_bit_cast(int, v))); if (ln >= o) v += t; }
    return v;
}
__device__ __forceinline__ int wave_scan_i(int v, int ln) {
#pragma unroll
    for (int o = 1; o < 64; o <<= 1) { const int t = __builtin_amdgcn_ds_bpermute((ln - o) << 2, v); if (ln >= o) v += t; }
    return v;
}

constexpr int CV_NITEMS = 32 * 80 + 32 * 64 + 32 * 96 + 32 + 3 * 16 * 32 + 32 * 32 + 32 * 2 + 65 * (2 * 32 * 8 + 8 * 32);
__device__ __forceinline__ void cv_item(const float* W, int ldn, int k0, int ns0, bf16_t* dst, int ld_dst, int drow0, int dk0, LAS float* scr, int lane) {
#pragma unroll 8
    for (int i = 0; i < 32; ++i) { const int kk = 2 * i + (lane >> 5); scr[kk * 33 + (lane & 31)] = W[(size_t)(k0 + kk) * ldn + ns0 + (lane & 31)]; }
    LDS_WAIT(); asm volatile("" ::: "memory");
    const int c = lane & 7;
#pragma unroll
    for (int j = 0; j < 4; ++j) { const int n = (lane >> 3) + 8 * j; const LAS float* s = scr + (8 * c) * 33 + n;
        u32x4 o; o.x = cvt_pk_bf16(s[0 * 33], s[1 * 33]); o.y = cvt_pk_bf16(s[2 * 33], s[3 * 33]); o.z = cvt_pk_bf16(s[4 * 33], s[5 * 33]); o.w = cvt_pk_bf16(s[6 * 33], s[7 * 33]);
        *(GAS u32x4*)(dst + (size_t)(drow0 + n) * ld_dst + dk0 + k0 + 8 * c) = o; }
    LDS_WAIT(); asm volatile("" ::: "memory");
}
__device__ __forceinline__ void cv_item64(const float* W, int ldn, int k0, int ns0, fp8_t* dst, int ld_dst, int drow0, int dk0, LAS float* scr, int lane) {
    const float* wp = W + (size_t)(k0 + (lane >> 4)) * ldn + ns0 + 4 * (lane & 15);
    f32x4 v[16];
#pragma unroll
    for (int i = 0; i < 16; ++i) v[i] = *(const GAS f32x4*)(wp + (size_t)(4 * i) * ldn);
#pragma unroll
    for (int i = 0; i < 16; ++i) { LAS float* sp = scr + (4 * i + (lane >> 4)) * 65 + 4 * (lane & 15); sp[0] = v[i].x * WSCALE; sp[1] = v[i].y * WSCALE; sp[2] = v[i].z * WSCALE; sp[3] = v[i].w * WSCALE; }
    LDS_WAIT(); asm volatile("" ::: "memory");
    const int c = lane & 3;
#pragma unroll
    for (int j = 0; j < 4; ++j) { const int n = (lane >> 2) + 16 * j; const LAS float* s = scr + (16 * c) * 65 + n;
        u32x4 o; o.x = pk4_fp8(s[0 * 65], s[1 * 65], s[2 * 65], s[3 * 65]); o.y = pk4_fp8(s[4 * 65], s[5 * 65], s[6 * 65], s[7 * 65]);
        o.z = pk4_fp8(s[8 * 65], s[9 * 65], s[10 * 65], s[11 * 65]); o.w = pk4_fp8(s[12 * 65], s[13 * 65], s[14 * 65], s[15 * 65]);
        *(GAS u32x4*)(dst + (size_t)(drow0 + n) * ld_dst + dk0 + k0 + 16 * c) = o; }
    LDS_WAIT(); asm volatile("" ::: "memory");
}
__device__ __forceinline__ void cv_item_small(const float* W, int k0, bf16_t* dst, LAS float* scr, int lane) {
    const int c32 = lane & 31, sc = c32 < 16 ? 5120 + c32 : 9232 + (c32 - 16);
#pragma unroll 8
    for (int i = 0; i < 32; ++i) { const int kk = 2 * i + (lane >> 5); scr[kk * 33 + c32] = W[(size_t)(k0 + kk) * IN_WIDTH + sc]; }
    LDS_WAIT(); asm volatile("" ::: "memory");
    const int c = lane & 7;
#pragma unroll
    for (int j = 0; j < 4; ++j) { const int n = (lane >> 3) + 8 * j; const LAS float* s = scr + (8 * c) * 33 + n;
        u32x4 o; o.x = cvt_pk_bf16(s[0 * 33], s[1 * 33]); o.y = cvt_pk_bf16(s[2 * 33], s[3 * 33]); o.z = cvt_pk_bf16(s[4 * 33], s[5 * 33]); o.w = cvt_pk_bf16(s[6 * 33], s[7 * 33]);
        *(GAS u32x4*)(dst + (size_t)n * D + k0 + 8 * c) = o; }
    LDS_WAIT(); asm volatile("" ::: "memory");
}
__device__ __forceinline__ void cv_item_router(const float* W, int k0, int ns0, bf16_t* dhi, bf16_t* dlo, LAS float* scr, int lane) {
#pragma unroll 8
    for (int i = 0; i < 32; ++i) { const int kk = 2 * i + (lane >> 5); scr[kk * 33 + (lane & 31)] = W[(size_t)(k0 + kk) * NEXP + ns0 + (lane & 31)]; }
    LDS_WAIT(); asm volatile("" ::: "memory");
    const int c = lane & 7;
#pragma unroll
    for (int j = 0; j < 4; ++j) { const int n = (lane >> 3) + 8 * j; const LAS float* s = scr + (8 * c) * 33 + n;
        float v[8], r[8]; unsigned short hb[8];
#pragma unroll
        for (int q = 0; q < 8; ++q) { v[q] = s[q * 33]; hb[q] = f2bf(v[q]); r[q] = v[q] - bf2f(hb[q]); }
        u32x4 o; o.x = hb[0] | ((unsigned)hb[1] << 16); o.y = hb[2] | ((unsigned)hb[3] << 16); o.z = hb[4] | ((unsigned)hb[5] << 16); o.w = hb[6] | ((unsigned)hb[7] << 16);
        u32x4 l; l.x = cvt_pk_bf16(r[0], r[1]); l.y = cvt_pk_bf16(r[2], r[3]); l.z = cvt_pk_bf16(r[4], r[5]); l.w = cvt_pk_bf16(r[6], r[7]);
        *(GAS u32x4*)(dhi + (size_t)(ns0 + n) * D + k0 + 8 * c) = o;
        *(GAS u32x4*)(dlo + (size_t)(ns0 + n) * D + k0 + 8 * c) = l; }
    LDS_WAIT(); asm volatile("" ::: "memory");
}

struct CvDesc { const float* W; fp8_t* dst; int ldn, ld_dst; };
__device__ __forceinline__ void cv_load64(const CvDesc& d, int lane, f32x4 (&v)[16]) {
    const unsigned voff = (unsigned)(((lane >> 4) * d.ldn + 4 * (lane & 15)) * 4);
#pragma unroll
    for (int i = 0; i < 16; ++i) { const GAS float* rp = (const GAS float*)(d.W + (size_t)(4 * i) * d.ldn);
        asm volatile("s_nop 4\n\tglobal_load_dwordx4 %0, %1, %2" : "=&v"(v[i]) : "v"(voff), "s"(rp) : "memory"); }
}
template <int N> __device__ __forceinline__ void cv_wait(f32x4 (&v)[16]) {
    asm volatile("s_waitcnt vmcnt(%16)" : "+v"(v[0]), "+v"(v[1]), "+v"(v[2]), "+v"(v[3]), "+v"(v[4]), "+v"(v[5]), "+v"(v[6]), "+v"(v[7]), "+v"(v[8]), "+v"(v[9]), "+v"(v[10]), "+v"(v[11]), "+v"(v[12]), "+v"(v[13]), "+v"(v[14]), "+v"(v[15]) : "n"(N) : "memory");
}
__device__ __forceinline__ void cv_proc64(const CvDesc& d, f32x4 (&v)[16], LAS float* scr, int lane) {
#pragma unroll
    for (int i = 0; i < 16; ++i) { LAS float* sp = scr + (4 * i + (lane >> 4)) * 65 + 4 * (lane & 15); sp[0] = v[i].x * WSCALE; sp[1] = v[i].y * WSCALE; sp[2] = v[i].z * WSCALE; sp[3] = v[i].w * WSCALE; }
    LDS_WAIT(); asm volatile("" ::: "memory");
    const int c = lane & 3;
#pragma unroll
    for (int j = 0; j < 4; ++j) { const int n = (lane >> 2) + 16 * j; const LAS float* s = scr + (16 * c) * 65 + n;
        u32x4 o; o.x = pk4_fp8(s[0 * 65], s[1 * 65], s[2 * 65], s[3 * 65]); o.y = pk4_fp8(s[4 * 65], s[5 * 65], s[6 * 65], s[7 * 65]);
        o.z = pk4_fp8(s[8 * 65], s[9 * 65], s[10 * 65], s[11 * 65]); o.w = pk4_fp8(s[12 * 65], s[13 * 65], s[14 * 65], s[15 * 65]);
        *(GAS u32x4*)(d.dst + (size_t)n * d.ld_dst + 16 * c) = o; }
    LDS_WAIT(); asm volatile("" ::: "memory");
}
__device__ __forceinline__ void cv_load_k128(const CvDesc& d, int lane, f32x4 (&v)[16]) {
    const unsigned voff = (unsigned)(((lane >> 3) * d.ldn + 4 * (lane & 7)) * 4);
#pragma unroll
    for (int i = 0; i < 16; ++i) { const GAS float* rp = (const GAS float*)(d.W + (size_t)(8 * i) * d.ldn);
        asm volatile("s_nop 4\n\tglobal_load_dwordx4 %0, %1, %2" : "=&v"(v[i]) : "v"(voff), "s"(rp) : "memory"); }
}
__device__ __forceinline__ void cv_proc_k128(const CvDesc& d, f32x4 (&v)[16], LAS float* scr, int lane) {
#pragma unroll
    for (int i = 0; i < 16; ++i) { LAS float* sp = scr + (8 * i + (lane >> 3)) * 33 + 4 * (lane & 7); sp[0] = v[i].x * WSCALE; sp[1] = v[i].y * WSCALE; sp[2] = v[i].z * WSCALE; sp[3] = v[i].w * WSCALE; }
    LDS_WAIT(); asm volatile("" ::: "memory");
    const int c = lane & 7;
#pragma unroll
    for (int j = 0; j < 4; ++j) { const int n = (lane >> 3) + 8 * j; const LAS float* s = scr + (16 * c) * 33 + n;
        u32x4 o; o.x = pk4_fp8(s[0 * 33], s[1 * 33], s[2 * 33], s[3 * 33]); o.y = pk4_fp8(s[4 * 33], s[5 * 33], s[6 * 33], s[7 * 33]);
        o.z = pk4_fp8(s[8 * 33], s[9 * 33], s[10 * 33], s[11 * 33]); o.w = pk4_fp8(s[12 * 33], s[13 * 33], s[14 * 33], s[15 * 33]);
        *(GAS u32x4*)(d.dst + (size_t)n * d.ld_dst + 16 * c) = o; }
    LDS_WAIT(); asm volatile("" ::: "memory");
}
__device__ __forceinline__ void cv_item_k128(const float* W, int ldn, int k0, int n0, fp8_t* dst, int ld_dst, int drow0, int dk0, LAS float* scr, int lane) {
    const float* wp = W + (size_t)(k0 + (lane >> 3)) * ldn + n0 + 4 * (lane & 7);
    f32x4 v[16];
#pragma unroll
    for (int i = 0; i < 16; ++i) v[i] = *(const GAS f32x4*)(wp + (size_t)(8 * i) * ldn);
    CvDesc d; d.W = W; d.ldn = ldn; d.dst = dst + (size_t)drow0 * ld_dst + dk0 + k0; d.ld_dst = ld_dst;
    cv_proc_k128(d, v, scr, lane);
}
__device__ __forceinline__ void phase_convert_experts(Frame& F, const Args& a, int l, int r0, int r1, int gw, int NGW) {
    LAS float* scr = (LAS float*)(F.lds + F.wave * 16896);
    fp8_t* EXP1 = (fp8_t*)(F.ws + WS_EXP1); fp8_t* EXP2 = (fp8_t*)(F.ws + WS_EXP2);
    const float* e_g = a.in[19] + (size_t)l * NEXP * D * EDIM; const float* e_u = a.in[20] + (size_t)l * NEXP * D * EDIM; const float* e_d = a.in[21] + (size_t)l * NEXP * EDIM * D;
    const float* s_g = a.in[22] + (size_t)l * D * EDIM; const float* s_u = a.in[23] + (size_t)l * D * EDIM; const float* s_d = a.in[24] + (size_t)l * EDIM * D;
    auto desc = [&](int r) -> CvDesc {
        const int e = r / 768, q0 = r % 768, kind = q0 >> 8, q = q0 & 255;
        const float* W = (kind == 0 ? (e < 64 ? e_g + (size_t)e * D * EDIM : s_g) : kind == 1 ? (e < 64 ? e_u + (size_t)e * D * EDIM : s_u) : (e < 64 ? e_d + (size_t)e * D * EDIM : s_d));
        const int ldn = kind == 2 ? D : EDIM, nb = kind == 2 ? 64 : 16, k0 = 128 * (q / nb), n0 = 32 * (q % nb);
        fp8_t* dst = kind == 2 ? EXP2 + (size_t)e * D * EDIM : EXP1 + (size_t)e * 1024 * D;
        const int ld_dst = kind == 2 ? EDIM : D, drow0 = kind == 2 ? n0 : (n0 / 128) * 256 + (kind == 1 ? 128 : 0) + (n0 % 128);
        CvDesc d; d.W = W + (size_t)k0 * ldn + n0; d.ldn = ldn; d.dst = dst + (size_t)drow0 * ld_dst + k0; d.ld_dst = ld_dst; return d; };
    int r = r0 + gw;
    if (r < r1) {
        f32x4 va[16], vb[16]; CvDesc da = desc(r), db = da; cv_load_k128(da, F.lane, va);
        {   const int rn = r + NGW; db = desc(rn < r1 ? rn : r); cv_load_k128(db, F.lane, vb); cv_wait<16>(va); cv_proc_k128(da, va, scr, F.lane); r = rn; }
        while (r < r1) {
            {   const int rn = r + NGW; da = desc(rn < r1 ? rn : r); cv_load_k128(da, F.lane, va); cv_wait<20>(vb); cv_proc_k128(db, vb, scr, F.lane); r = rn; }
            if (r >= r1) break;
            {   const int rn = r + NGW; db = desc(rn < r1 ? rn : r); cv_load_k128(db, F.lane, vb); cv_wait<20>(va); cv_proc_k128(da, va, scr, F.lane); r = rn; }
        }
        asm volatile("s_waitcnt vmcnt(0)" ::: "memory");
    }
}
__device__ __forceinline__ void phase_convert(Frame& F, const Args& a, int l, int it0, int it1, int gw, int NGW, bool do_x) {
    LAS float* scr = (LAS float*)(F.lds + F.wave * 16896);
    const float* w_in = a.in[1] + (size_t)l * D * IN_WIDTH;
    const float* w_br = a.in[13] + (size_t)l * 3 * 1024 * D;
    const float* w_out = a.in[14] + (size_t)l * D * D;
    const float* w_rt = a.in[17] + (size_t)l * D * NEXP;
    const float* e_g = a.in[19] + (size_t)l * NEXP * D * EDIM;
    const float* e_u = a.in[20] + (size_t)l * NEXP * D * EDIM;
    const float* e_d = a.in[21] + (size_t)l * NEXP * EDIM * D;
    const float* s_g = a.in[22] + (size_t)l * D * EDIM;
    const float* s_u = a.in[23] + (size_t)l * D * EDIM;
    const float* s_d = a.in[24] + (size_t)l * EDIM * D;
    fp8_t* WIN = (fp8_t*)(F.ws + WS_WIN); bf16_t* SM = (bf16_t*)(F.ws + WS_SM); fp8_t* WBR = (fp8_t*)(F.ws + WS_WBR); fp8_t* WOUT = (fp8_t*)(F.ws + WS_WOUT);
    bf16_t* RTH = (bf16_t*)(F.ws + WS_RT); bf16_t* RTL = RTH + 64 * D; fp8_t* EXP1 = (fp8_t*)(F.ws + WS_EXP1); fp8_t* EXP2 = (fp8_t*)(F.ws + WS_EXP2);
    constexpr int I_A = 32 * 80, I_B = 32 * 64, I_C = 32 * 96, I_SM = 32, I_BR = 16 * 32, I_WO = 32 * 32, I_RT = 32 * 2, I_EG = 32 * 8, I_ED = 8 * 32;
    for (int it = it0 + gw; it < it1; it += NGW) {
        int r = it;
        if (r < I_A) { cv_item_k128(w_in, IN_WIDTH, 128 * (r / 160), 0 + 32 * (r % 160), WIN, D, 0 + 32 * (r % 160), 0, scr, F.lane); continue; } r -= I_A;
        if (r < I_B) { cv_item_k128(w_in, IN_WIDTH, 128 * (r / 128), 5136 + 32 * (r % 128), WIN, D, 5120 + 32 * (r % 128), 0, scr, F.lane); continue; } r -= I_B;
        if (r < I_C) { cv_item_k128(w_in, IN_WIDTH, 128 * (r / 192), 9248 + 32 * (r % 192), WIN, D, 9216 + 32 * (r % 192), 0, scr, F.lane); continue; } r -= I_C;
        if (r < I_SM) { cv_item_small(w_in, 64 * r, SM, scr, F.lane); continue; } r -= I_SM;
        if (r < 3 * I_BR) { const int br = r / I_BR, q = r % I_BR; cv_item_k128(w_br + (size_t)br * 1024 * D, D, 128 * (q / 64), 32 * (q % 64), WBR, 3072, 32 * (q % 64), 1024 * br, scr, F.lane); continue; } r -= 3 * I_BR;
        if (r < I_WO) { cv_item_k128(w_out, D, 128 * (r / 64), 32 * (r % 64), WOUT, D, 32 * (r % 64), 0, scr, F.lane); continue; } r -= I_WO;
        if (r < I_RT) { cv_item_router(w_rt, 64 * (r / 2), 32 * (r % 2), RTH, RTL, scr, F.lane); continue; } r -= I_RT;
        {
            constexpr int PER = 2 * I_EG + I_ED; const int e = r / PER; int q = r % PER;
            const float* wg = e < 64 ? e_g + (size_t)e * D * EDIM : s_g; const float* wu = e < 64 ? e_u + (size_t)e * D * EDIM : s_u; const float* wd = e < 64 ? e_d + (size_t)e * EDIM * D : s_d;
            fp8_t* d1 = EXP1 + (size_t)e * 1024 * D; fp8_t* d2 = EXP2 + (size_t)e * D * EDIM;
            if (q < I_EG) { const int n0 = 64 * (q % 8); cv_item64(wg, EDIM, 64 * (q / 8), n0, d1, D, (n0 / 128) * 256 + (n0 % 128), 0, scr, F.lane); continue; } q -= I_EG;
            if (q < I_EG) { const int n0 = 64 * (q % 8); cv_item64(wu, EDIM, 64 * (q / 8), n0, d1, D, (n0 / 128) * 256 + 128 + (n0 % 128), 0, scr, F.lane); continue; } q -= I_EG;
            cv_item64(wd, D, 64 * (q / 32), 64 * (q % 32), d2, EDIM, 64 * (q % 32), 0, scr, F.lane);
        }
    }
    if (do_x) {
        const float* x = a.in[0]; fp8_t* XB = (fp8_t*)(F.ws + WS_XB); bf16_t* XR = (bf16_t*)(F.ws + WS_XRES);
        for (int m = gw; m < T; m += NGW) { const GAS f32x4* xr = (const GAS f32x4*)(x + (size_t)m * D) + 2 * F.lane; GAS u32x2* o = (GAS u32x2*)(XB + (size_t)m * D) + F.lane; GAS u32x4* ob = (GAS u32x4*)(XR + (size_t)m * D) + F.lane;
            f32x4 v0[4], v1[4];
#pragma unroll
            for (int j = 0; j < 4; ++j) { v0[j] = xr[128 * j]; v1[j] = xr[128 * j + 1]; }
#pragma unroll
            for (int j = 0; j < 4; ++j) { u32x2 q8; q8.x = pk4_fp8(v0[j].x, v0[j].y, v0[j].z, v0[j].w); q8.y = pk4_fp8(v1[j].x, v1[j].y, v1[j].z, v1[j].w); o[64 * j] = q8;
                u32x4 wb; wb.x = cvt_pk_bf16(v0[j].x, v0[j].y); wb.y = cvt_pk_bf16(v0[j].z, v0[j].w); wb.z = cvt_pk_bf16(v1[j].x, v1[j].y); wb.w = cvt_pk_bf16(v1[j].z, v1[j].w); ob[64 * j] = wb; } }
    }
}

namespace pg8 {
struct EpiBf16 {
    static constexpr bool PERM = true, HAS_MID = false; static constexpr int MID0 = -1, MID1 = -1;
    bf16_t* O; int ldc; int nmod;
    __device__ __forceinline__ void mid(f32x4 (&)[2][2][4][2], const Unit&, int, int, int, int, int) const {}
    __device__ __forceinline__ void operator()(const f32x4 (&acc)[2][2][4][2], const Unit& u, int wr, int wc, int fr, int fq) const {
        const int pl = nmod ? (u.pn % nmod) : u.pn;
        const int row0 = u.pm * BM + wr * 64 + fr, col0 = pl * BM + wc * 32 + 8 * fq;
#pragma unroll
        for (int ai = 0; ai < 2; ++ai)
#pragma unroll
            for (int m = 0; m < 4; ++m) { bf16_t* rowp = O + (size_t)(row0 + ai * HALF + m * 16) * ldc + col0;
#pragma unroll
                for (int bj = 0; bj < 2; ++bj) { const f32x4 v0 = acc[ai][bj][m][0], v1 = acc[ai][bj][m][1];
                    u32x4 w; w.x = cvt_pk_bf16(v0[0], v0[1]); w.y = cvt_pk_bf16(v0[2], v0[3]); w.z = cvt_pk_bf16(v1[0], v1[1]); w.w = cvt_pk_bf16(v1[2], v1[3]);
                    *(u32x4*)(rowp + bj * HALF) = w; } }
    }
};
struct EpiGate {
    static constexpr bool PERM = true, PERM16 = true, HAS_MID = false; static constexpr int MID0 = -1, MID1 = -1;
    unsigned char* G;
    __device__ __forceinline__ void mid(f32x4 (&)[2][2][4][2], const Unit&, int, int, int, int, int) const {}
    __device__ __forceinline__ void operator()(const f32x4 (&acc)[2][2][4][2], const Unit& u, int wr, int wc, int fr, int fq) const {
        const int row0 = u.pm * BM + wr * 64 + fr, col0 = u.pn * BM + wc * 64 + 16 * fq;
#pragma unroll
        for (int ai = 0; ai < 2; ++ai)
#pragma unroll
            for (int m = 0; m < 4; ++m) { unsigned char* rowp = G + (size_t)(row0 + ai * HALF + m * 16) * NGATE + col0; u32x4 w;
#pragma unroll
                for (int bj = 0; bj < 2; ++bj)
#pragma unroll
                    for (int n = 0; n < 2; ++n) { unsigned pk = 0;
#pragma unroll
                        for (int q = 0; q < 4; ++q) pk = __builtin_amdgcn_cvt_pk_u8_f32(fmaxf(__builtin_rintf(255.0f * sigmoidf_(acc[ai][bj][m][n][q])), 1.0f), q, pk);
                        w[2 * bj + n] = pk; }
                *(u32x4*)rowp = w; }
    }
};

struct EpiFp8 {
    static constexpr bool PERM = true, PERM16 = true, HAS_MID = false; static constexpr int MID0 = -1, MID1 = -1;
    fp8_t* O; int ldc; int nmod;
    __device__ __forceinline__ void mid(f32x4 (&)[2][2][4][2], const Unit&, int, int, int, int, int) const {}
    __device__ __forceinline__ void operator()(const f32x4 (&acc)[2][2][4][2], const Unit& u, int wr, int wc, int fr, int fq) const {
        const int pl = nmod ? (u.pn % nmod) : u.pn;
        const int row0 = u.pm * BM + wr * 64 + fr, col0 = pl * BM + wc * 64 + 16 * fq;
#pragma unroll
        for (int ai = 0; ai < 2; ++ai)
#pragma unroll
            for (int m = 0; m < 4; ++m) { fp8_t* rowp = O + (size_t)(row0 + ai * HALF + m * 16) * ldc + col0; u32x4 w;
#pragma unroll
                for (int bj = 0; bj < 2; ++bj)
#pragma unroll
                    for (int n = 0; n < 2; ++n) { const f32x4 v = acc[ai][bj][m][n] * OSCALE; w[2 * bj + n] = pk4_fp8(v[0], v[1], v[2], v[3]); }
                *(u32x4*)rowp = w; }
    }
};
struct EpiSwiglu {
    static constexpr bool PERM = true, HAS_MID = false; static constexpr int MID0 = -1, MID1 = -1;
    fp8_t* O; int ldc;
    __device__ __forceinline__ void mid(f32x4 (&)[2][2][4][2], const Unit&, int, int, int, int, int) const {}
    __device__ __forceinline__ void operator()(const f32x4 (&acc)[2][2][4][2], const Unit& u, int wr, int wc, int fr, int fq) const {
        const int pl = u.pn & 3;
        const int row0 = u.pm * BM + wr * 64 + fr, col0 = pl * HALF + wc * 32 + 8 * fq;
#pragma unroll
        for (int ai = 0; ai < 2; ++ai)
#pragma unroll
            for (int m = 0; m < 4; ++m) { fp8_t* rowp = O + (size_t)(row0 + ai * HALF + m * 16) * ldc + col0;
                float h[8];
#pragma unroll
                for (int n = 0; n < 2; ++n)
#pragma unroll
                    for (int j = 0; j < 4; ++j) { const float gt = acc[ai][0][m][n][j], up = acc[ai][1][m][n][j]; h[4 * n + j] = siluf_(gt) * up; }
                u32x2 w; w.x = pk4_fp8(h[0], h[1], h[2], h[3]); w.y = pk4_fp8(h[4], h[5], h[6], h[7]);
                *(u32x2*)(rowp) = w; }
    }
};
struct EpiMerge {
    static constexpr bool PERM = true, PERM16 = true, HAS_MID = true; static constexpr int MID0 = 8, MID1 = 16;
    const unsigned char* P; fp8_t* O;
    __device__ __forceinline__ void mid(f32x4 (&acc)[2][2][4][2], const Unit& u, int t, int wr, int wc, int fr, int fq) const {
        const int i = t >> 3;
        unsigned o0 = (unsigned)(u.pm * BM + wr * 64 + fr) * (unsigned)NGATE + (unsigned)((i - 1) * 2048 + u.pn * BM + wc * 64 + 16 * fq);
        asm volatile("" : "+v"(o0));
        const char* Pb = (const char*)P;
#pragma unroll
        for (int ai = 0; ai < 2; ++ai)
#pragma unroll
            for (int m = 0; m < 4; ++m) { const unsigned orow = o0 + (unsigned)((ai * HALF + m * 16) * NGATE);
                const u32x4 ga = *(const u32x4*)(Pb + orow), gb = *(const u32x4*)(Pb + orow + 2048);
#pragma unroll
                for (int bj = 0; bj < 2; ++bj)
#pragma unroll
                    for (int n = 0; n < 2; ++n)
#pragma unroll
                        for (int q = 0; q < 4; ++q) acc[ai][bj][m][n][q] *= (float)((ga[2 * bj + n] >> (8 * q)) & 255u) * __builtin_amdgcn_rcpf((float)((gb[2 * bj + n] >> (8 * q)) & 255u));
                asm volatile("" : "+v"(acc[ai][0][m][0]), "+v"(acc[ai][0][m][1]), "+v"(acc[ai][1][m][0]), "+v"(acc[ai][1][m][1]) :: "memory"); }
    }
    __device__ __forceinline__ void operator()(const f32x4 (&acc)[2][2][4][2], const Unit& u, int wr, int wc, int fr, int fq) const {
        unsigned o0 = (unsigned)(u.pm * BM + wr * 64 + fr) * (unsigned)NGATE + (unsigned)(2 * 2048 + u.pn * BM + wc * 64 + 16 * fq);
        unsigned q0 = (unsigned)(u.pm * BM + wr * 64 + fr) * (unsigned)D + (unsigned)(u.pn * BM + wc * 64 + 16 * fq);
        asm volatile("" : "+v"(o0), "+v"(q0));
        const char* Pb = (const char*)P; char* Ob = (char*)O;
#pragma unroll
        for (int ai = 0; ai < 2; ++ai)
#pragma unroll
            for (int m = 0; m < 4; ++m) { const unsigned orow = o0 + (unsigned)((ai * HALF + m * 16) * NGATE), qrow = q0 + (unsigned)((ai * HALF + m * 16) * D);
                const u32x4 gg = *(const u32x4*)(Pb + orow); u32x4 w;
#pragma unroll
                for (int bj = 0; bj < 2; ++bj)
#pragma unroll
                    for (int n = 0; n < 2; ++n) { float v[4];
#pragma unroll
                        for (int q = 0; q < 4; ++q) v[q] = acc[ai][bj][m][n][q] * ((float)((gg[2 * bj + n] >> (8 * q)) & 255u) * (1.0f / 255.0f));
                        w[2 * bj + n] = pk4_fp8(v[0], v[1], v[2], v[3]); }
                *(u32x4*)(Ob + qrow) = w;
                asm volatile("" ::: "memory"); }
    }
};
struct EpiWout {
    static constexpr bool PERM = true, HAS_MID = false; static constexpr int MID0 = -1, MID1 = -1;
    const bf16_t* Xb; bf16_t* H;
    __device__ __forceinline__ void mid(f32x4 (&)[2][2][4][2], const Unit&, int, int, int, int, int) const {}
    __device__ __forceinline__ void operator()(const f32x4 (&acc)[2][2][4][2], const Unit& u, int wr, int wc, int fr, int fq) const {
        const int row0 = u.pm * BM + wr * 64 + fr, col0 = u.pn * BM + wc * 32 + 8 * fq;
#pragma unroll
        for (int ai = 0; ai < 2; ++ai)
#pragma unroll
            for (int m = 0; m < 4; ++m) { const unsigned off = (unsigned)((row0 + ai * HALF + m * 16) * D + col0);
#pragma unroll
                for (int bj = 0; bj < 2; ++bj) { const u32x4 xp = *(const u32x4*)(Xb + off + bj * HALF);
                    const f32x4 x0 = {bflo(xp.x), bfhi(xp.x), bflo(xp.y), bfhi(xp.y)}, x1 = {bflo(xp.z), bfhi(xp.z), bflo(xp.w), bfhi(xp.w)};
                    const f32x4 h0 = x0 * ALPHA + acc[ai][bj][m][0], h1 = x1 * ALPHA + acc[ai][bj][m][1];
                    u32x4 w; w.x = cvt_pk_bf16(h0[0], h0[1]); w.y = cvt_pk_bf16(h0[2], h0[3]); w.z = cvt_pk_bf16(h1[0], h1[1]); w.w = cvt_pk_bf16(h1[2], h1[3]);
                    *(u32x4*)(H + off + bj * HALF) = w; } }
    }
};
}

#ifndef FUSE_LN1
#define FUSE_LN1 1
#endif
__device__ __forceinline__ void phase_ln1(Frame& F, const Args& a, int l) {
    const int gw = F.bid * NWAVES + F.wave, NGW = F.G * NWAVES;
    bf16_t* H = (bf16_t*)(F.ws + WS_H); fp8_t* X1B = (fp8_t*)(F.ws + WS_X1B);
    const GAS f32x4* gp = (const GAS f32x4*)(a.in[15] + (size_t)l * D) + 2 * F.lane; const GAS f32x4* bp = (const GAS f32x4*)(a.in[16] + (size_t)l * D) + 2 * F.lane;
    for (int m = gw; m < T; m += NGW) {
        GAS u32x4* xr = (GAS u32x4*)(H + (size_t)m * D) + F.lane;
        u32x4 p[4]; float v[4][8]; float s = 0.f;
#pragma unroll
        for (int j = 0; j < 4; ++j) p[j] = xr[64 * j];
#pragma unroll
        for (int j = 0; j < 4; ++j) { v[j][0] = bflo(p[j].x); v[j][1] = bfhi(p[j].x); v[j][2] = bflo(p[j].y); v[j][3] = bfhi(p[j].y); v[j][4] = bflo(p[j].z); v[j][5] = bfhi(p[j].z); v[j][6] = bflo(p[j].w); v[j][7] = bfhi(p[j].w);
            s += ((v[j][0] + v[j][1]) + (v[j][2] + v[j][3])) + ((v[j][4] + v[j][5]) + (v[j][6] + v[j][7])); }
        const float mean = wave_sum(s) * (1.f / D); float s2 = 0.f;
#pragma unroll
        for (int j = 0; j < 4; ++j)
#pragma unroll
            for (int q = 0; q < 8; ++q) { v[j][q] -= mean; s2 += v[j][q] * v[j][q]; }
        const float rstd = 1.f / sqrtf(wave_sum(s2) * (1.f / D) + EPS);
        GAS u32x2* o8 = (GAS u32x2*)(X1B + (size_t)m * D) + F.lane;
#pragma unroll
        for (int j = 0; j < 4; ++j) { const f32x4 g0 = gp[128 * j], g1 = gp[128 * j + 1], b0 = bp[128 * j], b1 = bp[128 * j + 1];
            const f32x4 y0 = {v[j][0] * rstd * g0.x + b0.x, v[j][1] * rstd * g0.y + b0.y, v[j][2] * rstd * g0.z + b0.z, v[j][3] * rstd * g0.w + b0.w};
            const f32x4 y1 = {v[j][4] * rstd * g1.x + b1.x, v[j][5] * rstd * g1.y + b1.y, v[j][6] * rstd * g1.z + b1.z, v[j][7] * rstd * g1.w + b1.w};
            u32x4 w; w.x = cvt_pk_bf16(y0.x, y0.y); w.y = cvt_pk_bf16(y0.z, y0.w); w.z = cvt_pk_bf16(y1.x, y1.y); w.w = cvt_pk_bf16(y1.z, y1.w); xr[64 * j] = w;
            u32x2 q8; q8.x = pk4_fp8(y0.x, y0.y, y0.z, y0.w); q8.y = pk4_fp8(y1.x, y1.y, y1.z, y1.w); o8[64 * j] = q8; }
    }
}

__device__ __forceinline__ void ln1_rows8(Frame& F, const Args& a, int l, int m0) {
    bf16_t* H = (bf16_t*)(F.ws + WS_H); fp8_t* X1B = (fp8_t*)(F.ws + WS_X1B);
    const GAS f32x4* gp = (const GAS f32x4*)(a.in[15] + (size_t)l * D) + 2 * F.lane; const GAS f32x4* bp = (const GAS f32x4*)(a.in[16] + (size_t)l * D) + 2 * F.lane;
    for (int hb = 0; hb < 2; ++hb) {
        u32x4 p[4][4];
#pragma unroll
        for (int r = 0; r < 4; ++r) { const GAS u32x4* xr = (const GAS u32x4*)(H + (size_t)(m0 + 4 * hb + r) * D) + F.lane;
#pragma unroll
            for (int j = 0; j < 4; ++j) p[r][j] = xr[64 * j]; }
#pragma unroll
        for (int r = 0; r < 4; ++r) { const int m = m0 + 4 * hb + r;
            float v[4][8]; float s = 0.f;
#pragma unroll
            for (int j = 0; j < 4; ++j) { v[j][0] = bflo(p[r][j].x); v[j][1] = bfhi(p[r][j].x); v[j][2] = bflo(p[r][j].y); v[j][3] = bfhi(p[r][j].y); v[j][4] = bflo(p[r][j].z); v[j][5] = bfhi(p[r][j].z); v[j][6] = bflo(p[r][j].w); v[j][7] = bfhi(p[r][j].w);
                s += ((v[j][0] + v[j][1]) + (v[j][2] + v[j][3])) + ((v[j][4] + v[j][5]) + (v[j][6] + v[j][7])); }
            const float mean = wave_sum(s) * (1.f / D); float s2 = 0.f;
#pragma unroll
            for (int j = 0; j < 4; ++j)
#pragma unroll
                for (int q = 0; q < 8; ++q) { v[j][q] -= mean; s2 += v[j][q] * v[j][q]; }
            const float rstd = 1.f / sqrtf(wave_sum(s2) * (1.f / D) + EPS);
            GAS u32x4* xw = (GAS u32x4*)(H + (size_t)m * D) + F.lane; GAS u32x2* o8 = (GAS u32x2*)(X1B + (size_t)m * D) + F.lane;
#pragma unroll
            for (int j = 0; j < 4; ++j) { const f32x4 g0 = gp[128 * j], g1 = gp[128 * j + 1], b0 = bp[128 * j], b1 = bp[128 * j + 1];
                const f32x4 y0 = {v[j][0] * rstd * g0.x + b0.x, v[j][1] * rstd * g0.y + b0.y, v[j][2] * rstd * g0.z + b0.z, v[j][3] * rstd * g0.w + b0.w};
                const f32x4 y1 = {v[j][4] * rstd * g1.x + b1.x, v[j][5] * rstd * g1.y + b1.y, v[j][6] * rstd * g1.z + b1.z, v[j][7] * rstd * g1.w + b1.w};
                u32x4 w; w.x = cvt_pk_bf16(y0.x, y0.y); w.y = cvt_pk_bf16(y0.z, y0.w); w.z = cvt_pk_bf16(y1.x, y1.y); w.w = cvt_pk_bf16(y1.z, y1.w); xw[64 * j] = w;
                u32x2 q8; q8.x = pk4_fp8(y0.x, y0.y, y0.z, y0.w); q8.y = pk4_fp8(y1.x, y1.y, y1.z, y1.w); o8[64 * j] = q8; } }
    }
}

__device__ __forceinline__ bf16x8 pack8(const float* v) { u32x4 p; p.x = cvt_pk_bf16(v[0], v[1]); p.y = cvt_pk_bf16(v[2], v[3]); p.z = cvt_pk_bf16(v[4], v[5]); p.w = cvt_pk_bf16(v[6], v[7]); return __builtin_bit_cast(bf16x8, p); }
__device__ __forceinline__ float grp8_max(float v) { v = fmaxf(v, swz_xor<1>(v)); v = fmaxf(v, swz_xor<2>(v)); v = fmaxf(v, swz_xor<4>(v)); return v; }
__device__ __forceinline__ void phase_router(Frame& F, const Args& a, int l) {
    const bf16_t* X1 = (const bf16_t*)(F.ws + WS_H);
    const bf16_t* RTH = (const bf16_t*)(F.ws + WS_RT); const bf16_t* RTL = RTH + 64 * D;
    unsigned long long* SELMASK = (unsigned long long*)(F.ws + WS_MISC + MS_SELMASK); float* SELW = (float*)(F.ws + WS_MISC + MS_SELW); int* CNT = (int*)(F.ws + WS_MISC + MS_CNT);
    LAS float* PART = (LAS float*)F.lds;
    LAS float* LG = (LAS float*)(F.lds + 131072);
    LAS int* CNTL = (LAS int*)(F.lds + 131072 + 16384);
    const int lane = F.lane, w = F.wave, li = lane & 15, lq = lane >> 4;
    const float bias = a.in[18][l * NEXP + lane];
    for (int blk = F.bid; blk < T / 64; blk += F.G) {
#if FUSE_LN1
        ln1_rows8(F, a, l, blk * 64 + w * 8);
        __syncthreads();
#endif
        if (F.tid < 64) CNTL[F.tid] = 0;
        {
            f32x4 acc[4][4];
#pragma unroll
            for (int rt = 0; rt < 4; ++rt)
#pragma unroll
                for (int nb = 0; nb < 4; ++nb) acc[rt][nb] = (f32x4){0.f, 0.f, 0.f, 0.f};
            const bf16_t* xp = X1 + (size_t)(blk * 64 + li) * D + 256 * w + 8 * lq;
            const bf16_t* whp = RTH + (size_t)li * D + 256 * w + 8 * lq;
#pragma unroll 4
            for (int ks = 0; ks < 8; ++ks) {
                bf16x8 xh[4], bh[4];
#pragma unroll
                for (int rt = 0; rt < 4; ++rt) xh[rt] = *(const bf16x8*)(xp + (size_t)(16 * rt) * D + 32 * ks);
#pragma unroll
                for (int nb = 0; nb < 4; ++nb) bh[nb] = *(const bf16x8*)(whp + (size_t)(16 * nb) * D + 32 * ks);
#pragma unroll
                for (int rt = 0; rt < 4; ++rt)
#pragma unroll
                    for (int nb = 0; nb < 4; ++nb) acc[rt][nb] = __builtin_amdgcn_mfma_f32_16x16x32_bf16(xh[rt], bh[nb], acc[rt][nb], 0, 0, 0);
            }
#pragma unroll
            for (int rt = 0; rt < 4; ++rt)
#pragma unroll
                for (int nb = 0; nb < 4; ++nb)
#pragma unroll
                    for (int r = 0; r < 4; ++r) PART[(w * 64 + 16 * rt + 4 * lq + r) * 64 + 16 * nb + li] = acc[rt][nb][r];
        }
        __syncthreads();
#pragma unroll
        for (int i = 0; i < 8; ++i) { const int id = F.tid + 512 * i; float sacc = 0.f;
#pragma unroll
            for (int q = 0; q < 8; ++q) sacc += PART[q * 4096 + id];
            LG[id] = sacc; }
        __syncthreads();
        int mycnt = 0;
        for (int i = 0; i < 8; ++i) {
            const int tl = w * 8 + i, t = blk * 64 + tl;
            const float logit = LG[tl * 64 + lane];
            const float score = 1.0f / (1.0f + expf(-logit));
            const float sel = score + bias;
            const float m1 = grp8_max(sel);
            const unsigned long long eqm = __ballot(sel == m1);
            const unsigned gb = (unsigned)(eqm >> (lane & ~7)) & 0xffu;
            const int first = __builtin_ctz(gb);
            const float v2 = ((lane & 7) == first) ? -INFINITY : sel;
            const float gs = m1 + grp8_max(v2);
            const int g = lane >> 3; int grank = 0;
#pragma unroll
            for (int g2 = 0; g2 < 8; ++g2) { const float o = __builtin_bit_cast(float, __builtin_amdgcn_readlane(__builtin_bit_cast(int, gs), 8 * g2)); grank += (o > gs || (o == gs && g2 < g)) ? 1 : 0; }
            const float mv = grank < 4 ? sel : -INFINITY;
            int rank = 0;
#pragma unroll 4
            for (int e2 = 0; e2 < 64; ++e2) { const float o = __builtin_bit_cast(float, __builtin_amdgcn_readlane(__builtin_bit_cast(int, mv), e2)); rank += (o > mv || (o == mv && e2 < lane)) ? 1 : 0; }
            const bool chosen = rank < 8;
            const unsigned long long mask = __ballot(chosen);
            const float wsum = wave_sum(chosen ? score : 0.f);
            const float wgt = score / wsum * 2.5f;
            if (chosen) { const int j = __builtin_popcountll(mask & ((1ull << lane) - 1ull)); SELW[(size_t)t * 8 + j] = wgt; }
            if (lane == 0) SELMASK[t] = mask;
            mycnt += chosen ? 1 : 0;
        }
        __hip_atomic_fetch_add(&CNTL[lane], mycnt, __ATOMIC_RELAXED, __HIP_MEMORY_SCOPE_WORKGROUP);
        __syncthreads();
        if (F.tid < 64) CNT[blk * 64 + F.tid] = CNTL[F.tid];
        __syncthreads();
    }
}

__device__ __forceinline__ void phase_lists(Frame& F) {
    const unsigned long long* SELMASK = (const unsigned long long*)(F.ws + WS_MISC + MS_SELMASK); const int* CNT = (const int*)(F.ws + WS_MISC + MS_CNT);
    int* TOK2SLOT = (int*)(F.ws + WS_MISC + MS_TOK2SLOT); int* SLOTTOK = (int*)(F.ws + WS_MISC + MS_SLOTTOK); int* BLKE = (int*)(F.ws + WS_MISC + MS_BLKE); int* NBLK = (int*)(F.ws + WS_MISC + MS_NBLK);
    LAS int* P = (LAS int*)F.lds;
    LAS int* TOT = P + 1024;
    LAS int* PST = TOT + 64; LAS int* BASE = TOT + 192;
    const int lane = F.lane, e = F.tid & 63, part = F.tid >> 6;
    for (int blk = F.bid; blk < T / 64; blk += F.G) {
        int tot = 0, pre = 0;
        for (int b2 = part; b2 < T / 64; b2 += 8) { const int c = CNT[b2 * 64 + e]; tot += c; pre += (b2 < blk) ? c : 0; }
        P[part * 64 + e] = tot; P[512 + part * 64 + e] = pre;
        __syncthreads();
        if (F.tid < 64) { int t2 = 0, p2 = 0;
#pragma unroll
            for (int q = 0; q < 8; ++q) { t2 += P[q * 64 + e]; p2 += P[512 + q * 64 + e]; }
            TOT[e] = t2; BASE[e] = p2;
            const int padded = (t2 + 255) & ~255;
            const int incl = wave_scan_i(padded, lane);
            PST[e] = incl - padded; if (e == 63) PST[64] = incl;
        }
        __syncthreads();
        if (F.wave == 0) {
            int running = PST[lane] + BASE[lane];
            const unsigned long long mymask = SELMASK[blk * 64 + lane];
            const unsigned mlo = (unsigned)mymask, mhi = (unsigned)(mymask >> 32);
            for (int i = 0; i < 64; ++i) {
                const unsigned long long mk = ((unsigned long long)(unsigned)__builtin_amdgcn_readlane((int)mhi, i) << 32) | (unsigned)__builtin_amdgcn_readlane((int)mlo, i);
                if ((mk >> lane) & 1ull) { const int t = blk * 64 + i, j = __builtin_popcountll(mk & ((1ull << lane) - 1ull)); TOK2SLOT[t * 8 + j] = running; SLOTTOK[running] = t; ++running; }
            }
        }
        if (blk == 0) {
            const int nblk = PST[64] >> 8;
            if (F.tid == 0) NBLK[0] = nblk;
            for (int ee = F.wave; ee < 64; ee += NWAVES) { const int s0 = PST[ee] + TOT[ee], s1 = PST[ee + 1]; for (int s = s0 + lane; s < s1; s += 64) SLOTTOK[s] = 0;
                for (int j = (PST[ee] >> 8) + lane; j < (PST[ee + 1] >> 8); j += 64) BLKE[j] = ee; }
            for (int j = F.tid; j < 64; j += NTHR) BLKE[MAXSLOT / 256 + j] = 64;
        }
        for (int i = F.tid; i < 64; i += NTHR) SLOTTOK[MAXSLOT + blk * 64 + i] = blk * 64 + i;
        __syncthreads();
    }
}

constexpr int MOE_TOKL = 131072, MOE_BLKL = 131072 + 12288;
__device__ __forceinline__ bool moe_unit(int i, int c, int G, int NT, int nb, int& j, int& pl) {
    if ((G & 7) == 0 && ((G >> 3) % NT) == 0) { const int W = G >> 3, x = c & 7, q = c >> 3; j = i * (G / NT) + x * (W / NT) + q / NT; pl = q % NT; return j < nb; }
    const int L = i * G + c; j = L / NT; pl = L - j * NT; return j < nb;
}
struct MoeOrder2 {
    const LAS int* blke_l; int nblk, NT, G, c;
    __device__ bool next(int i, pg8::Unit& u) const {
        int j, pl; if (!moe_unit(i, c, G, NT, nblk + 64, j, pl)) return false;
        const int jj = j < nblk ? j : (MAXSLOT / 256 + (j - nblk));
        u.pm = jj; u.pn = __builtin_amdgcn_readfirstlane(blke_l[i]) * NT + pl; return true;
    }
};
template <bool GATHER> __device__ __forceinline__ void moe_fill(Frame& F, int nblk, int NT) {
    const int* BLKE = (const int*)(F.ws + WS_MISC + MS_BLKE); const int* SLOTTOK = (const int*)(F.ws + WS_MISC + MS_SLOTTOK);
    LAS int* TOKL = (LAS int*)(F.lds + MOE_TOKL); LAS int* BLKL = (LAS int*)(F.lds + MOE_BLKL);
    for (int i = 0; i < (GATHER ? 12 : 64); ++i) { int j, pl; if (!moe_unit(i, F.bid, F.G, NT, nblk + 64, j, pl)) break;
        const int jj = j < nblk ? j : (MAXSLOT / 256 + (j - nblk));
        if (F.tid == 0) BLKL[i] = BLKE[jj];
        if (GATHER && F.tid < 256) TOKL[i * 256 + F.tid] = SLOTTOK[jj * 256 + F.tid]; }
    __syncthreads();
}

__device__ __forceinline__ void phase_combine(Frame& F, const Args& a, int l) {
    const int gw = F.bid * NWAVES + F.wave, NGW = F.G * NWAVES;
    const GAS char* X1 = (const GAS char*)(F.ws + WS_H); const GAS char* OS = (const GAS char*)(F.ws + WS_OS);
    const int* TOK2SLOT = (const int*)(F.ws + WS_MISC + MS_TOK2SLOT); const float* SELW = (const float*)(F.ws + WS_MISC + MS_SELW);
    GAS char* XRES = (GAS char*)((l == DEPTH - 1) ? a.out : (float*)(F.ws + WS_XRES)); GAS char* XB = (GAS char*)(F.ws + WS_XB);
    const GAS char* gp = (const GAS char*)(a.in[25] + (size_t)l * D); const GAS char* bp = (const GAS char*)(a.in[26] + (size_t)l * D);
    for (int m = gw; m < T; m += NGW) {
        int ln = F.lane; asm volatile("" : "+v"(ln));
        const unsigned o32 = (unsigned)ln * 32u, o8 = (unsigned)ln * 8u;
        int slot[8]; float wt[8];
#pragma unroll
        for (int k = 0; k < 8; ++k) { slot[k] = __builtin_amdgcn_readfirstlane(TOK2SLOT[m * 8 + k]); wt[k] = __builtin_bit_cast(float, __builtin_amdgcn_readfirstlane(__builtin_bit_cast(int, SELW[m * 8 + k]))) * (1.0f / OSCALE); }
        const GAS char* xr = X1 + (size_t)m * (D * 2); const GAS char* shr = OS + (size_t)(MAXSLOT + m) * D;
        float v[4][8];
#pragma unroll
        for (int j = 0; j < 4; ++j) {
            const u32x4 xp8 = *(const GAS u32x4*)(xr + 2u * o8 + 1024 * j);
            const u32x2 sh = *(const GAS u32x2*)(shr + o8 + 512 * j);
            u32x2 ex[8];
#pragma unroll
            for (int k = 0; k < 8; ++k) ex[k] = *(const GAS u32x2*)(OS + (size_t)slot[k] * D + o8 + 512 * j);
            float acc[8] = {bflo(xp8.x) * ALPHA, bfhi(xp8.x) * ALPHA, bflo(xp8.y) * ALPHA, bfhi(xp8.y) * ALPHA, bflo(xp8.z) * ALPHA, bfhi(xp8.z) * ALPHA, bflo(xp8.w) * ALPHA, bfhi(xp8.w) * ALPHA};
            {   float f0[4], f1[4]; unpk4_fp8(sh.x, f0); unpk4_fp8(sh.y, f1);
#pragma unroll
                for (int q = 0; q < 4; ++q) { acc[q] += f0[q] * (1.0f / OSCALE); acc[4 + q] += f1[q] * (1.0f / OSCALE); } }
#pragma unroll
            for (int k = 0; k < 8; ++k) { float f0[4], f1[4]; unpk4_fp8(ex[k].x, f0); unpk4_fp8(ex[k].y, f1);
#pragma unroll
                for (int q = 0; q < 4; ++q) { acc[q] += wt[k] * f0[q]; acc[4 + q] += wt[k] * f1[q]; } }
#pragma unroll
            for (int q = 0; q < 8; ++q) v[j][q] = acc[q];
        }
        float s = 0.f;
#pragma unroll
        for (int j = 0; j < 4; ++j)
#pragma unroll
            for (int q = 0; q < 8; ++q) s += v[j][q];
        const float mean = wave_sum(s) * (1.f / D); float s2 = 0.f;
#pragma unroll
        for (int j = 0; j < 4; ++j)
#pragma unroll
            for (int q = 0; q < 8; ++q) { v[j][q] -= mean; s2 += v[j][q] * v[j][q]; }
        const float rstd = 1.f / sqrtf(wave_sum(s2) * (1.f / D) + EPS);
        GAS char* orow = XRES + (size_t)m * (D * 4); GAS char* orow16 = XRES + (size_t)m * (D * 2); GAS char* xbr = XB + (size_t)m * D;
#pragma unroll
        for (int j = 0; j < 4; ++j) { const f32x4 g0 = *(const GAS f32x4*)(gp + o32 + 2048 * j), g1 = *(const GAS f32x4*)(gp + o32 + 2048 * j + 16), b0 = *(const GAS f32x4*)(bp + o32 + 2048 * j), b1 = *(const GAS f32x4*)(bp + o32 + 2048 * j + 16);
            const f32x4 y0 = {v[j][0] * rstd * g0.x + b0.x, v[j][1] * rstd * g0.y + b0.y, v[j][2] * rstd * g0.z + b0.z, v[j][3] * rstd * g0.w + b0.w};
            const f32x4 y1 = {v[j][4] * rstd * g1.x + b1.x, v[j][5] * rstd * g1.y + b1.y, v[j][6] * rstd * g1.z + b1.z, v[j][7] * rstd * g1.w + b1.w};
            if (l == DEPTH - 1) { *(GAS f32x4*)(orow + o32 + 2048 * j) = y0; *(GAS f32x4*)(orow + o32 + 2048 * j + 16) = y1; }
            else {
                u32x4 wb; wb.x = cvt_pk_bf16(y0.x, y0.y); wb.y = cvt_pk_bf16(y0.z, y0.w); wb.z = cvt_pk_bf16(y1.x, y1.y); wb.w = cvt_pk_bf16(y1.z, y1.w); *(GAS u32x4*)(orow16 + 2u * o8 + 1024 * j) = wb;
                u32x2 w; w.x = pk4_fp8(y0.x, y0.y, y0.z, y0.w); w.y = pk4_fp8(y1.x, y1.y, y1.z, y1.w); *(GAS u32x2*)(xbr + o8 + 512 * j) = w; } }
    }
}

typedef short v4i16_t __attribute__((ext_vector_type(4)));
__device__ __forceinline__ unsigned offb(unsigned row, unsigned ch) { return 256u * row + 16u * (ch ^ (((row & 3u) << 2) | ((row >> 2) & 3u))); }
__device__ __forceinline__ s16x4 trr(const LAS unsigned char* p) { return __builtin_bit_cast(s16x4, __builtin_amdgcn_ds_read_tr16_b64_v4i16((LAS v4i16_t*)p)); }
#define MFMA32(a, b, c) __builtin_amdgcn_mfma_f32_32x32x16_bf16((a), (b), (c), 0, 0, 0)
__device__ __forceinline__ int crow(int i, int hh) { return (i & 3) + 8 * (i >> 2) + 4 * hh; }
__device__ __forceinline__ bf16x8 frag_row(const LAS unsigned char* img, int row0, int s, int lane) { return *(const LAS bf16x8*)(img + offb(row0 + (lane & 31), 2 * s + (lane >> 5))); }
template <bool PERMK> __device__ __forceinline__ bf16x8 frag_tr(const LAS unsigned char* img, int cb, int k0, int lane) {
    const int hh = lane >> 5, blk = (lane >> 4) & 1, q = (lane & 15) >> 2, p = lane & 3;
    const int r0 = PERMK ? (k0 + 4 * hh + q) : (k0 + 8 * hh + q), r1 = PERMK ? (r0 + 8) : (r0 + 4);
    const int ch = 4 * cb + 2 * blk + (p >> 1);
    const s16x4 lo = trr(img + offb(r0, ch) + 8 * (p & 1)), hi = trr(img + offb(r1, ch) + 8 * (p & 1));
    return __builtin_shufflevector(lo, hi, 0, 1, 2, 3, 4, 5, 6, 7);
}
__device__ __forceinline__ bf16x8 pack_acc(const f32x16& x, int half) {
    u32x4 p;
    if (half == 0) { p.x = cvtpk(x[0], x[1]); p.y = cvtpk(x[2], x[3]); p.z = cvtpk(x[4], x[5]); p.w = cvtpk(x[6], x[7]); }
    else { p.x = cvtpk(x[8], x[9]); p.y = cvtpk(x[10], x[11]); p.z = cvtpk(x[12], x[13]); p.w = cvtpk(x[14], x[15]); }
    return __builtin_bit_cast(bf16x8, p);
}

__device__ __forceinline__ void attn_unit(Frame& F, const bf16_t* PROJ, fp8_t* BRCAT, const float* normg, int b, int h, int j, float lam, float lam_init) {
    int tid_ = F.tid; asm volatile("" : "+v"(tid_));
    const int tid = tid_, lane = tid & 63, w = F.wave, c = w >> 2, r0 = 32 * (w & 3), r32 = lane & 31, hh = lane >> 5;
    LAS unsigned char* lds = F.lds;
    unsigned rowa = offb(r32, hh), tb[4][2];
    {   const int blk = (lane >> 4) & 1, q = (lane & 15) >> 2, p = lane & 3; const unsigned tra = 32768u + offb(4 * hh + q, 2 * blk + (p >> 1)) + 8 * (p & 1);
#pragma unroll
        for (int cb = 0; cb < 4; ++cb) { tb[cb][0] = tra ^ (64u * cb); tb[cb][1] = ((tra ^ (64u * cb)) ^ 32u) + 2048u; asm volatile("" : "+v"(tb[cb][0]), "+v"(tb[cb][1])); } }
    asm volatile("" : "+v"(rowa));
    const unsigned kq = (unsigned)(c * 16384), qq = (unsigned)(65536 + w * 8192);
    unsigned ko = (unsigned)(((tid >> 4) * NPROJ + PQ_DAK + h * 256 + 8 * (tid & 15)) * 2), vo = (unsigned)(((tid >> 5) * NPROJ + PQ_DAV + h * 256 + 8 * (tid & 31)) * 2);
    unsigned kl = offb(tid >> 4, tid & 15), vl = 32768u + ((tid >> 4) & 1) * 16384u + offb(tid >> 5, tid & 15);
    asm volatile("" : "+v"(ko), "+v"(vo), "+v"(kl), "+v"(vl));
    const float c1 = 0.08838834764831845f * 1.4426950408889634f;
    __syncthreads();
    {   int ln = lane; asm volatile("" : "+v"(ln));
        const char* qp = (const char*)(PROJ + ((size_t)b * SEQ + 128 * j + r0) * NPROJ + PQ_DAQ + h * 256 + c * 128);
#pragma unroll
        for (int i = 0; i < 8; ++i) { const int id = ln + 64 * i, row = id >> 4, ch = id & 15; const u32x4 qv = *(const u32x4*)(qp + (unsigned)((row * NPROJ + 8 * ch) * 2));
            u32x4 qs; qs.x = cvtpk(bflo(qv.x) * c1, bfhi(qv.x) * c1); qs.y = cvtpk(bflo(qv.y) * c1, bfhi(qv.y) * c1); qs.z = cvtpk(bflo(qv.z) * c1, bfhi(qv.z) * c1); qs.w = cvtpk(bflo(qv.w) * c1, bfhi(qv.w) * c1);
            *(LAS u32x4*)(lds + qq + offb(row, ch)) = qs; } }
    f32x16 o[8];
#pragma unroll
    for (int eb = 0; eb < 8; ++eb)
#pragma unroll
        for (int i = 0; i < 16; ++i) o[eb][i] = 0.f;
    float mrun = 0.f, lrun = 0.f;
    const int qpos = 128 * j + r0 + r32;
    const float c2 = __builtin_amdgcn_exp2f(-2.0f * (float)(h + 1)) * 1.4426950408889634f;
    const int nt = 2 * (j + 1);
    u32x4 k1a, k2a, k1b, k2b, v0, v1, v2, v3;
#define ATT_LOAD(kt_) do { const char* kb_ = (const char*)(PROJ + ((size_t)b * SEQ + 64 * (kt_)) * NPROJ); \
        k1a = *(const u32x4*)(kb_ + ko); k2a = *(const u32x4*)(kb_ + ko + 256); k1b = *(const u32x4*)(kb_ + ko + 32 * NPROJ * 2); k2b = *(const u32x4*)(kb_ + ko + 32 * NPROJ * 2 + 256); \
        v0 = *(const u32x4*)(kb_ + vo); v1 = *(const u32x4*)(kb_ + vo + 16 * NPROJ * 2); v2 = *(const u32x4*)(kb_ + vo + 32 * NPROJ * 2); v3 = *(const u32x4*)(kb_ + vo + 48 * NPROJ * 2); } while (0)
    ATT_LOAD(0);
    for (int kt = 0; kt < nt; ++kt) {
        __syncthreads();
        *(LAS u32x4*)(lds + kl) = k1a; *(LAS u32x4*)(lds + kl + 16384) = k2a; *(LAS u32x4*)(lds + kl + 8192) = k1b; *(LAS u32x4*)(lds + kl + 8192 + 16384) = k2b;
        *(LAS u32x4*)(lds + vl) = v0; *(LAS u32x4*)(lds + vl + 4096) = v1; *(LAS u32x4*)(lds + vl + 8192) = v2; *(LAS u32x4*)(lds + vl + 12288) = v3;
        __syncthreads();
        if (kt + 1 < nt) ATT_LOAD(kt + 1);
        const int kbase = 64 * kt + 4 * hh - qpos;
        const float fkb = c2 * (float)kbase - (kt == 0 ? 0.f : mrun);
        f32x16 p0, p1;
#pragma unroll
        for (int i = 0; i < 16; ++i) { p0[i] = fmaf(c2, (float)((i & 3) + 8 * (i >> 2)), fkb); p1[i] = fmaf(c2, (float)(32 + (i & 3) + 8 * (i >> 2)), fkb); }
#pragma unroll
        for (int s = 0; s < 8; ++s) { const unsigned ra = rowa ^ (32u * s); const bf16x8 a0 = *(const LAS bf16x8*)(lds + kq + ra), a1 = *(const LAS bf16x8*)(lds + kq + ra + 8192), qv = *(const LAS bf16x8*)(lds + qq + ra);
            p0 = MFMA32(a0, qv, p0); p1 = MFMA32(a1, qv, p1); }
        if (kt >= 2 * j) {
#pragma unroll
            for (int i = 0; i < 16; ++i) { const int dk = kbase + (i & 3) + 8 * (i >> 2); if (dk > 0) p0[i] = -INFINITY; if (dk + 32 > 0) p1[i] = -INFINITY; } }
        float mx = fmaxf(p0[0], p1[0]);
#pragma unroll
        for (int i = 1; i < 16; ++i) mx = fmaxf(fmaxf(mx, p0[i]), p1[i]);
        mx = x32_max(mx);
        if (kt == 0) {
#pragma unroll
            for (int i = 0; i < 16; ++i) { p0[i] -= mx; p1[i] -= mx; }
            mrun = mx; mx = 0.f; }
        float psum = 0.f;
#pragma unroll
        for (int i = 0; i < 16; ++i) { p0[i] = __builtin_amdgcn_exp2f(p0[i]); p1[i] = __builtin_amdgcn_exp2f(p1[i]); psum += p0[i] + p1[i]; }
        lrun += psum;
        bf16x8 pf[4]; pf[0] = pack_acc(p0, 0); pf[1] = pack_acc(p0, 1); pf[2] = pack_acc(p1, 0); pf[3] = pack_acc(p1, 1);
#pragma unroll
        for (int ks = 0; ks < 4; ++ks)
#pragma unroll
            for (int eb = 0; eb < 8; ++eb) { const unsigned ab = (eb >> 2) * 16384 + ks * 4096;
                const s16x4 lo = trr(lds + tb[eb & 3][0] + ab), hi = trr(lds + tb[eb & 3][1] + ab);
                const bf16x8 va = __builtin_shufflevector(lo, hi, 0, 1, 2, 3, 4, 5, 6, 7); o[eb] = MFMA32(va, pf[ks], o[eb]); }
        const float dm = fmaxf(mx, 0.f);
        if (__builtin_amdgcn_ballot_w64(dm > 0.f) != 0ull) { const float sc = __builtin_amdgcn_exp2f(-dm);
#pragma unroll
            for (int eb = 0; eb < 8; ++eb) o[eb] = o[eb] * sc;
            lrun *= sc; mrun += dm; }
    }
#undef ATT_LOAD
    asm volatile("" : "+s"(normg), "+s"(BRCAT) :: "memory");
    const GAS float* normg_g = (const GAS float*)normg; GAS fp8_t* brcat_g = (GAS fp8_t*)BRCAT;
    const float lsum = x32_sum(lrun), inv = 1.0f / lsum;
    LAS float* XCH = (LAS float*)lds;
    int ln2 = lane; asm volatile("" : "+v"(ln2));
    const int hh2 = ln2 >> 5;
    __syncthreads();
    if (c == 1) {
        const float sc = inv * lam;
#pragma unroll
        for (int eb = 0; eb < 8; ++eb)
#pragma unroll
            for (int i = 0; i < 16; ++i) XCH[(((w & 3) * 128 + eb * 16 + i) << 6) + ln2] = o[eb][i] * sc;
    }
    __syncthreads();
    if (c == 0) {
        float ss = 0.f;
#pragma unroll
        for (int eb = 0; eb < 8; ++eb)
#pragma unroll
            for (int i = 0; i < 16; ++i) { const float v = o[eb][i] * inv - XCH[(((w & 3) * 128 + eb * 16 + i) << 6) + ln2]; o[eb][i] = v; ss += v * v; }
        ss = x32_sum(ss);
        const float rstd = (1.0f - lam_init) / sqrtf(ss * (1.0f / 256.0f) + EPS);
        GAS char* op = (GAS char*)(brcat_g + ((size_t)b * SEQ + 128 * j + r0) * 3072 + h * 256);
        const unsigned oo = (unsigned)((ln2 & 31) * 3072 + 4 * hh2);
#pragma unroll
        for (int eb = 0; eb < 8; ++eb)
#pragma unroll
            for (int g = 0; g < 4; ++g) { const int e0 = 32 * eb + 8 * g; const f32x4 gn = *(const GAS f32x4*)(normg_g + e0 + 4 * hh2);
                *(GAS unsigned*)(op + oo + e0) = pk4_fp8(o[eb][4 * g] * rstd * gn.x, o[eb][4 * g + 1] * rstd * gn.y, o[eb][4 * g + 2] * rstd * gn.z, o[eb][4 * g + 3] * rstd * gn.w); }
    }
}
__device__ __forceinline__ void phase_attn(Frame& F, const Args& a, int l) {
    const bf16_t* PROJ = (const bf16_t*)(F.ws + WS_PROJ); fp8_t* BRCAT = (fp8_t*)(F.ws + WS_BRCAT);
    const float* lp = a.in[2] + (size_t)l * 4 * 128; const float* normg = a.in[3] + (size_t)l * 256;
    const float s01 = wave_sum(lp[F.lane] * lp[128 + F.lane] + lp[64 + F.lane] * lp[192 + F.lane]);
    const float s23 = wave_sum(lp[256 + F.lane] * lp[384 + F.lane] + lp[320 + F.lane] * lp[448 + F.lane]);
    const float lam_init = 0.8f - 0.6f * expf(-0.3f * (float)l);
    const float lam = __builtin_bit_cast(float, __builtin_amdgcn_readfirstlane(__builtin_bit_cast(int, expf(s01) - expf(s23) + lam_init)));
    volatile LAS unsigned* qslot = (volatile LAS unsigned*)(F.lds + MISC_OFF + 128);
    for (;;) {
        __syncthreads();
        if (F.tid == 0) *qslot = __hip_atomic_fetch_add((unsigned*)(F.ws + WS_CTL) + CW_ATTQ + 64 * l, 1u, __ATOMIC_RELAXED, __HIP_MEMORY_SCOPE_AGENT);
        __syncthreads();
        const int k = __builtin_amdgcn_readfirstlane((int)*qslot);
        if (k >= 512) break;
        const int bh = k & 15, b = bh >> 2, h = bh & 3;
        attn_unit(F, PROJ, BRCAT, normg, b, h, 31 - (k >> 4), lam, lam_init);
    }
}


__device__ __forceinline__ void gla_gates(Frame& F, const float* SMALL, const float* w2, const float* b2, int h, size_t t0, float (&bc)[16], float& btot) {
    LAS float* LR = (LAS float*)F.lds; LAS float* GT = (LAS float*)(F.lds + 4096);
    const int tid = F.tid, d = tid & 127, g4 = tid >> 7;
#pragma unroll
    for (int i = 0; i < 2; ++i) { const int id = tid + 512 * i, pos = id >> 4, r = id & 15; LR[id] = SMALL[(t0 + pos) * 32 + r]; }
    float wv[16];
#pragma unroll
    for (int r = 0; r < 16; ++r) wv[r] = w2[r * 512 + h * 128 + d];
    const float bb = b2[h * 128 + d];
    __syncthreads();
    float run = 0.f;
#pragma unroll
    for (int i = 0; i < 16; ++i) { const int pos = 16 * g4 + i; float z = bb;
#pragma unroll
        for (int r4 = 0; r4 < 4; ++r4) { const f32x4 lv = *(const LAS f32x4*)(LR + pos * 16 + 4 * r4); z += lv.x * wv[4 * r4] + lv.y * wv[4 * r4 + 1] + lv.z * wv[4 * r4 + 2] + lv.w * wv[4 * r4 + 3]; }
        const float ls = fminf(z, 0.f) - fast_log(1.0f + fast_exp(-fabsf(z)));
        run += ls * (1.0f / 16.0f); bc[i] = run; }
    GT[g4 * 128 + d] = run;
    __syncthreads();
    float pre = 0.f, tot = 0.f;
#pragma unroll
    for (int q = 0; q < 4; ++q) { const float v = GT[q * 128 + d]; tot += v; pre += (q < g4) ? v : 0.f; }
#pragma unroll
    for (int i = 0; i < 16; ++i) bc[i] += pre;
    btot = tot;
}
__device__ __forceinline__ void gla_stage_v(Frame& F, const bf16_t* PROJ, int h, size_t t0, int voff) {
#pragma unroll
    for (int i = 0; i < 4; ++i) { const int cid = F.tid + 512 * i, row = cid >> 5, c32 = cid & 31;
        const u32x4 v = *(const u32x4*)(PROJ + (t0 + row) * NPROJ + PQ_GV + h * 256 + 8 * c32);
        *(LAS u32x4*)(F.lds + voff + (c32 >> 4) * 16384 + offb(row, c32 & 15)) = v; }
}
__device__ __forceinline__ void gla_stage128(Frame& F, const bf16_t* PROJ, int col0, size_t t0, int off) {
#pragma unroll
    for (int i = 0; i < 2; ++i) { const int cid = F.tid + 512 * i, row = cid >> 4, ch = cid & 15;
        *(LAS u32x4*)(F.lds + off + offb(row, ch)) = *(const u32x4*)(PROJ + (t0 + row) * NPROJ + col0 + 8 * ch); }
}
__device__ __forceinline__ void phase_gla_local(Frame& F, const Args& a, int l) {
    const bf16_t* PROJ = (const bf16_t*)(F.ws + WS_PROJ); const float* SMALL = (const float*)(F.ws + WS_SMALL);
    bf16_t* UPDT = (bf16_t*)(F.ws + WS_UPDT); float* GDEC = (float*)(F.ws + WS_GDEC);
    const float* w2 = a.in[4] + (size_t)l * 16 * 512; const float* b2 = a.in[5] + (size_t)l * 512;
    const int w = F.wave;
    constexpr int KDT = 8192, VOFF = 40960, KRAW = 73728;
    u32x4 pk[2], pv[4];
    auto ldkv = [&](int uu) { const int bh2 = uu >> 6, n2 = uu & 63, b2i = bh2 >> 2, h2 = bh2 & 3; const size_t tt = (size_t)b2i * SEQ + 64 * n2;
#pragma unroll
        for (int i = 0; i < 2; ++i) { const int cid = F.tid + 512 * i, row = cid >> 4, ch = cid & 15; pk[i] = *(const u32x4*)(PROJ + (tt + row) * NPROJ + PQ_GK + h2 * 128 + 8 * ch); }
#pragma unroll
        for (int i = 0; i < 4; ++i) { const int cid = F.tid + 512 * i, row = cid >> 5, c32 = cid & 31; pv[i] = *(const u32x4*)(PROJ + (tt + row) * NPROJ + PQ_GV + h2 * 256 + 8 * c32); } };
    if (F.bid < 1024) ldkv(F.bid);
    for (int u = F.bid; u < 1024; u += F.G) {
        const int bh = u >> 6, n = u & 63, b = bh >> 2, h = bh & 3; const size_t t0 = (size_t)b * SEQ + 64 * n;
        int tid_ = F.tid; asm volatile("" : "+v"(tid_));
        const int tid = tid_, lane = tid & 63, d = tid & 127, g4 = tid >> 7, r32 = lane & 31, hh = lane >> 5;
        __syncthreads();
        float bc[16], btot;
#pragma unroll
        for (int i = 0; i < 2; ++i) { const int cid = F.tid + 512 * i, row = cid >> 4, ch = cid & 15; *(LAS u32x4*)(F.lds + KRAW + offb(row, ch)) = pk[i]; }
#pragma unroll
        for (int i = 0; i < 4; ++i) { const int cid = F.tid + 512 * i, row = cid >> 5, c32 = cid & 31; *(LAS u32x4*)(F.lds + VOFF + (c32 >> 4) * 16384 + offb(row, c32 & 15)) = pv[i]; }
        gla_gates(F, SMALL, w2, b2, h, t0, bc, btot);
        { const int un = u + F.G; ldkv(un < 1024 ? un : u); }
        {   float kd[16];
#pragma unroll
            for (int i = 0; i < 16; ++i) kd[i] = bf2f(*(const LAS unsigned short*)(F.lds + KRAW + offb(16 * g4 + i, d >> 3) + 2 * (d & 7))) * fast_exp(btot - bc[i]);
            u32x4 w0, w1; w0.x = cvtpk(kd[0], kd[1]); w0.y = cvtpk(kd[2], kd[3]); w0.z = cvtpk(kd[4], kd[5]); w0.w = cvtpk(kd[6], kd[7]);
            w1.x = cvtpk(kd[8], kd[9]); w1.y = cvtpk(kd[10], kd[11]); w1.z = cvtpk(kd[12], kd[13]); w1.w = cvtpk(kd[14], kd[15]);
            *(LAS u32x4*)(F.lds + KDT + offb(d, 2 * g4)) = w0; *(LAS u32x4*)(F.lds + KDT + offb(d, 2 * g4 + 1)) = w1;
            if (g4 == 0) GDEC[((size_t)bh * 64 + n) * 128 + d] = fast_exp(btot);
        }
        __syncthreads();
        f32x16 acc[4];
#pragma unroll
        for (int db = 0; db < 4; ++db)
#pragma unroll
            for (int i = 0; i < 16; ++i) acc[db][i] = 0.f;
#pragma unroll
        for (int s = 0; s < 4; ++s) { const bf16x8 va = frag_tr<false>(F.lds + VOFF + (w >> 2) * 16384, w & 3, 16 * s, lane);
#pragma unroll
            for (int db = 0; db < 4; ++db) { const bf16x8 kb = frag_row(F.lds + KDT, 32 * db, s, lane); acc[db] = MFMA32(va, kb, acc[db]); } }
        bf16_t* up = UPDT + ((size_t)bh * 64 + n) * 256 * 128;
#pragma unroll
        for (int db = 0; db < 4; ++db)
#pragma unroll
            for (int i = 0; i < 16; ++i) up[(size_t)(32 * w + crow(i, hh)) * 128 + 32 * db + r32] = (bf16_t)(cvtpk(acc[db][i], 0.f) & 0xffffu);
    }
}
__device__ __forceinline__ void phase_gla_scan(Frame& F) {
    const bf16_t* UPDT = (const bf16_t*)(F.ws + WS_UPDT); const float* GDEC = (const float*)(F.ws + WS_GDEC); bf16_t* SPT = (bf16_t*)(F.ws + WS_SPREVT);
    for (int idx = F.bid * NTHR + F.tid; idx < 16 * 256 * 32; idx += F.G * NTHR) {
        const int bh = idx >> 13, e = (idx >> 5) & 255, d4 = idx & 31;
        f32x4 st = {0.f, 0.f, 0.f, 0.f};
        const size_t base = ((size_t)bh * 64) * 256 * 128 + (size_t)e * 128 + 4 * d4;
#pragma unroll 8
        for (int n = 0; n < 64; ++n) {
            const u32x2 up2 = *(const u32x2*)(UPDT + base + (size_t)n * 256 * 128); const f32x4 uu = {bflo(up2.x), bfhi(up2.x), bflo(up2.y), bfhi(up2.y)}; const f32x4 dc = *(const f32x4*)(GDEC + ((size_t)bh * 64 + n) * 128 + 4 * d4);
            u32x2 o; o.x = cvtpk(st.x, st.y); o.y = cvtpk(st.z, st.w); *(u32x2*)(SPT + base + (size_t)n * 256 * 128) = o;
            st = dc * st + uu; }
    }
}
__device__ __forceinline__ void phase_gla_out(Frame& F, const Args& a, int l) {
    const bf16_t* PROJ = (const bf16_t*)(F.ws + WS_PROJ); const float* SMALL = (const float*)(F.ws + WS_SMALL); const bf16_t* SPT = (const bf16_t*)(F.ws + WS_SPREVT);
    fp8_t* BRCAT = (fp8_t*)(F.ws + WS_BRCAT);
    const float* w2 = a.in[4] + (size_t)l * 16 * 512; const float* b2 = a.in[5] + (size_t)l * 512; const float* normg = a.in[6] + (size_t)l * 256;
    const int w = F.wave;
    constexpr int SSO = 6144, QE = 8192, KE = 24576, VOFF = 40960;
    LAS float* SS = (LAS float*)(F.lds + SSO);
    u32x4 pq[2], pk[2], pv[4];
    auto ldqkv = [&](int uu) { const int bh2 = uu >> 6, n2 = uu & 63, bi2 = bh2 >> 2, h2 = bh2 & 3; const size_t tt = (size_t)bi2 * SEQ + 64 * n2;
#pragma unroll
        for (int i = 0; i < 2; ++i) { const int cid = F.tid + 512 * i, row = cid >> 4, ch = cid & 15; pq[i] = *(const u32x4*)(PROJ + (tt + row) * NPROJ + PQ_GQ + h2 * 128 + 8 * ch); pk[i] = *(const u32x4*)(PROJ + (tt + row) * NPROJ + PQ_GK + h2 * 128 + 8 * ch); }
#pragma unroll
        for (int i = 0; i < 4; ++i) { const int cid = F.tid + 512 * i, row = cid >> 5, c32 = cid & 31; pv[i] = *(const u32x4*)(PROJ + (tt + row) * NPROJ + PQ_GV + h2 * 256 + 8 * c32); } };
    if (F.bid < 1024) ldqkv(F.bid);
    for (int u = F.bid; u < 1024; u += F.G) {
        const int bh = u >> 6, n = u & 63, b = bh >> 2, h = bh & 3; const size_t t0 = (size_t)b * SEQ + 64 * n;
        int tid_ = F.tid; asm volatile("" : "+v"(tid_));
        const int tid = tid_, lane = tid & 63, d = tid & 127, g4 = tid >> 7, r32 = lane & 31, hh = lane >> 5;
        bf16x8 spf[8]; u32x2 rvp[2][4];
        {   const bf16_t* sp = SPT + (((size_t)bh * 64 + n) * 256 + 32 * w + r32) * 128 + 8 * hh;
#pragma unroll
            for (int ks = 0; ks < 8; ++ks) spf[ks] = *(const bf16x8*)(sp + 16 * ks);
#pragma unroll
            for (int qb = 0; qb < 2; ++qb)
#pragma unroll
                for (int g = 0; g < 4; ++g) rvp[qb][g] = *(const u32x2*)(PROJ + (t0 + 32 * qb + r32) * NPROJ + PQ_GR + h * 256 + 32 * w + 8 * g + 4 * hh); }
        __syncthreads();
        float bc[16], btot;
#pragma unroll
        for (int i = 0; i < 2; ++i) { const int cid = F.tid + 512 * i, row = cid >> 4, ch = cid & 15; *(LAS u32x4*)(F.lds + QE + offb(row, ch)) = pq[i]; *(LAS u32x4*)(F.lds + KE + offb(row, ch)) = pk[i]; }
#pragma unroll
        for (int i = 0; i < 4; ++i) { const int cid = F.tid + 512 * i, row = cid >> 5, c32 = cid & 31; *(LAS u32x4*)(F.lds + VOFF + (c32 >> 4) * 16384 + offb(row, c32 & 15)) = pv[i]; }
        gla_gates(F, SMALL, w2, b2, h, t0, bc, btot);
#pragma unroll
        for (int i = 0; i < 16; ++i) { const int pos = 16 * g4 + i; const float eb = fast_exp(bc[i]), reb = __builtin_amdgcn_rcpf(eb);
            LAS unsigned short* qa = (LAS unsigned short*)(F.lds + QE + offb(pos, d >> 3) + 2 * (d & 7)); LAS unsigned short* ka = (LAS unsigned short*)(F.lds + KE + offb(pos, d >> 3) + 2 * (d & 7));
            const float qv = bf2f(*qa) * 0.08838834764831845f * eb, kv = bf2f(*ka) * reb;
            *qa = f2bf(qv); *ka = f2bf(kv); }
        __syncthreads();
        f32x16 att[2][2];
#pragma unroll
        for (int sb = 0; sb < 2; ++sb)
#pragma unroll
            for (int qb = 0; qb < 2; ++qb)
#pragma unroll
                for (int i = 0; i < 16; ++i) att[sb][qb][i] = 0.f;
#pragma unroll
        for (int ks = 0; ks < 8; ++ks) { const bf16x8 k0 = frag_row(F.lds + KE, 0, ks, lane), k1 = frag_row(F.lds + KE, 32, ks, lane), q0 = frag_row(F.lds + QE, 0, ks, lane), q1 = frag_row(F.lds + QE, 32, ks, lane);
            att[0][0] = MFMA32(k0, q0, att[0][0]); att[0][1] = MFMA32(k0, q1, att[0][1]); att[1][0] = MFMA32(k1, q0, att[1][0]); att[1][1] = MFMA32(k1, q1, att[1][1]); }
#pragma unroll
        for (int sb = 0; sb < 2; ++sb)
#pragma unroll
            for (int qb = 0; qb < 2; ++qb)
#pragma unroll
                for (int i = 0; i < 16; ++i) { const int sp = 32 * sb + crow(i, hh), qp = 32 * qb + r32; if (sp > qp) att[sb][qb][i] = 0.f; }
        f32x16 o[2];
#pragma unroll
        for (int qb = 0; qb < 2; ++qb)
#pragma unroll
            for (int i = 0; i < 16; ++i) o[qb][i] = 0.f;
#pragma unroll
        for (int ks = 0; ks < 4; ++ks) { const bf16x8 va = frag_tr<true>(F.lds + VOFF + (w >> 2) * 16384, w & 3, 16 * ks, lane);
#pragma unroll
            for (int qb = 0; qb < 2; ++qb) { const bf16x8 pf = pack_acc(att[ks >> 1][qb], ks & 1); o[qb] = MFMA32(va, pf, o[qb]); } }
#pragma unroll
        for (int ks = 0; ks < 8; ++ks) {
#pragma unroll
            for (int qb = 0; qb < 2; ++qb) { const bf16x8 qf = frag_row(F.lds + QE, 32 * qb, ks, lane); o[qb] = MFMA32(spf[ks], qf, o[qb]); } }
        f32x4 gnv[4];
#pragma unroll
        for (int g = 0; g < 4; ++g) gnv[g] = *(const f32x4*)(normg + 32 * w + 8 * g + 4 * hh);
        { const int un = u + F.G; ldqkv(un < 1024 ? un : u); }
#pragma unroll
        for (int qb = 0; qb < 2; ++qb) { float ss = 0.f;
#pragma unroll
            for (int i = 0; i < 16; ++i) ss += o[qb][i] * o[qb][i];
            ss = x32_sum(ss);
            if (hh == 0) SS[w * 64 + 32 * qb + r32] = ss; }
        __syncthreads();
#pragma unroll
        for (int qb = 0; qb < 2; ++qb) { float tot = 0.f;
#pragma unroll
            for (int q = 0; q < 8; ++q) tot += SS[q * 64 + 32 * qb + r32];
            const float rstd = __builtin_amdgcn_rsqf(tot * (1.0f / 256.0f) + EPS);
            const size_t t = t0 + 32 * qb + r32;
#pragma unroll
            for (int g = 0; g < 4; ++g) { const int e0 = 32 * w + 8 * g + 4 * hh; const f32x4 gn = gnv[g];
                const u32x2 rv = rvp[qb][g];
                const float y0 = o[qb][4 * g] * rstd * gn.x * siluf_(bflo(rv.x)), y1 = o[qb][4 * g + 1] * rstd * gn.y * siluf_(bfhi(rv.x));
                const float y2 = o[qb][4 * g + 2] * rstd * gn.z * siluf_(bflo(rv.y)), y3 = o[qb][4 * g + 3] * rstd * gn.w * siluf_(bfhi(rv.y));
                *(unsigned*)(BRCAT + t * 3072 + 1024 + h * 256 + e0) = pk4_fp8(y0, y1, y2, y3); } }
    }
}

constexpr int SD_DT = 0, SD_ACS = 2048, SD_WT = 4096, SD_SSX = 4352, SD_XT = 8192, SD_BT = 73728, SD_CT = 106496;
__device__ __forceinline__ void ssd_tables(Frame& F, const Args& a, int l, const float* SMALL, int g, size_t t0, int tid) {
    LAS float* DT = (LAS float*)(F.lds + SD_DT); LAS float* ACS = (LAS float*)(F.lds + SD_ACS); LAS float* WT = (LAS float*)(F.lds + SD_WT);
    const int lane = tid & 63, hq = tid >> 7, pos = tid & 127, hd = 4 * g + hq;
    const float raw = SMALL[(t0 + pos) * 32 + 16 + hd] + a.in[9][l * 16 + hd];
    const float dt = raw > 20.f ? raw : logf(1.0f + expf(raw));
    const float A = -expf(a.in[10][l * 16 + hd]);
    float incl = wave_scan_f(dt * A, lane);
    if (lane == 63) WT[F.wave] = incl;
    __syncthreads();
    if (F.wave & 1) incl += WT[F.wave - 1];
    DT[hq * 128 + pos] = dt; ACS[hq * 128 + pos] = incl;
    __syncthreads();
}
struct SsdRows { u32x4 r[19]; };
template <int MODE> __device__ __forceinline__ void ssd_conv_load(SsdRows& R, const bf16_t* PROJ, int g, int n, size_t t0, int tid) {
    const int cg = tid & 63, seg = tid >> 6, pos0 = 16 * seg;
    const int cc0 = cg < 32 ? g * 256 + 8 * cg : (cg < 48 ? 1024 + g * 128 + 8 * (cg - 32) : 1536 + g * 128 + 8 * (cg - 48));
    const bf16_t* src = PROJ + (t0 + pos0) * NPROJ + PQ_SX + cc0;
    const bool havehalo = (n > 0) || (seg > 0);
#pragma unroll
    for (int p = 0; p < 19; ++p) { if ((p >= 3 || havehalo) && !(MODE == 0 && cg >= 48)) R.r[p] = *(const u32x4*)(src + (ptrdiff_t)(p - 3) * NPROJ); else R.r[p] = (u32x4){0u, 0u, 0u, 0u}; }
}
template <int MODE> __device__ __forceinline__ void ssd_conv(Frame& F, const Args& a, int l, const SsdRows& R, int g, int tid) {
    const LAS float* DT = (const LAS float*)(F.lds + SD_DT); const LAS float* ACS = (const LAS float*)(F.lds + SD_ACS);
    const int cg = tid & 63, seg = tid >> 6, pos0 = 16 * seg;
    if (MODE == 0 && cg >= 48) return;
    int cc0, row0; LAS unsigned char* img;
    if (cg < 32) { cc0 = g * 256 + 8 * cg; img = F.lds + SD_XT; row0 = 8 * cg; }
    else if (cg < 48) { cc0 = 1024 + g * 128 + 8 * (cg - 32); img = F.lds + SD_BT; row0 = 8 * (cg - 32); }
    else { cc0 = 1536 + g * 128 + 8 * (cg - 48); img = F.lds + SD_CT; row0 = 8 * (cg - 48); }
    const float* cw = a.in[7] + (size_t)l * 4 * 2048 + cc0; const float* cbp = a.in[8] + (size_t)l * 2048 + cc0;
    float wt[4][8], cb[8];
#pragma unroll
    for (int j = 0; j < 4; ++j) { const f32x4 w0 = *(const f32x4*)(cw + 2048 * j), w1 = *(const f32x4*)(cw + 2048 * j + 4); wt[j][0] = w0.x; wt[j][1] = w0.y; wt[j][2] = w0.z; wt[j][3] = w0.w; wt[j][4] = w1.x; wt[j][5] = w1.y; wt[j][6] = w1.z; wt[j][7] = w1.w; }
    {   const f32x4 b0 = *(const f32x4*)cbp, b1 = *(const f32x4*)(cbp + 4); cb[0] = b0.x; cb[1] = b0.y; cb[2] = b0.z; cb[3] = b0.w; cb[4] = b1.x; cb[5] = b1.y; cb[6] = b1.z; cb[7] = b1.w; }
    const int hq = cg >> 3;
    const float alast = (MODE == 0 && cg < 32) ? ACS[hq * 128 + 127] : 0.f;
    float sc[16];
#pragma unroll
    for (int p = 0; p < 16; ++p) { sc[p] = 1.0f; if (cg < 32) { sc[p] = DT[hq * 128 + pos0 + p]; if (MODE == 0) sc[p] *= fast_exp(alast - ACS[hq * 128 + pos0 + p]); } }
#pragma unroll
    for (int c = 0; c < 8; ++c) {
        float y[16];
#pragma unroll
        for (int p = 0; p < 16; ++p) { float v = cb[c];
#pragma unroll
            for (int j = 0; j < 4; ++j) { const unsigned wv = R.r[p + j][c >> 1]; v += wt[j][c] * ((c & 1) ? bfhi(wv) : bflo(wv)); }
            y[p] = siluf_(v) * sc[p]; }
        u32x4 o0, o1; o0.x = cvtpk(y[0], y[1]); o0.y = cvtpk(y[2], y[3]); o0.z = cvtpk(y[4], y[5]); o0.w = cvtpk(y[6], y[7]);
        o1.x = cvtpk(y[8], y[9]); o1.y = cvtpk(y[10], y[11]); o1.z = cvtpk(y[12], y[13]); o1.w = cvtpk(y[14], y[15]);
        *(LAS u32x4*)(img + offb(row0 + c, 2 * seg)) = o0; *(LAS u32x4*)(img + offb(row0 + c, 2 * seg + 1)) = o1; }
}
__device__ __forceinline__ void phase_ssd_local(Frame& F, const Args& a, int l) {
    const bf16_t* PROJ = (const bf16_t*)(F.ws + WS_PROJ); const float* SMALL = (const float*)(F.ws + WS_SMALL);
    bf16_t* STATES = (bf16_t*)(F.ws + WS_STATES); float* ALAST = (float*)(F.ws + WS_ALAST);
    const int w = F.wave;
    SsdRows R;
    if (F.bid < 512) { const int u0 = F.bid; ssd_conv_load<0>(R, PROJ, u0 & 3, (u0 >> 2) & 31, (size_t)(u0 >> 7) * SEQ + 128 * ((u0 >> 2) & 31), F.tid); }
    for (int u = F.bid; u < 512; u += F.G) {
        const int b = u >> 7, n = (u >> 2) & 31, g = u & 3; const size_t t0 = (size_t)b * SEQ + 128 * n;
        int tid_ = F.tid; asm volatile("" : "+v"(tid_));
        __syncthreads();
        ssd_tables(F, a, l, SMALL, g, t0, tid_);
        ssd_conv<0>(F, a, l, R, g, tid_);
        { const int un = (u + F.G < 512) ? u + F.G : u; ssd_conv_load<0>(R, PROJ, un & 3, (un >> 2) & 31, (size_t)(un >> 7) * SEQ + 128 * ((un >> 2) & 31), tid_); }
        if (F.tid < 4) ALAST[((size_t)b * 32 + n) * 16 + 4 * g + F.tid] = ((const LAS float*)(F.lds + SD_ACS))[F.tid * 128 + 127];
        __syncthreads();
        int ln = F.lane; asm volatile("" : "+v"(ln));
        const int lane = ln, r32 = lane & 31, hh = lane >> 5;
        const int hd = w >> 1, pb = w & 1;
        f32x16 acc[4];
#pragma unroll
        for (int sb = 0; sb < 4; ++sb)
#pragma unroll
            for (int i = 0; i < 16; ++i) acc[sb][i] = 0.f;
#pragma unroll
        for (int ks = 0; ks < 8; ++ks) { const bf16x8 xa = frag_row(F.lds + SD_XT, 64 * hd + 32 * pb, ks, lane);
#pragma unroll
            for (int sb = 0; sb < 4; ++sb) { const bf16x8 bb = frag_row(F.lds + SD_BT, 32 * sb, ks, lane); acc[sb] = MFMA32(xa, bb, acc[sb]); } }
        bf16_t* sp = STATES + ((((size_t)b * 32 + n) * 16 + 4 * g + hd) * 64) * 128;
#pragma unroll
        for (int sb = 0; sb < 4; ++sb)
#pragma unroll
            for (int i = 0; i < 16; ++i) sp[(size_t)(32 * pb + crow(i, hh)) * 128 + 32 * sb + r32] = (bf16_t)(cvtpk(acc[sb][i], 0.f) & 0xffffu);
    }
}
__device__ __forceinline__ void phase_ssd_scan(Frame& F) {
    const bf16_t* STATES = (const bf16_t*)(F.ws + WS_STATES); const float* ALAST = (const float*)(F.ws + WS_ALAST); bf16_t* SPV = (bf16_t*)(F.ws + WS_SPREV);
    for (int idx = F.bid * NTHR + F.tid; idx < 4 * 16 * 64 * 32; idx += F.G * NTHR) {
        const int b = idx >> 15, hd = (idx >> 11) & 15, ps = idx & 2047;
        f32x4 st = {0.f, 0.f, 0.f, 0.f};
#pragma unroll 8
        for (int n = 0; n < 32; ++n) { const size_t off = ((((size_t)b * 32 + n) * 16 + hd) * 64) * 128 + 4 * ps;
            const u32x2 up2 = *(const u32x2*)(STATES + off); const f32x4 uu = {bflo(up2.x), bfhi(up2.x), bflo(up2.y), bfhi(up2.y)}; const float dc = fast_exp(ALAST[((size_t)b * 32 + n) * 16 + hd]);
            u32x2 o; o.x = cvtpk(st.x, st.y); o.y = cvtpk(st.z, st.w); *(u32x2*)(SPV + off) = o;
            st = st * dc + uu; }
    }
}
__device__ __forceinline__ void phase_ssd_out(Frame& F, const Args& a, int l) {
    const bf16_t* PROJ = (const bf16_t*)(F.ws + WS_PROJ); const float* SMALL = (const float*)(F.ws + WS_SMALL); const bf16_t* SPV = (const bf16_t*)(F.ws + WS_SPREV);
    fp8_t* BRCAT = (fp8_t*)(F.ws + WS_BRCAT);
    const float* normg = a.in[12] + (size_t)l * 1024;
    const int w = F.wave, lb = w & 3, hp = w >> 2;
    const LAS float* DT = (const LAS float*)(F.lds + SD_DT); const LAS float* ACS = (const LAS float*)(F.lds + SD_ACS); LAS float* SSX = (LAS float*)(F.lds + SD_SSX);
    for (int u = F.bid; u < 512; u += F.G) {
        const int b = u >> 7, n = (u >> 2) & 31, g = u & 3; const size_t t0 = (size_t)b * SEQ + 128 * n;
        int tid_ = F.tid; asm volatile("" : "+v"(tid_));
        SsdRows R; ssd_conv_load<1>(R, PROJ, g, n, t0, tid_);
        __syncthreads();
        ssd_tables(F, a, l, SMALL, g, t0, tid_);
        ssd_conv<1>(F, a, l, R, g, tid_);
        __syncthreads();
        int ln = F.lane; asm volatile("" : "+v"(ln));
        const int lane = ln, r32 = lane & 31, hh = lane >> 5, lpos = 32 * lb + r32;
        f32x16 y[2][2];
#pragma unroll
        for (int hi = 0; hi < 2; ++hi)
#pragma unroll
            for (int pb = 0; pb < 2; ++pb)
#pragma unroll
                for (int i = 0; i < 16; ++i) y[hi][pb][i] = 0.f;
        {   const bf16_t* sp0 = SPV + (((((size_t)b * 32 + n) * 16 + 4 * g + 2 * hp) * 64) + r32) * 128 + 8 * hh;
#pragma unroll
            for (int ks = 0; ks < 8; ++ks) { const bf16x8 cf = frag_tr<false>(F.lds + SD_CT, lb, 16 * ks, lane);
#pragma unroll
                for (int hi = 0; hi < 2; ++hi)
#pragma unroll
                    for (int pb = 0; pb < 2; ++pb) { const bf16x8 sa = *(const bf16x8*)(sp0 + (size_t)(hi * 64 + 32 * pb) * 128 + 16 * ks); y[hi][pb] = MFMA32(sa, cf, y[hi][pb]); } }
        }
        float acl[2];
#pragma unroll
        for (int hi = 0; hi < 2; ++hi) { acl[hi] = ACS[(2 * hp + hi) * 128 + lpos]; const float ea = fast_exp(acl[hi]);
#pragma unroll
            for (int pb = 0; pb < 2; ++pb)
#pragma unroll
                for (int i = 0; i < 16; ++i) y[hi][pb][i] *= ea; }
#pragma unroll 1
        for (int mb = 0; mb <= lb; ++mb) {
            f32x16 cbt;
#pragma unroll
            for (int i = 0; i < 16; ++i) cbt[i] = 0.f;
#pragma unroll
            for (int ks = 0; ks < 8; ++ks) { const bf16x8 bf = frag_tr<false>(F.lds + SD_BT, mb, 16 * ks, lane), cf = frag_tr<false>(F.lds + SD_CT, lb, 16 * ks, lane); cbt = MFMA32(bf, cf, cbt); }
#pragma unroll
            for (int hi = 0; hi < 2; ++hi) { const int hq = 2 * hp + hi;
                f32x16 mt;
#pragma unroll
                for (int i = 0; i < 16; ++i) { const int m = 32 * mb + crow(i, hh); const float am = ACS[hq * 128 + m]; mt[i] = (m <= lpos) ? cbt[i] * fast_exp(acl[hi] - am) : 0.f; }
#pragma unroll
                for (int half = 0; half < 2; ++half) { const bf16x8 mf = pack_acc(mt, half);
                    const int ksx = 2 * mb + half;
#pragma unroll
                    for (int pb = 0; pb < 2; ++pb) { const int row = 64 * hq + 32 * pb + r32;
                        const s16x4 lo = *(const LAS s16x4*)(F.lds + SD_XT + offb(row, 2 * ksx) + 8 * hh), hi4 = *(const LAS s16x4*)(F.lds + SD_XT + offb(row, 2 * ksx + 1) + 8 * hh);
                        const bf16x8 xa = __builtin_shufflevector(lo, hi4, 0, 1, 2, 3, 4, 5, 6, 7);
                        y[hi][pb] = MFMA32(xa, mf, y[hi][pb]); } } }
        }
        float ssq = 0.f;
#pragma unroll
        for (int hi = 0; hi < 2; ++hi) { const int hq = 2 * hp + hi, hd = 4 * g + hq;
            const float dsk = a.in[11][l * 16 + hd] * __builtin_amdgcn_rcpf(DT[hq * 128 + lpos]);
#pragma unroll
            for (int pb = 0; pb < 2; ++pb)
#pragma unroll
                for (int gq = 0; gq < 4; ++gq) { const int p0 = 32 * pb + 8 * gq + 4 * hh;
                    const u32x2 zv = *(const u32x2*)(PROJ + (t0 + lpos) * NPROJ + PQ_SZ + hd * 64 + p0);
                    const float zz[4] = {bflo(zv.x), bfhi(zv.x), bflo(zv.y), bfhi(zv.y)};
#pragma unroll
                    for (int jj = 0; jj < 4; ++jj) { const int row = 64 * hq + p0 + jj;
                        const float xd = bf2f(*(const LAS unsigned short*)(F.lds + SD_XT + offb(row, lpos >> 3) + 2 * (lpos & 7)));
                        float v = y[hi][pb][4 * gq + jj] + xd * dsk; v *= siluf_(zz[jj]); y[hi][pb][4 * gq + jj] = v; ssq += v * v; } }
        }
        ssq = x32_sum(ssq);
        if (hh == 0) SSX[(hp * 4 + lb) * 32 + r32] = ssq;
        __syncthreads();
        const float rstd = __builtin_amdgcn_rsqf((SSX[lb * 32 + r32] + SSX[(4 + lb) * 32 + r32]) * (1.0f / 256.0f) + EPS);
#pragma unroll
        for (int hi = 0; hi < 2; ++hi) { const int hq = 2 * hp + hi;
#pragma unroll
            for (int pb = 0; pb < 2; ++pb)
#pragma unroll
                for (int gq = 0; gq < 4; ++gq) { const int p0 = 32 * pb + 8 * gq + 4 * hh, ch = g * 256 + hq * 64 + p0; const f32x4 gn = *(const f32x4*)(normg + ch);
                    *(unsigned*)(BRCAT + (t0 + lpos) * 3072 + 2048 + ch) = pk4_fp8(y[hi][pb][4 * gq] * rstd * gn.x, y[hi][pb][4 * gq + 1] * rstd * gn.y, y[hi][pb][4 * gq + 2] * rstd * gn.z, y[hi][pb][4 * gq + 3] * rstd * gn.w); } }
    }
}

__device__ __forceinline__ void phase_small(Frame& F, const bf16_t* xsb) {
    const bf16_t* SM = (const bf16_t*)(F.ws + WS_SM); float* SMALL = (float*)(F.ws + WS_SMALL);
    const int li = F.lane & 15, lq = F.lane >> 4, w = F.wave, kh = w >> 2;
    LAS float* red = (LAS float*)F.lds;
    for (int tb = F.bid; tb < T / 64; tb += F.G) {
        const int task = 4 * tb + (w & 3);
        const bf16_t* w0 = SM + (size_t)li * D + 1024 * kh + 8 * lq; const bf16_t* w1 = SM + (size_t)(16 + li) * D + 1024 * kh + 8 * lq; const bf16_t* xp = xsb + (size_t)(task * 16 + li) * D + 1024 * kh + 8 * lq;
        f32x4 c0 = {0.f, 0.f, 0.f, 0.f}, c1 = {0.f, 0.f, 0.f, 0.f};
#pragma unroll 8
        for (int ks = 0; ks < 32; ++ks) { const bf16x8 av = *(const bf16x8*)(xp + 32 * ks), b0 = *(const bf16x8*)(w0 + 32 * ks), b1 = *(const bf16x8*)(w1 + 32 * ks);
            c0 = __builtin_amdgcn_mfma_f32_16x16x32_bf16(av, b0, c0, 0, 0, 0); c1 = __builtin_amdgcn_mfma_f32_16x16x32_bf16(av, b1, c1, 0, 0, 0); }
        __syncthreads();
        if (kh == 1) { *(LAS f32x4*)(red + ((w & 3) * 64 + F.lane) * 8) = c0; *(LAS f32x4*)(red + ((w & 3) * 64 + F.lane) * 8 + 4) = c1; }
        __syncthreads();
        if (kh == 0) { c0 += *(const LAS f32x4*)(red + (w * 64 + F.lane) * 8); c1 += *(const LAS f32x4*)(red + (w * 64 + F.lane) * 8 + 4);
#pragma unroll
            for (int r = 0; r < 4; ++r) { SMALL[(size_t)(task * 16 + 4 * lq + r) * 32 + li] = c0[r]; SMALL[(size_t)(task * 16 + 4 * lq + r) * 32 + 16 + li] = c1[r]; } }
    }
    __syncthreads();
}

constexpr int PPL = 13, NPH = PPL * DEPTH;
constexpr int NCVT = 96;
#ifndef CV_DEFER
#define CV_DEFER 49920
#endif
#ifndef MK_ONE_LAUNCH
#define MK_ONE_LAUNCH 1
#endif
#ifndef PH_MASK
#define PH_MASK 0x1fff
#endif
#ifndef REP_MASK
#define REP_MASK 0
#endif
#ifndef REP_SUB
#define REP_SUB 0
#endif
#ifndef SUB_MASK
#define SUB_MASK 0xff
#endif
__global__ void __launch_bounds__(NTHR, 2) fwd(Args a) {
    extern __shared__ __attribute__((aligned(16))) unsigned char lds_raw[];
    Frame F;
    const int wave0 = __builtin_amdgcn_readfirstlane((int)threadIdx.x >> 6);
    F.lds = (LAS unsigned char*)lds_raw; F.ws = a.ws; F.G = gridDim.x; F.bid = blockIdx.x; F.wave = wave0; F.lane = lane_id(); F.tid = wave0 * 64 + F.lane;
    volatile LAS unsigned* MISCW = (volatile LAS unsigned*)(F.lds + MISC_OFF);
    for (int u = F.tid; u < (LDS_BYTES - LDSCTL_OFF) / 4; u += NTHR) ((LAS unsigned*)(F.lds + LDSCTL_OFF))[u] = 0u;
    __syncthreads();
    unsigned* barw = (unsigned*)(a.ws + WS_CTL) + CW_BAR;
    XcdBarrier bar; bar.bar = barw; bar.x = 0; bar.st = MISCW + 8;
    const int lo = a.ph_lo, hi = a.ph_hi;
    if (hi - lo > 1) bar = xcd_barrier_post(barw, MISCW + 8, F.tid == 0);
#define SUB(k) ((SUB_MASK >> (k)) & 1)
#define IN(k) (((PH_MASK >> (k)) & 1) && lo <= p0 + (k) && p0 + (k) < hi)
#define PH_BEGIN() int ln_ = lane_id(), b_ = blockIdx.x; asm volatile("" : "+v"(ln_), "+s"(b_)); F.lane = ln_; F.wave = wave0; F.tid = wave0 * 64 + ln_; F.bid = b_; \
    const Args al = load_args(a); F.ws = al.ws
#define SEAM(k) do { if (IN(k) && p0 + (k) + 1 < hi) xcd_barrier(bar, wave0 == 0 && lane_id() == 0); } while (0)
#define WSP(T_, off) ((T_*)(F.ws + (off)))
    for (int l = 0; l < DEPTH; ++l) {
        const int p0 = l * PPL;
        if (IN(0)) { PH_BEGIN(); phase_convert(F, al, l, 0, CV_NITEMS - CV_DEFER, F.bid * NWAVES + F.wave, F.G * NWAVES, l == 0); }
        SEAM(0);
        if (IN(1)) {
            PH_BEGIN();
            if (SUB(5)) phase_small(F, WSP(const bf16_t, WS_XRES));
            {   pg8::Gemm g{WSP(const fp8_t, WS_XB), WSP(const fp8_t, WS_WIN), D, nullptr}; pg8::StaticOrder S; S.init(T, NPROJ, F.G, F.bid);
                pg8::EpiBf16 E{WSP(bf16_t, WS_PROJ), NPROJ, 0};
                pg8::gemm_phase<pg8::EpiBf16, pg8::StaticOrder, false>(F.lds, g, S, E, F.tid); }
            {   pg8::Gemm g{WSP(const fp8_t, WS_XB), WSP(const fp8_t, WS_WIN) + (size_t)NPROJ * D, D, nullptr}; pg8::StaticOrder S; S.init(T, NGATE, F.G, F.bid);
                pg8::EpiGate E{WSP(unsigned char, WS_G8)};
                pg8::gemm_phase<pg8::EpiGate, pg8::StaticOrder, false>(F.lds, g, S, E, F.tid); }
        }
        SEAM(1);
        if (IN(2)) { PH_BEGIN();
            if (SUB(0) && (al.sub & 1)) {
                if (CV_DEFER > 0 && F.bid >= F.G - NCVT) phase_convert_experts(F, al, l, 65 * 768 - CV_DEFER, 65 * 768, (F.bid - (F.G - NCVT)) * NWAVES + F.wave, NCVT * NWAVES);
                phase_attn(F, al, l);
                { int ln2 = lane_id(); asm volatile("" : "+v"(ln2)); F.lane = ln2; F.tid = wave0 * 64 + ln2; } }
            if (SUB(1) && (al.sub & 2)) phase_gla_local(F, al, l); if (SUB(2) && (al.sub & 4)) phase_ssd_local(F, al, l); }
        SEAM(2);
        if (IN(3)) { PH_BEGIN(); phase_gla_scan(F); phase_ssd_scan(F); }
        SEAM(3);
        if (IN(4)) { PH_BEGIN(); if (SUB(3) && (al.sub & 8)) phase_gla_out(F, al, l); if (SUB(4) && (al.sub & 16)) phase_ssd_out(F, al, l); }
        SEAM(4);
        if (IN(5)) {
            PH_BEGIN();
            pg8::Gemm g{WSP(const fp8_t, WS_BRCAT), WSP(const fp8_t, WS_WBR), 3072, nullptr}; pg8::StaticOrder S; S.init(T, D, F.G, F.bid);
            pg8::EpiMerge E{WSP(const unsigned char, WS_G8), WSP(fp8_t, WS_MERGED)};
            pg8::gemm_phase<pg8::EpiMerge, pg8::StaticOrder, false>(F.lds, g, S, E, F.tid);
        }
        SEAM(5);
        if (IN(6)) {
            PH_BEGIN();
            pg8::Gemm g{WSP(const fp8_t, WS_MERGED), WSP(const fp8_t, WS_WOUT), D, nullptr}; pg8::StaticOrder S; S.init(T, D, F.G, F.bid);
            pg8::EpiWout E{WSP(const bf16_t, WS_XRES), WSP(bf16_t, WS_H)};
            pg8::gemm_phase<pg8::EpiWout, pg8::StaticOrder, false>(F.lds, g, S, E, F.tid);
        }
        SEAM(6);
        if (!FUSE_LN1) { if (IN(7)) { PH_BEGIN(); phase_ln1(F, al, l); }
            SEAM(7); }
        if (IN(8)) { PH_BEGIN(); phase_router(F, al, l); }
        SEAM(8);
        if (IN(9)) { PH_BEGIN(); phase_lists(F); }
        SEAM(9);
        if (IN(10)) {
            PH_BEGIN();
            const int nblk = __builtin_amdgcn_readfirstlane(WSP(const int, WS_MISC + MS_NBLK)[0]);
            moe_fill<true>(F, nblk, 4);
            pg8::Gemm g{WSP(const fp8_t, WS_X1B), WSP(const fp8_t, WS_EXP1), D, (const LAS int*)(F.lds + MOE_TOKL)}; MoeOrder2 S{(const LAS int*)(F.lds + MOE_BLKL), nblk, 4, F.G, F.bid};
            pg8::EpiSwiglu E{WSP(fp8_t, WS_HS), EDIM};
            pg8::gemm_phase<pg8::EpiSwiglu, MoeOrder2, true>(F.lds, g, S, E, F.tid);
        }
        SEAM(10);
        if (IN(11)) {
            PH_BEGIN();
            const int nblk = __builtin_amdgcn_readfirstlane(WSP(const int, WS_MISC + MS_NBLK)[0]);
            moe_fill<false>(F, nblk, 8);
            pg8::Gemm g{WSP(const fp8_t, WS_HS), WSP(const fp8_t, WS_EXP2), EDIM, nullptr}; MoeOrder2 S{(const LAS int*)(F.lds + MOE_BLKL), nblk, 8, F.G, F.bid};
            pg8::EpiFp8 E{WSP(fp8_t, WS_OS), D, 8};
            pg8::gemm_phase<pg8::EpiFp8, MoeOrder2, false>(F.lds, g, S, E, F.tid);
        }
        SEAM(11);
        if (IN(12)) { PH_BEGIN(); phase_combine(F, al, l); }
        SEAM(12);
    }
#undef IN
#undef SEAM
}

extern "C" void kernel_launch(void* const* d_in, const int* in_sizes, int n_in, void* d_out, int out_size, void* d_ws, size_t ws_size, hipStream_t stream) {
    static int grid = 0;
    if (grid == 0) {
        if (n_in != 27 || out_size != T * D || ws_size < WS_END) { fprintf(stderr, "kernel_launch: unexpected sizes n_in %d out %d ws %zu (need %zu)\n", n_in, out_size, ws_size, (size_t)WS_END); grid = -1; return; }
        int dev = 0, cus = 0, per_cu = 0;
        if (hipGetDevice(&dev) != hipSuccess || hipDeviceGetAttribute(&cus, hipDeviceAttributeMultiprocessorCount, dev) != hipSuccess) { grid = -1; return; }
        if (hipFuncSetAttribute((const void*)fwd, hipFuncAttributeMaxDynamicSharedMemorySize, LDS_BYTES) != hipSuccess) { fprintf(stderr, "kernel_launch: hipFuncSetAttribute failed\n"); grid = -1; return; }
        if (hipOccupancyMaxActiveBlocksPerMultiprocessor(&per_cu, (const void*)fwd, NTHR, LDS_BYTES) != hipSuccess || per_cu < 1) fprintf(stderr, "kernel_launch: occupancy query says %d\n", per_cu);
        (void)hipGetLastError();
        grid = cus;
    }
    if (grid < 0) return;
    if (hipMemsetAsync((char*)d_ws + WS_CTL, 0, CTL_ZERO_BYTES, stream) != hipSuccess) return;
    Args a{};
    for (int i = 0; i < 27; ++i) a.in[i] = (const float*)d_in[i];
    a.out = (float*)d_out; a.ws = (unsigned char*)d_ws; a.sub = 0xff; a.pad = 0;
#if MK_ONE_LAUNCH
    a.ph_lo = 0; a.ph_hi = NPH;
    hipLaunchKernelGGL(fwd, dim3(grid), dim3(NTHR), LDS_BYTES, stream, a);
#else
    for (int k = 0; k < NPH; ++k) { a.ph_lo = k; a.ph_hi = k + 1;
#ifdef HOTPROBE
#ifndef HOTPHASE
#define HOTPHASE 1
#endif
        if ((k % PPL) == HOTPHASE) { a.pad = HOTPROBE; hipLaunchKernelGGL(fwd, dim3(grid), dim3(NTHR), LDS_BYTES, stream, a); a.pad = 0; }
#endif
        const int reps = ((REP_MASK >> (k % PPL)) & 1) ? 2 : 1;
        for (int r = 0; r < reps; ++r) hipLaunchKernelGGL(fwd, dim3(grid), dim3(NTHR), LDS_BYTES, stream, a);
        if (REP_SUB && ((k % PPL) == 2 || (k % PPL) == 4)) { a.sub = REP_SUB; hipLaunchKernelGGL(fwd, dim3(grid), dim3(NTHR), LDS_BYTES, stream, a); a.sub = 0xff; } }
#endif
}
```

```cpp
#include <hip/hip_runtime.h>
#include <cstdio>
#include <cstdint>

#define LAS __attribute__((address_space(3)))
#define GAS __attribute__((address_space(1)))
typedef unsigned short bf16_t;
typedef short bf16x8 __attribute__((ext_vector_type(8)));
typedef short s16x4 __attribute__((ext_vector_type(4)));
typedef float f32x4 __attribute__((ext_vector_type(4)));
typedef float f32x2 __attribute__((ext_vector_type(2)));
typedef float f32x16 __attribute__((ext_vector_type(16)));
typedef unsigned u32x4 __attribute__((ext_vector_type(4)));
typedef unsigned u32x2 __attribute__((ext_vector_type(2)));
typedef GAS unsigned gu32;
typedef int i32x4 __attribute__((ext_vector_type(4)));
typedef int i32x8 __attribute__((ext_vector_type(8)));
typedef unsigned char fp8_t;
typedef float f32x2_ __attribute__((ext_vector_type(2)));
__device__ __forceinline__ void unpk4_fp8(unsigned w, float (&o)[4]) { const f32x2_ a = __builtin_amdgcn_cvt_pk_f32_fp8((int)w, false), b = __builtin_amdgcn_cvt_pk_f32_fp8((int)w, true); o[0] = a.x; o[1] = a.y; o[2] = b.x; o[3] = b.y; }
__device__ __forceinline__ float clamp448(float x) { return __builtin_amdgcn_fmed3f(x, -448.0f, 448.0f); }
__device__ __forceinline__ unsigned pk4_fp8(float a, float b, float c, float d) { int r = 0; r = __builtin_amdgcn_cvt_pk_fp8_f32(clamp448(a), clamp448(b), r, false); r = __builtin_amdgcn_cvt_pk_fp8_f32(clamp448(c), clamp448(d), r, true); return (unsigned)r; }
constexpr float OSCALE = 16.0f;
constexpr float WSCALE = 64.0f; constexpr int SC_W = 0x7c7c7c7c, SC_A = 0x7c7c7c7c;

__device__ __forceinline__ unsigned cvt_pk_bf16(float lo, float hi) { unsigned r; asm volatile("v_cvt_pk_bf16_f32 %0, %1, %2" : "=v"(r) : "v"(lo), "v"(hi)); return r; }
typedef __bf16 bf16x2_t __attribute__((ext_vector_type(2)));
__device__ __forceinline__ unsigned cvtpk(float lo, float hi) { f32x2 v = {lo, hi}; bf16x2_t b = __builtin_convertvector(v, bf16x2_t); return __builtin_bit_cast(unsigned, b); }
__device__ __forceinline__ float bf2f(unsigned short b) { return __uint_as_float(((unsigned)b) << 16); }
__device__ __forceinline__ float bflo(unsigned w) { return __uint_as_float(w << 16); }
__device__ __forceinline__ float bfhi(unsigned w) { return __uint_as_float(w & 0xffff0000u); }
__device__ __forceinline__ unsigned short f2bf(float f) { unsigned u = __float_as_uint(f); return (unsigned short)((u + 0x7fffu + ((u >> 16) & 1u)) >> 16); }
__device__ __forceinline__ float fast_exp(float x) { return __builtin_amdgcn_exp2f(x * 1.4426950408889634f); }
__device__ __forceinline__ float fast_log(float x) { return __builtin_amdgcn_logf(x) * 0.6931471805599453f; }
__device__ __forceinline__ float sigmoidf_(float x) { return __builtin_amdgcn_rcpf(1.0f + fast_exp(-x)); }
__device__ __forceinline__ float siluf_(float x) { return x * sigmoidf_(x); }

namespace pg8 {
constexpr int BM = 256, BK = 64, HALF = 128, HTB = HALF * BK * 2  , STAGE_BYTES = 8 * HTB, NXCD = 8, WGM = 4;

__host__ __device__ __forceinline__ int lds_byte(int r, int c) { const int st = (r >> 4) * 2 + (c >> 5), rr = r & 15, cc = c & 31, ob = rr * 64 + cc * 2; return st * 1024 + (ob ^ (((ob >> 9) & 1) << 5)); }
__host__ __device__ __forceinline__ void stage_rc(int b, int& R, int& C) { const int st = b / 1024, sb = b % 1024, swz = sb ^ (((sb >> 9) & 1) << 5); R = (st >> 1) * 16 + swz / 64; C = (st & 1) * 32 + (swz % 64) / 2; }
__host__ __device__ __forceinline__ int perm32(int rho) { const int n = rho >> 4, i = rho & 15; return 8 * (i >> 2) + 4 * n + (i & 3); }

struct Unit { int pm, pn; };
struct Gemm { const fp8_t* A; const fp8_t* Bt; int KB; const LAS int* gidx; };

struct StaticOrder {
    int nM, nN, nwg, G, c;
    __host__ __device__ void init(int M, int N, int G_, int c_) { nM = M / BM; nN = N / BM; nwg = nM * nN; G = G_; c = c_; }
    __host__ __device__ bool next(int i, Unit& u) const {
        const long L = (long)i * G + c; if (L >= nwg) return false;
        int wgid = (int)L; { const int q = nwg / NXCD, r = nwg % NXCD, xcd = wgid % NXCD, off = wgid / NXCD; wgid = (xcd < r ? xcd * (q + 1) : r * (q + 1) + (xcd - r) * q) + off; }
        const int nig = WGM * nN, gid = wgid / nig, fm = gid * WGM, gsz = (nM - fm) < WGM ? (nM - fm) : WGM;
        u.pm = fm + ((wgid % nig) % gsz); u.pn = (wgid % nig) / gsz; return true;
    }
};
struct MoeOrder {
    const int* blk_e; int nunits, NT, G, c;
    __device__ bool next(int i, Unit& u) const {
        const int L = i * G + c; if (L >= nunits) return false;
        const int j = L / NT, pl = L - j * NT; u.pm = j; u.pn = __builtin_amdgcn_readfirstlane(blk_e[j]) * NT + pl; return true;
    }
};

#ifndef PG8_ALIGN
#define PG8_ALIGN true
#endif
template <class E, class = void> struct epi_perm16 { static constexpr bool value = false; };
template <class E> struct epi_perm16<E, decltype((void)E::PERM16)> { static constexpr bool value = E::PERM16; };
template <class Epi, class Sched, bool GATHER, bool ALIGN_EPI = PG8_ALIGN>
__device__ __forceinline__ void gemm_phase(LAS unsigned char* lds, const Gemm g, const Sched& S, const Epi& E, int tid_in) {
    int tid_ = tid_in; asm volatile("" : "+v"(tid_));
    const int tid = tid_, wid = __builtin_amdgcn_readfirstlane(tid >> 6), lane = tid & 63, wr = wid >> 2, wc = wid & 3, fr = lane & 15, fq = lane >> 4;
    int KB_ = g.KB; asm volatile("" : "+s"(KB_));
    const int KB = KB_, nt = KB / 128;
    unsigned vA[2][2], vAn[2][2], voffB[2]; int Rl[2], Cl[2];
    const size_t hstep = (size_t)HALF * KB, q64 = (size_t)64 * KB;
    constexpr bool P16 = epi_perm16<Epi>::value;
    const size_t bhstep = P16 ? (size_t)8 * KB : hstep, qB = P16 ? (size_t)128 * KB : (size_t)64 * KB;
    const size_t tstep = 2 * hstep;
#pragma unroll
    for (int i = 0; i < 2; ++i) { int R, C; stage_rc(tid * 16 + i * 8192, R, C); const int Rb = P16 ? (64 * (R >> 5) + 16 * ((R & 15) >> 2) + 4 * ((R >> 4) & 1) + (R & 3)) : (Epi::PERM ? ((R & ~31) + perm32(R & 31)) : R); Rl[i] = R; Cl[i] = C;
        voffB[i] = (unsigned)(Rb * KB + 2 * C);
        vA[0][i] = (unsigned)(R * KB + 2 * C); vA[1][i] = (unsigned)((R + HALF) * KB + 2 * C); vAn[0][i] = vA[0][i]; vAn[1][i] = vA[1][i]; }
    const size_t kstep = (size_t)(BK * 2);
    const unsigned ldsw = (unsigned)wid * 1024u;
    const int aoff = lds_byte(wr * 64 + fr, fq * 8), boff = lds_byte(wc * 32 + fr, fq * 8);
#define PG8_SA(b, h) (((b) * 2 + (h)) * HTB)
#define PG8_SB(b, h) ((4 + (b) * 2 + (h)) * HTB)
#define PG8_STAGE(bufoff, gbase, voff) do { _Pragma("unroll") for (int _i = 0; _i < 2; ++_i) \
        __builtin_amdgcn_global_load_lds((const unsigned*)((const char*)(gbase) + (size_t)_i * q64 + (voff)[0]), (LAS unsigned*)(lds + (bufoff) + ldsw + _i * 8192), 16, 0, 0); } while (0)
#define PG8_STAGE_B(bufoff, gbase, voff) do { _Pragma("unroll") for (int _i = 0; _i < 2; ++_i) \
        __builtin_amdgcn_global_load_lds((const unsigned*)((const char*)(gbase) + (size_t)_i * qB + (voff)[0]), (LAS unsigned*)(lds + (bufoff) + ldsw + _i * 8192), 16, 0, 0); } while (0)
#define PG8_STAGE_G(bufoff, gbase, voff) do { _Pragma("unroll") for (int _i = 0; _i < 2; ++_i) \
        __builtin_amdgcn_global_load_lds((const unsigned*)((const char*)(gbase) + (voff)[_i]), (LAS unsigned*)(lds + (bufoff) + ldsw + _i * 8192), 16, 0, 0); } while (0)
#define PG8_STAGE_A(bufoff, gbase, vv, h) do { if constexpr (GATHER) PG8_STAGE_G(bufoff, gbase, (vv)[h]); else PG8_STAGE(bufoff, (gbase) + (size_t)(h) * hstep, (vv)[0]); } while (0)
#define PG8_CAT(x0, x1) __builtin_shufflevector((x0), (x1), 0, 1, 2, 3, 4, 5, 6, 7)
#define PG8_LDA(dst, b, h) do { _Pragma("unroll") for (int m = 0; m < 4; ++m) dst[m] = PG8_CAT(*(const LAS i32x4*)(lds + PG8_SA(b, h) + aoff + m * 2048), *(const LAS i32x4*)(lds + PG8_SA(b, h) + aoff + m * 2048 + 1024)); } while (0)
#define PG8_LDB(dst, b, h) do { _Pragma("unroll") for (int n = 0; n < 2; ++n) dst[n] = PG8_CAT(*(const LAS i32x4*)(lds + PG8_SB(b, h) + boff + n * 2048), *(const LAS i32x4*)(lds + PG8_SB(b, h) + boff + n * 2048 + 1024)); } while (0)
#define PG8_MMA(ai, bj, At, Bt) do { __builtin_amdgcn_s_setprio(1); _Pragma("unroll") for (int m = 0; m < 4; ++m) _Pragma("unroll") for (int n = 0; n < 2; ++n) \
        asm volatile("v_mfma_scale_f32_16x16x128_f8f6f4 %0, %1, %2, %0, %3, %3 op_sel_hi:[0,0,0]" : "+v"(acc[ai][bj][m][n]) : "v"(Bt[n]), "v"(At[m]), "v"(scv)); __builtin_amdgcn_s_setprio(0); } while (0)
#define PG8_WAIT_V(n) asm volatile("s_waitcnt vmcnt(" #n ")" ::: "memory")
#define PG8_WAIT_L(n) asm volatile("s_waitcnt lgkmcnt(" #n ")" ::: "memory")
#define PG8_BAR __builtin_amdgcn_s_barrier()
#define PG8_SCHED __builtin_amdgcn_sched_barrier(0)
#define PG8_GIDX(dst, ord) do { if constexpr (GATHER) { _Pragma("unroll") for (int _h = 0; _h < 2; ++_h) _Pragma("unroll") for (int _i = 0; _i < 2; ++_i) \
        dst[_h][_i] = (unsigned)g.gidx[(ord) * BM + _h * HALF + Rl[_i]] * (unsigned)KB + 2u * (unsigned)Cl[_i]; } } while (0)
    Unit cur, nxt; int ui = 0;
    if (!S.next(0, cur)) return;
    f32x4 acc[2][2][4][2];
#pragma unroll
    for (int a = 0; a < 2; ++a)
#pragma unroll
        for (int b = 0; b < 2; ++b)
#pragma unroll
            for (int m = 0; m < 4; ++m)
#pragma unroll
                for (int n = 0; n < 2; ++n) acc[a][b][m][n] = (f32x4){0.f, 0.f, 0.f, 0.f};
    i32x8 At[4], B0[2], B1[2];
    int scv = SC_W; asm volatile("" : "+v"(scv));
    PG8_GIDX(vA, 0);
    const char* cA = (const char*)g.A + (GATHER ? (size_t)0 : (size_t)cur.pm * tstep); const char* cB = (const char*)g.Bt + (size_t)cur.pn * tstep;
    PG8_STAGE_B(PG8_SB(0, 0), cB, voffB); PG8_STAGE_B(PG8_SB(0, 1), cB + bhstep, voffB); PG8_STAGE_A(PG8_SA(0, 0), cA, vA, 0); PG8_STAGE_A(PG8_SA(0, 1), cA, vA, 1);
    if (wr == 1) PG8_BAR;
    PG8_WAIT_V(2); PG8_BAR;
    PG8_STAGE_B(PG8_SB(1, 0), cB + kstep, voffB); PG8_STAGE_A(PG8_SA(1, 0), cA + kstep, vA, 0); PG8_STAGE_B(PG8_SB(1, 1), cB + bhstep + kstep, voffB);
    PG8_WAIT_V(6); PG8_BAR;
    for (;;) {
        const bool has_next = S.next(ui + 1, nxt);
        if (has_next) PG8_GIDX(vAn, ui + 1);
        const char* nA = has_next ? (const char*)g.A + (GATHER ? (size_t)0 : (size_t)nxt.pm * tstep) : cA; const char* nB = has_next ? (const char*)g.Bt + (size_t)nxt.pn * tstep : cB;
        constexpr int NSEG = Epi::HAS_MID ? 3 : 1; const int seglen = nt / NSEG;
        for (int seg = 0; seg < NSEG; ++seg) {
        if constexpr (Epi::HAS_MID) { if (seg > 0) { asm volatile("s_nop 15\n\ts_nop 15" ::: "memory"); E.mid(acc, cur, seg * Epi::MID0, wr, wc, fr, fq); asm volatile("s_nop 7" ::: "memory"); } }
        for (int t = seg * seglen; t < (seg + 1) * seglen; t += 2) {
            const bool last = (t == nt - 2);
            const char* a1 = cA + (size_t)(t + 1) * kstep;
            const char* a2 = last ? nA : cA + (size_t)(t + 2) * kstep; const char* b2 = last ? nB : cB + (size_t)(t + 2) * kstep;
            const char* a3 = a2 + kstep; const char* b3 = b2 + kstep;
            unsigned v2[2][2];
#pragma unroll
            for (int h = 0; h < 2; ++h)
#pragma unroll
                for (int i = 0; i < 2; ++i) v2[h][i] = (GATHER && last) ? vAn[h][i] : vA[h][i];
            PG8_LDB(B0, 0, 0); PG8_LDB(B1, 0, 1); PG8_SCHED; PG8_LDA(At, 0, 0); PG8_STAGE_A(PG8_SA(1, 1), a1, vA, 1);
            PG8_WAIT_V(8); PG8_WAIT_L(0); PG8_BAR; PG8_MMA(0, 0, At, B0); PG8_MMA(0, 1, At, B1); PG8_BAR; PG8_SCHED;
            PG8_LDA(At, 0, 1); PG8_STAGE_B(PG8_SB(0, 0), b2, voffB); PG8_STAGE_B(PG8_SB(0, 1), b2 + bhstep, voffB); PG8_STAGE_A(PG8_SA(0, 0), a2, v2, 0);
            PG8_WAIT_V(8); PG8_WAIT_L(0); PG8_BAR; PG8_MMA(1, 0, At, B0); PG8_MMA(1, 1, At, B1); PG8_BAR; PG8_SCHED;
            PG8_LDB(B0, 1, 0); PG8_LDB(B1, 1, 1); PG8_SCHED; PG8_LDA(At, 1, 0); PG8_STAGE_A(PG8_SA(0, 1), a2, v2, 1);
            PG8_WAIT_V(8); PG8_WAIT_L(0); PG8_BAR; PG8_MMA(0, 0, At, B0); PG8_MMA(0, 1, At, B1); PG8_BAR; PG8_SCHED;
            PG8_LDA(At, 1, 1); PG8_STAGE_B(PG8_SB(1, 0), b3, voffB); PG8_STAGE_B(PG8_SB(1, 1), b3 + bhstep, voffB); PG8_STAGE_A(PG8_SA(1, 0), a3, v2, 0);
            PG8_WAIT_V(8); PG8_WAIT_L(0); PG8_BAR; PG8_MMA(1, 0, At, B0); PG8_MMA(1, 1, At, B1); PG8_BAR; PG8_SCHED;
        }
        }
        if constexpr (ALIGN_EPI) { if (wr == 0) PG8_BAR; }
        asm volatile("s_nop 15\n\ts_nop 15" ::: "memory");
        {   int l2_ = lane; asm volatile("" : "+v"(l2_));
            E(acc, cur, wr, wc, l2_ & 15, l2_ >> 4); }
        if (!has_next) break;
#pragma unroll
        for (int a = 0; a < 2; ++a)
#pragma unroll
            for (int b = 0; b < 2; ++b)
#pragma unroll
                for (int m = 0; m < 4; ++m)
#pragma unroll
                    for (int n = 0; n < 2; ++n) acc[a][b][m][n] = (f32x4){0.f, 0.f, 0.f, 0.f};
        cur = nxt; cA = nA; cB = nB; ++ui;
#pragma unroll
        for (int h = 0; h < 2; ++h)
#pragma unroll
            for (int i = 0; i < 2; ++i) vA[h][i] = vAn[h][i];
        if constexpr (ALIGN_EPI) { if (wr == 1) PG8_BAR; }
    }
    PG8_WAIT_V(0);
    if constexpr (!ALIGN_EPI) { if (wr == 0) PG8_BAR; }
    PG8_BAR;
#undef PG8_SA
#undef PG8_SB
#undef PG8_STAGE
#undef PG8_STAGE_A
#undef PG8_STAGE_G
#undef PG8_LDA
#undef PG8_LDB
#undef PG8_MMA
#undef PG8_CAT
#undef PG8_WAIT_V
#undef PG8_WAIT_L
#undef PG8_BAR
#undef PG8_SCHED
#undef PG8_GIDX
}
}

constexpr int NWAVES = 8, NTHR = 512;
constexpr int BATCH = 4, SEQ = 4096, T = BATCH * SEQ, D = 2048, DEPTH = 2;
constexpr int IN_WIDTH = 15392, NPROJ = 9216, NGATE = 6144, NPROJ_ALL = NPROJ + NGATE;
constexpr int PQ_DAQ = 0, PQ_DAK = 1024, PQ_DAV = 2048, PQ_GQ = 3072, PQ_GK = 3584, PQ_GV = 4096, PQ_GR = 5120, PQ_SZ = 6144, PQ_SX = 7168, PQ_SB = 8192, PQ_SC = 8704, PQ_MG = 9216;
constexpr int NEXP = 64, TOPK = 8, EDIM = 512;
constexpr int MAXSLOT = T * TOPK + NEXP * 256;
constexpr int NSLOT_ALL = MAXSLOT + T;
constexpr int MAXBLK = NSLOT_ALL / 256;
constexpr float ALPHA = 1.4142135623730951f;
constexpr float EPS = 1e-5f;

constexpr size_t MiB = 1u << 20;
constexpr size_t WS_CTL = 0, CTL_ZERO_BYTES = 1 * MiB;
constexpr size_t WS_MISC = 1 * MiB;
constexpr size_t WS_WIN = 10 * MiB, WS_SM = 70 * MiB, WS_WBR = 71 * MiB, WS_WOUT = 83 * MiB, WS_RT = 91 * MiB, WS_EXP1 = 92 * MiB, WS_EXP2 = 352 * MiB;
constexpr size_t WS_XB = 482 * MiB, WS_XRES = 546 * MiB;
constexpr size_t WS_R1 = 674 * MiB, WS_PROJ = WS_R1, WS_G8 = WS_PROJ + (size_t)T * NPROJ * 2, WS_BRCAT = 1154 * MiB, WS_OS = WS_R1;
constexpr size_t WS_R2 = 1314 * MiB, WS_UPDT = WS_R2, WS_SPREVT = 1442 * MiB, WS_STATES = 1506 * MiB, WS_SPREV = 1570 * MiB, WS_HS = WS_R2;
constexpr size_t WS_MERGED = 1602 * MiB, WS_X1B = WS_MERGED, WS_H = 1666 * MiB, WS_SMALL = 1794 * MiB, WS_GDEC = 1796 * MiB, WS_ALAST = WS_GDEC + 512 * 1024, WS_END = 1797 * MiB;
static_assert(WS_WIN + (size_t)NPROJ_ALL * D * 2 <= WS_SM && WS_EXP1 + (size_t)65 * 1024 * 2048 * 2 <= WS_EXP2 && WS_EXP2 + (size_t)65 * 2048 * 512 * 2 <= WS_XB, "weights map");
static_assert(WS_G8 + (size_t)T * NGATE <= WS_BRCAT && WS_BRCAT + (size_t)T * 3072 * 2 <= WS_R2 && WS_OS + (size_t)NSLOT_ALL * D * 2 <= WS_R2, "R1 map");
static_assert(WS_HS + (size_t)NSLOT_ALL * EDIM * 2 <= WS_MERGED && WS_SPREV + (size_t)4 * 32 * 16 * 64 * 128 * 2 <= WS_MERGED, "R2 map");
constexpr size_t MS_SELMASK = 0, MS_SELW = 256 * 1024, MS_CNT = 1024 * 1024, MS_TOK2SLOT = 1280 * 1024, MS_SLOTTOK = 2 * MiB, MS_BLKE = 3 * MiB, MS_NBLK = 3 * MiB + 4096;
constexpr int CW_BAR = 4096, CW_ATTQ = 16384;

constexpr int RING_BYTES = 131072;
constexpr int LDSCTL_OFF = 155648, MISC_OFF = LDSCTL_OFF + 64;
constexpr int LDS_BYTES = 155648 + 256;

#define RLX_AGENT __ATOMIC_RELAXED, __HIP_MEMORY_SCOPE_AGENT
#define LDS_WAIT() asm volatile("s_waitcnt lgkmcnt(0)" ::: "memory")
#define VM_WAIT() asm volatile("s_waitcnt vmcnt(0)" ::: "memory")

#define XB_TMO      128
#define XB_XCNT(j)  (256  + 64 * (j))
#define XB_XSUB(j)  (1280 + 64 * (j))
#define XB_XGEN(j)  (2304 + 64 * (j))
#define XB_TOP      3328
#define XB_TOPGEN   3392
#define XCD_BAR_WORDS 3456
#define XB_SPIN_CAP (1u << 20)
__device__ __forceinline__ unsigned xb_ld(unsigned* p)              { return __hip_atomic_load(p, __ATOMIC_RELAXED, __HIP_MEMORY_SCOPE_AGENT); }
__device__ __forceinline__ unsigned xb_add(unsigned* p, unsigned v) { return __hip_atomic_fetch_add(p, v, __ATOMIC_RELAXED, __HIP_MEMORY_SCOPE_AGENT); }
__device__ __forceinline__ unsigned xb_xcc_id() { return (unsigned)__builtin_amdgcn_s_getreg((3 << 11) | 20) & 0xFu; }
#define XB_SPIN(cond, bar) do { unsigned _sp = 0; while (cond) { __builtin_amdgcn_s_sleep(1); \
    if ((++_sp & 255u) == 0u) { if (xb_ld(&(bar)[XB_TMO])) break; if (_sp > XB_SPIN_CAP) { atomicAdd(&(bar)[XB_TMO], 1u); break; } } } } while (0)
struct XcdBarrier { unsigned* bar; unsigned x; volatile LAS unsigned* st; };
__device__ __forceinline__ XcdBarrier xcd_barrier_post(unsigned* bar, volatile LAS unsigned* st, bool leader) {
    XcdBarrier b; b.bar = bar; b.x = xb_xcc_id(); b.st = st;
    if (leader) (void)xb_add(&bar[XB_XCNT(b.x)], 1u);
    return b;
}
__device__ __forceinline__ void xcd_barrier_complete(unsigned* bar, unsigned x, unsigned& nloc, unsigned& nx) {
    const unsigned G = gridDim.x * gridDim.y * gridDim.z;
    unsigned sum, cnt, mine, sp = 0u;
    for (;;) {
        sum = 0u; cnt = 0u; mine = 0u;
#pragma unroll
        for (unsigned j = 0; j < 16; ++j) { const unsigned c = xb_ld(&bar[XB_XCNT(j)]); sum += c; cnt += (c > 0u) ? 1u : 0u; mine = (j == x) ? c : mine; }
        if (sum == G) break;
        __builtin_amdgcn_s_sleep(1);
        if ((++sp & 255u) == 0u) { if (xb_ld(&bar[XB_TMO])) break; if (sp > XB_SPIN_CAP) { atomicAdd(&bar[XB_TMO], 1u); break; } }
    }
    nloc = mine > 0u ? mine : 1u; nx = cnt > 0u ? cnt : 1u;
}
__device__ __forceinline__ void xcd_barrier(const XcdBarrier& b, bool leader) {
    asm volatile("s_waitcnt vmcnt(0)" ::: "memory");
    __syncthreads();
    if (leader) {
        unsigned* bar = b.bar;
        __builtin_amdgcn_s_waitcnt(0);
        unsigned nloc = b.st[0], nx = b.st[1];
        if (nloc == 0u) { xcd_barrier_complete(bar, b.x, nloc, nx); b.st[0] = nloc; b.st[1] = nx; }
        const unsigned old = xb_add(&bar[XB_XSUB(b.x)], 1u);
        const unsigned gen = old / nloc;
        if (old + 1u == (gen + 1u) * nloc) {
            __builtin_amdgcn_fence(__ATOMIC_RELEASE, "agent");
            asm volatile("s_waitcnt vmcnt(0)" ::: "memory");
            const unsigned og = xb_add(&bar[XB_TOP], 1u);
            const unsigned tg = og / nx;
            if (og + 1u == (tg + 1u) * nx) xb_add(&bar[XB_TOPGEN], 1u);
            else XB_SPIN(xb_ld(&bar[XB_TOPGEN]) == tg, bar);
            __builtin_amdgcn_fence(__ATOMIC_ACQUIRE, "agent");
            xb_add(&bar[XB_XGEN(b.x)], 1u);
            asm volatile("s_waitcnt vmcnt(0)" ::: "memory");
        } else {
            XB_SPIN(xb_ld(&bar[XB_XGEN(b.x)]) == gen, bar);
            __builtin_amdgcn_fence(__ATOMIC_ACQUIRE, "agent");
            asm volatile("s_waitcnt vmcnt(0)" ::: "memory");
        }
    }
    __syncthreads();
}

struct Args { const float* in[27]; float* out; unsigned char* ws; int ph_lo, ph_hi; int sub, pad; };
__device__ __forceinline__ int lane_id() { int r; asm volatile("v_mbcnt_lo_u32_b32 %0, -1, 0\n\tv_mbcnt_hi_u32_b32 %0, -1, %0" : "=v"(r)); return r; }
__device__ __forceinline__ Args load_args(const Args& a) {
#if defined(__HIP_DEVICE_COMPILE__)
    typedef const __attribute__((address_space(4))) unsigned long long* kptr;
    kptr p = (kptr)__builtin_amdgcn_kernarg_segment_ptr(); asm volatile("" : "+s"(p));
    Args r;
#pragma unroll
    for (int i = 0; i < 27; ++i) r.in[i] = (const float*)(const GAS float*)p[i];
    r.out = (float*)(GAS float*)p[27]; r.ws = (unsigned char*)(GAS unsigned char*)p[28]; const unsigned long long q = p[29], q2 = p[30]; r.ph_lo = (int)(unsigned)q; r.ph_hi = (int)(unsigned)(q >> 32); r.sub = (int)(unsigned)q2; r.pad = (int)(unsigned)(q2 >> 32);
    return r;
#else
    return a;
#endif
}
struct Frame {
    LAS unsigned char* lds;
    unsigned char* ws;
    int tid, lane, wave, G, bid;
};

template <int K> __device__ __forceinline__ float swz_xor(float v) { return __builtin_bit_cast(float, __builtin_amdgcn_ds_swizzle(__builtin_bit_cast(int, v), 0x1f | (K << 10))); }
__device__ __forceinline__ float x32_sum(float v) { auto r = __builtin_amdgcn_permlane32_swap(__float_as_uint(v), __float_as_uint(v), false, false); return __uint_as_float(r[0]) + __uint_as_float(r[1]); }
__device__ __forceinline__ float x32_max(float v) { auto r = __builtin_amdgcn_permlane32_swap(__float_as_uint(v), __float_as_uint(v), false, false); return fmaxf(__uint_as_float(r[0]), __uint_as_float(r[1])); }
__device__ __forceinline__ float wave_sum(float v) { v += swz_xor<1>(v); v += swz_xor<2>(v); v += swz_xor<4>(v); v += swz_xor<8>(v); v += swz_xor<16>(v); return x32_sum(v); }
__device__ __forceinline__ float wave_max(float v) { v = fmaxf(v, swz_xor<1>(v)); v = fmaxf(v, swz_xor<2>(v)); v = fmaxf(v, swz_xor<4>(v)); v = fmaxf(v, swz_xor<8>(v)); v = fmaxf(v, swz_xor<16>(v)); return x32_max(v); }
__device__ __forceinline__ float wave_scan_f(float v, int ln) {
#pragma unroll
    for (int o = 1; o < 64; o <<= 1) { const float t = __builtin_bit_cast(float, __builtin_amdgcn_ds_bpermute((ln - o) << 2, __builtin_bit_cast(int, v))); if (ln >= o) v += t; }
    return v;
}
__device__ __forceinline__ int wave_scan_i(int v, int ln) {
#pragma unroll
    for (int o = 1; o < 64; o <<= 1) { const int t = __builtin_amdgcn_ds_bpermute((ln - o) << 2, v); if (ln >= o) v += t; }
    return v;
}

constexpr int CV_NITEMS = 32 * 80 + 32 * 64 + 32 * 96 + 32 + 3 * 16 * 32 + 32 * 32 + 32 * 2 + 65 * (2 * 32 * 8 + 8 * 32);
__device__ __forceinline__ void cv_item(const float* W, int ldn, int k0, int ns0, bf16_t* dst, int ld_dst, int drow0, int dk0, LAS float* scr, int lane) {
#pragma unroll 8
    for (int i = 0; i < 32; ++i) { const int kk = 2 * i + (lane >> 5); scr[kk * 33 + (lane & 31)] = W[(size_t)(k0 + kk) * ldn + ns0 + (lane & 31)]; }
    LDS_WAIT(); asm volatile("" ::: "memory");
    const int c = lane & 7;
#pragma unroll
    for (int j = 0; j < 4; ++j) { const int n = (lane >> 3) + 8 * j; const LAS float* s = scr + (8 * c) * 33 + n;
        u32x4 o; o.x = cvt_pk_bf16(s[0 * 33], s[1 * 33]); o.y = cvt_pk_bf16(s[2 * 33], s[3 * 33]); o.z = cvt_pk_bf16(s[4 * 33], s[5 * 33]); o.w = cvt_pk_bf16(s[6 * 33], s[7 * 33]);
        *(GAS u32x4*)(dst + (size_t)(drow0 + n) * ld_dst + dk0 + k0 + 8 * c) = o; }
    LDS_WAIT(); asm volatile("" ::: "memory");
}
__device__ __forceinline__ void cv_item64(const float* W, int ldn, int k0, int ns0, fp8_t* dst, int ld_dst, int drow0, int dk0, LAS float* scr, int lane) {
    const float* wp = W + (size_t)(k0 + (lane >> 4)) * ldn + ns0 + 4 * (lane & 15);
    f32x4 v[16];
#pragma unroll
    for (int i = 0; i < 16; ++i) v[i] = *(const GAS f32x4*)(wp + (size_t)(4 * i) * ldn);
#pragma unroll
    for (int i = 0; i < 16; ++i) { LAS float* sp = scr + (4 * i + (lane >> 4)) * 65 + 4 * (lane & 15); sp[0] = v[i].x * WSCALE; sp[1] = v[i].y * WSCALE; sp[2] = v[i].z * WSCALE; sp[3] = v[i].w * WSCALE; }
    LDS_WAIT(); asm volatile("" ::: "memory");
    const int c = lane & 3;
#pragma unroll
    for (int j = 0; j < 4; ++j) { const int n = (lane >> 2) + 16 * j; const LAS float* s = scr + (16 * c) * 65 + n;
        u32x4 o; o.x = pk4_fp8(s[0 * 65], s[1 * 65], s[2 * 65], s[3 * 65]); o.y = pk4_fp8(s[4 * 65], s[5 * 65], s[6 * 65], s[7 * 65]);
        o.z = pk4_fp8(s[8 * 65], s[9 * 65], s[10 * 65], s[11 * 65]); o.w = pk4_fp8(s[12 * 65], s[13 * 65], s[14 * 65], s[15 * 65]);
        *(GAS u32x4*)(dst + (size_t)(drow0 + n) * ld_dst + dk0 + k0 + 16 * c) = o; }
    LDS_WAIT(); asm volatile("" ::: "memory");
}
__device__ __forceinline__ void cv_item_small(const float* W, int k0, bf16_t* dst, LAS float* scr, int lane) {
    const int c32 = lane & 31, sc = c32 < 16 ? 5120 + c32 : 9232 + (c32 - 16);
#pragma unroll 8
    for (int i = 0; i < 32; ++i) { const int kk = 2 * i + (lane >> 5); scr[kk * 33 + c32] = W[(size_t)(k0 + kk) * IN_WIDTH + sc]; }
    LDS_WAIT(); asm volatile("" ::: "memory");
    const int c = lane & 7;
#pragma unroll
    for (int j = 0; j < 4; ++j) { const int n = (lane >> 3) + 8 * j; const LAS float* s = scr + (8 * c) * 33 + n;
        u32x4 o; o.x = cvt_pk_bf16(s[0 * 33], s[1 * 33]); o.y = cvt_pk_bf16(s[2 * 33], s[3 * 33]); o.z = cvt_pk_bf16(s[4 * 33], s[5 * 33]); o.w = cvt_pk_bf16(s[6 * 33], s[7 * 33]);
        *(GAS u32x4*)(dst + (size_t)n * D + k0 + 8 * c) = o; }
    LDS_WAIT(); asm volatile("" ::: "memory");
}
__device__ __forceinline__ void cv_item_router(const float* W, int k0, int ns0, bf16_t* dhi, bf16_t* dlo, LAS float* scr, int lane) {
#pragma unroll 8
    for (int i = 0; i < 32; ++i) { const int kk = 2 * i + (lane >> 5); scr[kk * 33 + (lane & 31)] = W[(size_t)(k0 + kk) * NEXP + ns0 + (lane & 31)]; }
    LDS_WAIT(); asm volatile("" ::: "memory");
    const int c = lane & 7;
#pragma unroll
    for (int j = 0; j < 4; ++j) { const int n = (lane >> 3) + 8 * j; const LAS float* s = scr + (8 * c) * 33 + n;
        float v[8], r[8]; unsigned short hb[8];
#pragma unroll
        for (int q = 0; q < 8; ++q) { v[q] = s[q * 33]; hb[q] = f2bf(v[q]); r[q] = v[q] - bf2f(hb[q]); }
        u32x4 o; o.x = hb[0] | ((unsigned)hb[1] << 16); o.y = hb[2] | ((unsigned)hb[3] << 16); o.z = hb[4] | ((unsigned)hb[5] << 16); o.w = hb[6] | ((unsigned)hb[7] << 16);
        u32x4 l; l.x = cvt_pk_bf16(r[0], r[1]); l.y = cvt_pk_bf16(r[2], r[3]); l.z = cvt_pk_bf16(r[4], r[5]); l.w = cvt_pk_bf16(r[6], r[7]);
        *(GAS u32x4*)(dhi + (size_t)(ns0 + n) * D + k0 + 8 * c) = o;
        *(GAS u32x4*)(dlo + (size_t)(ns0 + n) * D + k0 + 8 * c) = l; }
    LDS_WAIT(); asm volatile("" ::: "memory");
}

struct CvDesc { const float* W; fp8_t* dst; int ldn, ld_dst; };
__device__ __forceinline__ void cv_load64(const CvDesc& d, int lane, f32x4 (&v)[16]) {
    const unsigned voff = (unsigned)(((lane >> 4) * d.ldn + 4 * (lane & 15)) * 4);
#pragma unroll
    for (int i = 0; i < 16; ++i) { const GAS float* rp = (const GAS float*)(d.W + (size_t)(4 * i) * d.ldn);
        asm volatile("s_nop 4\n\tglobal_load_dwordx4 %0, %1, %2" : "=&v"(v[i]) : "v"(voff), "s"(rp) : "memory"); }
}
template <int N> __device__ __forceinline__ void cv_wait(f32x4 (&v)[16]) {
    asm volatile("s_waitcnt vmcnt(%16)" : "+v"(v[0]), "+v"(v[1]), "+v"(v[2]), "+v"(v[3]), "+v"(v[4]), "+v"(v[5]), "+v"(v[6]), "+v"(v[7]), "+v"(v[8]), "+v"(v[9]), "+v"(v[10]), "+v"(v[11]), "+v"(v[12]), "+v"(v[13]), "+v"(v[14]), "+v"(v[15]) : "n"(N) : "memory");
}
__device__ __forceinline__ void cv_proc64(const CvDesc& d, f32x4 (&v)[16], LAS float* scr, int lane) {
#pragma unroll
    for (int i = 0; i < 16; ++i) { LAS float* sp = scr + (4 * i + (lane >> 4)) * 65 + 4 * (lane & 15); sp[0] = v[i].x * WSCALE; sp[1] = v[i].y * WSCALE; sp[2] = v[i].z * WSCALE; sp[3] = v[i].w * WSCALE; }
    LDS_WAIT(); asm volatile("" ::: "memory");
    const int c = lane & 3;
#pragma unroll
    for (int j = 0; j < 4; ++j) { const int n = (lane >> 2) + 16 * j; const LAS float* s = scr + (16 * c) * 65 + n;
        u32x4 o; o.x = pk4_fp8(s[0 * 65], s[1 * 65], s[2 * 65], s[3 * 65]); o.y = pk4_fp8(s[4 * 65], s[5 * 65], s[6 * 65], s[7 * 65]);
        o.z = pk4_fp8(s[8 * 65], s[9 * 65], s[10 * 65], s[11 * 65]); o.w = pk4_fp8(s[12 * 65], s[13 * 65], s[14 * 65], s[15 * 65]);
        *(GAS u32x4*)(d.dst + (size_t)n * d.ld_dst + 16 * c) = o; }
    LDS_WAIT(); asm volatile("" ::: "memory");
}
__device__ __forceinline__ void cv_load_k128(const CvDesc& d, int lane, f32x4 (&v)[16]) {
    const unsigned voff = (unsigned)(((lane >> 3) * d.ldn + 4 * (lane & 7)) * 4);
#pragma unroll
    for (int i = 0; i < 16; ++i) { const GAS float* rp = (const GAS float*)(d.W + (size_t)(8 * i) * d.ldn);
        asm volatile("s_nop 4\n\tglobal_load_dwordx4 %0, %1, %2" : "=&v"(v[i]) : "v"(voff), "s"(rp) : "memory"); }
}
__device__ __forceinline__ void cv_proc_k128(const CvDesc& d, f32x4 (&v)[16], LAS float* scr, int lane) {
#pragma unroll
    for (int i = 0; i < 16; ++i) { LAS float* sp = scr + (8 * i + (lane >> 3)) * 33 + 4 * (lane & 7); sp[0] = v[i].x * WSCALE; sp[1] = v[i].y * WSCALE; sp[2] = v[i].z * WSCALE; sp[3] = v[i].w * WSCALE; }
    LDS_WAIT(); asm volatile("" ::: "memory");
    const int c = lane & 7;
#pragma unroll
    for (int j = 0; j < 4; ++j) { const int n = (lane >> 3) + 8 * j; const LAS float* s = scr + (16 * c) * 33 + n;
        u32x4 o; o.x = pk4_fp8(s[0 * 33], s[1 * 33], s[2 * 33], s[3 * 33]); o.y = pk4_fp8(s[4 * 33], s[5 * 33], s[6 * 33], s[7 * 33]);
        o.z = pk4_fp8(s[8 * 33], s[9 * 33], s[10 * 33], s[11 * 33]); o.w = pk4_fp8(s[12 * 33], s[13 * 33], s[14 * 33], s[15 * 33]);
        *(GAS u32x4*)(d.dst + (size_t)n * d.ld_dst + 16 * c) = o; }
    LDS_WAIT(); asm volatile("" ::: "memory");
}
__device__ __forceinline__ void cv_item_k128(const float* W, int ldn, int k0, int n0, fp8_t* dst, int ld_dst, int drow0, int dk0, LAS float* scr, int lane) {
    const float* wp = W + (size_t)(k0 + (lane >> 3)) * ldn + n0 + 4 * (lane & 7);
    f32x4 v[16];
#pragma unroll
    for (int i = 0; i < 16; ++i) v[i] = *(const GAS f32x4*)(wp + (size_t)(8 * i) * ldn);
    CvDesc d; d.W = W; d.ldn = ldn; d.dst = dst + (size_t)drow0 * ld_dst + dk0 + k0; d.ld_dst = ld_dst;
    cv_proc_k128(d, v, scr, lane);
}
__device__ __forceinline__ void phase_convert_experts(Frame& F, const Args& a, int l, int r0, int r1, int gw, int NGW) {
    LAS float* scr = (LAS float*)(F.lds + F.wave * 16896);
    fp8_t* EXP1 = (fp8_t*)(F.ws + WS_EXP1); fp8_t* EXP2 = (fp8_t*)(F.ws + WS_EXP2);
    const float* e_g = a.in[19] + (size_t)l * NEXP * D * EDIM; const float* e_u = a.in[20] + (size_t)l * NEXP * D * EDIM; const float* e_d = a.in[21] + (size_t)l * NEXP * EDIM * D;
    const float* s_g = a.in[22] + (size_t)l * D * EDIM; const float* s_u = a.in[23] + (size_t)l * D * EDIM; const float* s_d = a.in[24] + (size_t)l * EDIM * D;
    auto desc = [&](int r) -> CvDesc {
        const int e = r / 768, q0 = r % 768, kind = q0 >> 8, q = q0 & 255;
        const float* W = (kind == 0 ? (e < 64 ? e_g + (size_t)e * D * EDIM : s_g) : kind == 1 ? (e < 64 ? e_u + (size_t)e * D * EDIM : s_u) : (e < 64 ? e_d + (size_t)e * D * EDIM : s_d));
        const int ldn = kind == 2 ? D : EDIM, nb = kind == 2 ? 64 : 16, k0 = 128 * (q / nb), n0 = 32 * (q % nb);
        fp8_t* dst = kind == 2 ? EXP2 + (size_t)e * D * EDIM : EXP1 + (size_t)e * 1024 * D;
        const int ld_dst = kind == 2 ? EDIM : D, drow0 = kind == 2 ? n0 : (n0 / 128) * 256 + (kind == 1 ? 128 : 0) + (n0 % 128);
        CvDesc d; d.W = W + (size_t)k0 * ldn + n0; d.ldn = ldn; d.dst = dst + (size_t)drow0 * ld_dst + k0; d.ld_dst = ld_dst; return d; };
    int r = r0 + gw;
    if (r < r1) {
        f32x4 va[16], vb[16]; CvDesc da = desc(r), db = da; cv_load_k128(da, F.lane, va);
        {   const int rn = r + NGW; db = desc(rn < r1 ? rn : r); cv_load_k128(db, F.lane, vb); cv_wait<16>(va); cv_proc_k128(da, va, scr, F.lane); r = rn; }
        while (r < r1) {
            {   const int rn = r + NGW; da = desc(rn < r1 ? rn : r); cv_load_k128(da, F.lane, va); cv_wait<20>(vb); cv_proc_k128(db, vb, scr, F.lane); r = rn; }
            if (r >= r1) break;
            {   const int rn = r + NGW; db = desc(rn < r1 ? rn : r); cv_load_k128(db, F.lane, vb); cv_wait<20>(va); cv_proc_k128(da, va, scr, F.lane); r = rn; }
        }
        asm volatile("s_waitcnt vmcnt(0)" ::: "memory");
    }
}
__device__ __forceinline__ void phase_convert(Frame& F, const Args& a, int l, int it0, int it1, int gw, int NGW, bool do_x) {
    LAS float* scr = (LAS float*)(F.lds + F.wave * 16896);
    const float* w_in = a.in[1] + (size_t)l * D * IN_WIDTH;
    const float* w_br = a.in[13] + (size_t)l * 3 * 1024 * D;
    const float* w_out = a.in[14] + (size_t)l * D * D;
    const float* w_rt = a.in[17] + (size_t)l * D * NEXP;
    const float* e_g = a.in[19] + (size_t)l * NEXP * D * EDIM;
    const float* e_u = a.in[20] + (size_t)l * NEXP * D * EDIM;
    const float* e_d = a.in[21] + (size_t)l * NEXP * EDIM * D;
    const float* s_g = a.in[22] + (size_t)l * D * EDIM;
    const float* s_u = a.in[23] + (size_t)l * D * EDIM;
    const float* s_d = a.in[24] + (size_t)l * EDIM * D;
    fp8_t* WIN = (fp8_t*)(F.ws + WS_WIN); bf16_t* SM = (bf16_t*)(F.ws + WS_SM); fp8_t* WBR = (fp8_t*)(F.ws + WS_WBR); fp8_t* WOUT = (fp8_t*)(F.ws + WS_WOUT);
    bf16_t* RTH = (bf16_t*)(F.ws + WS_RT); bf16_t* RTL = RTH + 64 * D; fp8_t* EXP1 = (fp8_t*)(F.ws + WS_EXP1); fp8_t* EXP2 = (fp8_t*)(F.ws + WS_EXP2);
    constexpr int I_A = 32 * 80, I_B = 32 * 64, I_C = 32 * 96, I_SM = 32, I_BR = 16 * 32, I_WO = 32 * 32, I_RT = 32 * 2, I_EG = 32 * 8, I_ED = 8 * 32;
    for (int it = it0 + gw; it < it1; it += NGW) {
        int r = it;
        if (r < I_A) { cv_item_k128(w_in, IN_WIDTH, 128 * (r / 160), 0 + 32 * (r % 160), WIN, D, 0 + 32 * (r % 160), 0, scr, F.lane); continue; } r -= I_A;
        if (r < I_B) { cv_item_k128(w_in, IN_WIDTH, 128 * (r / 128), 5136 + 32 * (r % 128), WIN, D, 5120 + 32 * (r % 128), 0, scr, F.lane); continue; } r -= I_B;
        if (r < I_C) { cv_item_k128(w_in, IN_WIDTH, 128 * (r / 192), 9248 + 32 * (r % 192), WIN, D, 9216 + 32 * (r % 192), 0, scr, F.lane); continue; } r -= I_C;
        if (r < I_SM) { cv_item_small(w_in, 64 * r, SM, scr, F.lane); continue; } r -= I_SM;
        if (r < 3 * I_BR) { const int br = r / I_BR, q = r % I_BR; cv_item_k128(w_br + (size_t)br * 1024 * D, D, 128 * (q / 64), 32 * (q % 64), WBR, 3072, 32 * (q % 64), 1024 * br, scr, F.lane); continue; } r -= 3 * I_BR;
        if (r < I_WO) { cv_item_k128(w_out, D, 128 * (r / 64), 32 * (r % 64), WOUT, D, 32 * (r % 64), 0, scr, F.lane); continue; } r -= I_WO;
        if (r < I_RT) { cv_item_router(w_rt, 64 * (r / 2), 32 * (r % 2), RTH, RTL, scr, F.lane); continue; } r -= I_RT;
        {
            constexpr int PER = 2 * I_EG + I_ED; const int e = r / PER; int q = r % PER;
            const float* wg = e < 64 ? e_g + (size_t)e * D * EDIM : s_g; const float* wu = e < 64 ? e_u + (size_t)e * D * EDIM : s_u; const float* wd = e < 64 ? e_d + (size_t)e * EDIM * D : s_d;
            fp8_t* d1 = EXP1 + (size_t)e * 1024 * D; fp8_t* d2 = EXP2 + (size_t)e * D * EDIM;
            if (q < I_EG) { const int n0 = 64 * (q % 8); cv_item64(wg, EDIM, 64 * (q / 8), n0, d1, D, (n0 / 128) * 256 + (n0 % 128), 0, scr, F.lane); continue; } q -= I_EG;
            if (q < I_EG) { const int n0 = 64 * (q % 8); cv_item64(wu, EDIM, 64 * (q / 8), n0, d1, D, (n0 / 128) * 256 + 128 + (n0 % 128), 0, scr, F.lane); continue; } q -= I_EG;
            cv_item64(wd, D, 64 * (q / 32), 64 * (q % 32), d2, EDIM, 64 * (q % 32), 0, scr, F.lane);
        }
    }
    if (do_x) {
        const float* x = a.in[0]; fp8_t* XB = (fp8_t*)(F.ws + WS_XB); bf16_t* XR = (bf16_t*)(F.ws + WS_XRES);
        for (int m = gw; m < T; m += NGW) { const GAS f32x4* xr = (const GAS f32x4*)(x + (size_t)m * D) + 2 * F.lane; GAS u32x2* o = (GAS u32x2*)(XB + (size_t)m * D) + F.lane; GAS u32x4* ob = (GAS u32x4*)(XR + (size_t)m * D) + F.lane;
            f32x4 v0[4], v1[4];
#pragma unroll
            for (int j = 0; j < 4; ++j) { v0[j] = xr[128 * j]; v1[j] = xr[128 * j + 1]; }
#pragma unroll
            for (int j = 0; j < 4; ++j) { u32x2 q8; q8.x = pk4_fp8(v0[j].x, v0[j].y, v0[j].z, v0[j].w); q8.y = pk4_fp8(v1[j].x, v1[j].y, v1[j].z, v1[j].w); o[64 * j] = q8;
                u32x4 wb; wb.x = cvt_pk_bf16(v0[j].x, v0[j].y); wb.y = cvt_pk_bf16(v0[j].z, v0[j].w); wb.z = cvt_pk_bf16(v1[j].x, v1[j].y); wb.w = cvt_pk_bf16(v1[j].z, v1[j].w); ob[64 * j] = wb; } }
    }
}

namespace pg8 {
struct EpiBf16 {
    static constexpr bool PERM = true, HAS_MID = false; static constexpr int MID0 = -1, MID1 = -1;
    bf16_t* O; int ldc; int nmod;
    __device__ __forceinline__ void mid(f32x4 (&)[2][2][4][2], const Unit&, int, int, int, int, int) const {}
    __device__ __forceinline__ void operator()(const f32x4 (&acc)[2][2][4][2], const Unit& u, int wr, int wc, int fr, int fq) const {
        const int pl = nmod ? (u.pn % nmod) : u.pn;
        const int row0 = u.pm * BM + wr * 64 + fr, col0 = pl * BM + wc * 32 + 8 * fq;
#pragma unroll
        for (int ai = 0; ai < 2; ++ai)
#pragma unroll
            for (int m = 0; m < 4; ++m) { bf16_t* rowp = O + (size_t)(row0 + ai * HALF + m * 16) * ldc + col0;
#pragma unroll
                for (int bj = 0; bj < 2; ++bj) { const f32x4 v0 = acc[ai][bj][m][0], v1 = acc[ai][bj][m][1];
                    u32x4 w; w.x = cvt_pk_bf16(v0[0], v0[1]); w.y = cvt_pk_bf16(v0[2], v0[3]); w.z = cvt_pk_bf16(v1[0], v1[1]); w.w = cvt_pk_bf16(v1[2], v1[3]);
                    *(u32x4*)(rowp + bj * HALF) = w; } }
    }
};
struct EpiGate {
    static constexpr bool PERM = true, PERM16 = true, HAS_MID = false; static constexpr int MID0 = -1, MID1 = -1;
    unsigned char* G;
    __device__ __forceinline__ void mid(f32x4 (&)[2][2][4][2], const Unit&, int, int, int, int, int) const {}
    __device__ __forceinline__ void operator()(const f32x4 (&acc)[2][2][4][2], const Unit& u, int wr, int wc, int fr, int fq) const {
        const int row0 = u.pm * BM + wr * 64 + fr, col0 = u.pn * BM + wc * 64 + 16 * fq;
#pragma unroll
        for (int ai = 0; ai < 2; ++ai)
#pragma unroll
            for (int m = 0; m < 4; ++m) { unsigned char* rowp = G + (size_t)(row0 + ai * HALF + m * 16) * NGATE + col0; u32x4 w;
#pragma unroll
                for (int bj = 0; bj < 2; ++bj)
#pragma unroll
                    for (int n = 0; n < 2; ++n) { unsigned pk = 0;
#pragma unroll
                        for (int q = 0; q < 4; ++q) pk = __builtin_amdgcn_cvt_pk_u8_f32(fmaxf(__builtin_rintf(255.0f * sigmoidf_(acc[ai][bj][m][n][q])), 1.0f), q, pk);
                        w[2 * bj + n] = pk; }
                *(u32x4*)rowp = w; }
    }
};

struct EpiFp8 {
    static constexpr bool PERM = true, PERM16 = true, HAS_MID = false; static constexpr int MID0 = -1, MID1 = -1;
    fp8_t* O; int ldc; int nmod;
    __device__ __forceinline__ void mid(f32x4 (&)[2][2][4][2], const Unit&, int, int, int, int, int) const {}
    __device__ __forceinline__ void operator()(const f32x4 (&acc)[2][2][4][2], const Unit& u, int wr, int wc, int fr, int fq) const {
        const int pl = nmod ? (u.pn % nmod) : u.pn;
        const int row0 = u.pm * BM + wr * 64 + fr, col0 = pl * BM + wc * 64 + 16 * fq;
#pragma unroll
        for (int ai = 0; ai < 2; ++ai)
#pragma unroll
            for (int m = 0; m < 4; ++m) { fp8_t* rowp = O + (size_t)(row0 + ai * HALF + m * 16) * ldc + col0; u32x4 w;
#pragma unroll
                for (int bj = 0; bj < 2; ++bj)
#pragma unroll
                    for (int n = 0; n < 2; ++n) { const f32x4 v = acc[ai][bj][m][n] * OSCALE; w[2 * bj + n] = pk4_fp8(v[0], v[1], v[2], v[3]); }
                *(u32x4*)rowp = w; }
    }
};
struct EpiSwiglu {
    static constexpr bool PERM = true, HAS_MID = false; static constexpr int MID0 = -1, MID1 = -1;
    fp8_t* O; int ldc;
    __device__ __forceinline__ void mid(f32x4 (&)[2][2][4][2], const Unit&, int, int, int, int, int) const {}
    __device__ __forceinline__ void operator()(const f32x4 (&acc)[2][2][4][2], const Unit& u, int wr, int wc, int fr, int fq) const {
        const int pl = u.pn & 3;
        const int row0 = u.pm * BM + wr * 64 + fr, col0 = pl * HALF + wc * 32 + 8 * fq;
#pragma unroll
        for (int ai = 0; ai < 2; ++ai)
#pragma unroll
            for (int m = 0; m < 4; ++m) { fp8_t* rowp = O + (size_t)(row0 + ai * HALF + m * 16) * ldc + col0;
                float h[8];
#pragma unroll
                for (int n = 0; n < 2; ++n)
#pragma unroll
                    for (int j = 0; j < 4; ++j) { const float gt = acc[ai][0][m][n][j], up = acc[ai][1][m][n][j]; h[4 * n + j] = siluf_(gt) * up; }
                u32x2 w; w.x = pk4_fp8(h[0], h[1], h[2], h[3]); w.y = pk4_fp8(h[4], h[5], h[6], h[7]);
                *(u32x2*)(rowp) = w; }
    }
};
struct EpiMerge {
    static constexpr bool PERM = true, PERM16 = true, HAS_MID = true; static constexpr int MID0 = 8, MID1 = 16;
    const unsigned char* P; fp8_t* O;
    __device__ __forceinline__ void mid(f32x4 (&acc)[2][2][4][2], const Unit& u, int t, int wr, int wc, int fr, int fq) const {
        const int i = t >> 3;
        unsigned o0 = (unsigned)(u.pm * BM + wr * 64 + fr) * (unsigned)NGATE + (unsigned)((i - 1) * 2048 + u.pn * BM + wc * 64 + 16 * fq);
        asm volatile("" : "+v"(o0));
        const char* Pb = (const char*)P;
#pragma unroll
        for (int ai = 0; ai < 2; ++ai)
#pragma unroll
            for (int m = 0; m < 4; ++m) { const unsigned orow = o0 + (unsigned)((ai * HALF + m * 16) * NGATE);
                const u32x4 ga = *(const u32x4*)(Pb + orow), gb = *(const u32x4*)(Pb + orow + 2048);
#pragma unroll
                for (int bj = 0; bj < 2; ++bj)
#pragma unroll
                    for (int n = 0; n < 2; ++n)
#pragma unroll
                        for (int q = 0; q < 4; ++q) acc[ai][bj][m][n][q] *= (float)((ga[2 * bj + n] >> (8 * q)) & 255u) * __builtin_amdgcn_rcpf((float)((gb[2 * bj + n] >> (8 * q)) & 255u));
                asm volatile("" : "+v"(acc[ai][0][m][0]), "+v"(acc[ai][0][m][1]), "+v"(acc[ai][1][m][0]), "+v"(acc[ai][1][m][1]) :: "memory"); }
    }
    __device__ __forceinline__ void operator()(const f32x4 (&acc)[2][2][4][2], const Unit& u, int wr, int wc, int fr, int fq) const {
        unsigned o0 = (unsigned)(u.pm * BM + wr * 64 + fr) * (unsigned)NGATE + (unsigned)(2 * 2048 + u.pn * BM + wc * 64 + 16 * fq);
        unsigned q0 = (unsigned)(u.pm * BM + wr * 64 + fr) * (unsigned)D + (unsigned)(u.pn * BM + wc * 64 + 16 * fq);
        asm volatile("" : "+v"(o0), "+v"(q0));
        const char* Pb = (const char*)P; char* Ob = (char*)O;
#pragma unroll
        for (int ai = 0; ai < 2; ++ai)
#pragma unroll
            for (int m = 0; m < 4; ++m) { const unsigned orow = o0 + (unsigned)((ai * HALF + m * 16) * NGATE), qrow = q0 + (unsigned)((ai * HALF + m * 16) * D);
                const u32x4 gg = *(const u32x4*)(Pb + orow); u32x4 w;
#pragma unroll
                for (int bj = 0; bj < 2; ++bj)
#pragma unroll
                    for (int n = 0; n < 2; ++n) { float v[4];
#pragma unroll
                        for (int q = 0; q < 4; ++q) v[q] = acc[ai][bj][m][n][q] * ((float)((gg[2 * bj + n] >> (8 * q)) & 255u) * (1.0f / 255.0f));
                        w[2 * bj + n] = pk4_fp8(v[0], v[1], v[2], v[3]); }
                *(u32x4*)(Ob + qrow) = w;
                asm volatile("" ::: "memory"); }
    }
};
struct EpiWout {
    static constexpr bool PERM = true, HAS_MID = false; static constexpr int MID0 = -1, MID1 = -1;
    const bf16_t* Xb; bf16_t* H;
    __device__ __forceinline__ void mid(f32x4 (&)[2][2][4][2], const Unit&, int, int, int, int, int) const {}
    __device__ __forceinline__ void operator()(const f32x4 (&acc)[2][2][4][2], const Unit& u, int wr, int wc, int fr, int fq) const {
        const int row0 = u.pm * BM + wr * 64 + fr, col0 = u.pn * BM + wc * 32 + 8 * fq;
#pragma unroll
        for (int ai = 0; ai < 2; ++ai)
#pragma unroll
            for (int m = 0; m < 4; ++m) { const unsigned off = (unsigned)((row0 + ai * HALF + m * 16) * D + col0);
#pragma unroll
                for (int bj = 0; bj < 2; ++bj) { const u32x4 xp = *(const u32x4*)(Xb + off + bj * HALF);
                    const f32x4 x0 = {bflo(xp.x), bfhi(xp.x), bflo(xp.y), bfhi(xp.y)}, x1 = {bflo(xp.z), bfhi(xp.z), bflo(xp.w), bfhi(xp.w)};
                    const f32x4 h0 = x0 * ALPHA + acc[ai][bj][m][0], h1 = x1 * ALPHA + acc[ai][bj][m][1];
                    u32x4 w; w.x = cvt_pk_bf16(h0[0], h0[1]); w.y = cvt_pk_bf16(h0[2], h0[3]); w.z = cvt_pk_bf16(h1[0], h1[1]); w.w = cvt_pk_bf16(h1[2], h1[3]);
                    *(u32x4*)(H + off + bj * HALF) = w; } }
    }
};
}

#ifndef FUSE_LN1
#define FUSE_LN1 1
#endif
__device__ __forceinline__ void phase_ln1(Frame& F, const Args& a, int l) {
    const int gw = F.bid * NWAVES + F.wave, NGW = F.G * NWAVES;
    bf16_t* H = (bf16_t*)(F.ws + WS_H); fp8_t* X1B = (fp8_t*)(F.ws + WS_X1B);
    const GAS f32x4* gp = (const GAS f32x4*)(a.in[15] + (size_t)l * D) + 2 * F.lane; const GAS f32x4* bp = (const GAS f32x4*)(a.in[16] + (size_t)l * D) + 2 * F.lane;
    for (int m = gw; m < T; m += NGW) {
        GAS u32x4* xr = (GAS u32x4*)(H + (size_t)m * D) + F.lane;
        u32x4 p[4]; float v[4][8]; float s = 0.f;
#pragma unroll
        for (int j = 0; j < 4; ++j) p[j] = xr[64 * j];
#pragma unroll
        for (int j = 0; j < 4; ++j) { v[j][0] = bflo(p[j].x); v[j][1] = bfhi(p[j].x); v[j][2] = bflo(p[j].y); v[j][3] = bfhi(p[j].y); v[j][4] = bflo(p[j].z); v[j][5] = bfhi(p[j].z); v[j][6] = bflo(p[j].w); v[j][7] = bfhi(p[j].w);
            s += ((v[j][0] + v[j][1]) + (v[j][2] + v[j][3])) + ((v[j][4] + v[j][5]) + (v[j][6] + v[j][7])); }
        const float mean = wave_sum(s) * (1.f / D); float s2 = 0.f;
#pragma unroll
        for (int j = 0; j < 4; ++j)
#pragma unroll
            for (int q = 0; q < 8; ++q) { v[j][q] -= mean; s2 += v[j][q] * v[j][q]; }
        const float rstd = 1.f / sqrtf(wave_sum(s2) * (1.f / D) + EPS);
        GAS u32x2* o8 = (GAS u32x2*)(X1B + (size_t)m * D) + F.lane;
#pragma unroll
        for (int j = 0; j < 4; ++j) { const f32x4 g0 = gp[128 * j], g1 = gp[128 * j + 1], b0 = bp[128 * j], b1 = bp[128 * j + 1];
            const f32x4 y0 = {v[j][0] * rstd * g0.x + b0.x, v[j][1] * rstd * g0.y + b0.y, v[j][2] * rstd * g0.z + b0.z, v[j][3] * rstd * g0.w + b0.w};
            const f32x4 y1 = {v[j][4] * rstd * g1.x + b1.x, v[j][5] * rstd * g1.y + b1.y, v[j][6] * rstd * g1.z + b1.z, v[j][7] * rstd * g1.w + b1.w};
            u32x4 w; w.x = cvt_pk_bf16(y0.x, y0.y); w.y = cvt_pk_bf16(y0.z, y0.w); w.z = cvt_pk_bf16(y1.x, y1.y); w.w = cvt_pk_bf16(y1.z, y1.w); xr[64 * j] = w;
            u32x2 q8; q8.x = pk4_fp8(y0.x, y0.y, y0.z, y0.w); q8.y = pk4_fp8(y1.x, y1.y, y1.z, y1.w); o8[64 * j] = q8; }
    }
}

__device__ __forceinline__ void ln1_rows8(Frame& F, const Args& a, int l, int m0) {
    bf16_t* H = (bf16_t*)(F.ws + WS_H); fp8_t* X1B = (fp8_t*)(F.ws + WS_X1B);
    const GAS f32x4* gp = (const GAS f32x4*)(a.in[15] + (size_t)l * D) + 2 * F.lane; const GAS f32x4* bp = (const GAS f32x4*)(a.in[16] + (size_t)l * D) + 2 * F.lane;
    for (int hb = 0; hb < 2; ++hb) {
        u32x4 p[4][4];
#pragma unroll
        for (int r = 0; r < 4; ++r) { const GAS u32x4* xr = (const GAS u32x4*)(H + (size_t)(m0 + 4 * hb + r) * D) + F.lane;
#pragma unroll
            for (int j = 0; j < 4; ++j) p[r][j] = xr[64 * j]; }
#pragma unroll
        for (int r = 0; r < 4; ++r) { const int m = m0 + 4 * hb + r;
            float v[4][8]; float s = 0.f;
#pragma unroll
            for (int j = 0; j < 4; ++j) { v[j][0] = bflo(p[r][j].x); v[j][1] = bfhi(p[r][j].x); v[j][2] = bflo(p[r][j].y); v[j][3] = bfhi(p[r][j].y); v[j][4] = bflo(p[r][j].z); v[j][5] = bfhi(p[r][j].z); v[j][6] = bflo(p[r][j].w); v[j][7] = bfhi(p[r][j].w);
                s += ((v[j][0] + v[j][1]) + (v[j][2] + v[j][3])) + ((v[j][4] + v[j][5]) + (v[j][6] + v[j][7])); }
            const float mean = wave_sum(s) * (1.f / D); float s2 = 0.f;
#pragma unroll
            for (int j = 0; j < 4; ++j)
#pragma unroll
                for (int q = 0; q < 8; ++q) { v[j][q] -= mean; s2 += v[j][q] * v[j][q]; }
            const float rstd = 1.f / sqrtf(wave_sum(s2) * (1.f / D) + EPS);
            GAS u32x4* xw = (GAS u32x4*)(H + (size_t)m * D) + F.lane; GAS u32x2* o8 = (GAS u32x2*)(X1B + (size_t)m * D) + F.lane;
#pragma unroll
            for (int j = 0; j < 4; ++j) { const f32x4 g0 = gp[128 * j], g1 = gp[128 * j + 1], b0 = bp[128 * j], b1 = bp[128 * j + 1];
                const f32x4 y0 = {v[j][0] * rstd * g0.x + b0.x, v[j][1] * rstd * g0.y + b0.y, v[j][2] * rstd * g0.z + b0.z, v[j][3] * rstd * g0.w + b0.w};
                const f32x4 y1 = {v[j][4] * rstd * g1.x + b1.x, v[j][5] * rstd * g1.y + b1.y, v[j][6] * rstd * g1.z + b1.z, v[j][7] * rstd * g1.w + b1.w};
                u32x4 w; w.x = cvt_pk_bf16(y0.x, y0.y); w.y = cvt_pk_bf16(y0.z, y0.w); w.z = cvt_pk_bf16(y1.x, y1.y); w.w = cvt_pk_bf16(y1.z, y1.w); xw[64 * j] = w;
                u32x2 q8; q8.x = pk4_fp8(y0.x, y0.y, y0.z, y0.w); q8.y = pk4_fp8(y1.x, y1.y, y1.z, y1.w); o8[64 * j] = q8; } }
    }
}

__device__ __forceinline__ bf16x8 pack8(const float* v) { u32x4 p; p.x = cvt_pk_bf16(v[0], v[1]); p.y = cvt_pk_bf16(v[2], v[3]); p.z = cvt_pk_bf16(v[4], v[5]); p.w = cvt_pk_bf16(v[6], v[7]); return __builtin_bit_cast(bf16x8, p); }
__device__ __forceinline__ float grp8_max(float v) { v = fmaxf(v, swz_xor<1>(v)); v = fmaxf(v, swz_xor<2>(v)); v = fmaxf(v, swz_xor<4>(v)); return v; }
__device__ __forceinline__ void phase_router(Frame& F, const Args& a, int l) {
    const bf16_t* X1 = (const bf16_t*)(F.ws + WS_H);
    const bf16_t* RTH = (const bf16_t*)(F.ws + WS_RT); const bf16_t* RTL = RTH + 64 * D;
    unsigned long long* SELMASK = (unsigned long long*)(F.ws + WS_MISC + MS_SELMASK); float* SELW = (float*)(F.ws + WS_MISC + MS_SELW); int* CNT = (int*)(F.ws + WS_MISC + MS_CNT);
    LAS float* PART = (LAS float*)F.lds;
    LAS float* LG = (LAS float*)(F.lds + 131072);
    LAS int* CNTL = (LAS int*)(F.lds + 131072 + 16384);
    const int lane = F.lane, w = F.wave, li = lane & 15, lq = lane >> 4;
    const float bias = a.in[18][l * NEXP + lane];
    for (int blk = F.bid; blk < T / 64; blk += F.G) {
#if FUSE_LN1
        ln1_rows8(F, a, l, blk * 64 + w * 8);
        __syncthreads();
#endif
        if (F.tid < 64) CNTL[F.tid] = 0;
        {
            f32x4 acc[4][4];
#pragma unroll
            for (int rt = 0; rt < 4; ++rt)
#pragma unroll
                for (int nb = 0; nb < 4; ++nb) acc[rt][nb] = (f32x4){0.f, 0.f, 0.f, 0.f};
            const bf16_t* xp = X1 + (size_t)(blk * 64 + li) * D + 256 * w + 8 * lq;
            const bf16_t* whp = RTH + (size_t)li * D + 256 * w + 8 * lq;
#pragma unroll 4
            for (int ks = 0; ks < 8; ++ks) {
                bf16x8 xh[4], bh[4];
#pragma unroll
                for (int rt = 0; rt < 4; ++rt) xh[rt] = *(const bf16x8*)(xp + (size_t)(16 * rt) * D + 32 * ks);
#pragma unroll
                for (int nb = 0; nb < 4; ++nb) bh[nb] = *(const bf16x8*)(whp + (size_t)(16 * nb) * D + 32 * ks);
#pragma unroll
                for (int rt = 0; rt < 4; ++rt)
#pragma unroll
                    for (int nb = 0; nb < 4; ++nb) acc[rt][nb] = __builtin_amdgcn_mfma_f32_16x16x32_bf16(xh[rt], bh[nb], acc[rt][nb], 0, 0, 0);
            }
#pragma unroll
            for (int rt = 0; rt < 4; ++rt)
#pragma unroll
                for (int nb = 0; nb < 4; ++nb)
#pragma unroll
                    for (int r = 0; r < 4; ++r) PART[(w * 64 + 16 * rt + 4 * lq + r) * 64 + 16 * nb + li] = acc[rt][nb][r];
        }
        __syncthreads();
#pragma unroll
        for (int i = 0; i < 8; ++i) { const int id = F.tid + 512 * i; float sacc = 0.f;
#pragma unroll
            for (int q = 0; q < 8; ++q) sacc += PART[q * 4096 + id];
            LG[id] = sacc; }
        __syncthreads();
        int mycnt = 0;
        for (int i = 0; i < 8; ++i) {
            const int tl = w * 8 + i, t = blk * 64 + tl;
            const float logit = LG[tl * 64 + lane];
            const float score = 1.0f / (1.0f + expf(-logit));
            const float sel = score + bias;
            const float m1 = grp8_max(sel);
            const unsigned long long eqm = __ballot(sel == m1);
            const unsigned gb = (unsigned)(eqm >> (lane & ~7)) & 0xffu;
            const int first = __builtin_ctz(gb);
            const float v2 = ((lane & 7) == first) ? -INFINITY : sel;
            const float gs = m1 + grp8_max(v2);
            const int g = lane >> 3; int grank = 0;
#pragma unroll
            for (int g2 = 0; g2 < 8; ++g2) { const float o = __builtin_bit_cast(float, __builtin_amdgcn_readlane(__builtin_bit_cast(int, gs), 8 * g2)); grank += (o > gs || (o == gs && g2 < g)) ? 1 : 0; }
            const float mv = grank < 4 ? sel : -INFINITY;
            int rank = 0;
#pragma unroll 4
            for (int e2 = 0; e2 < 64; ++e2) { const float o = __builtin_bit_cast(float, __builtin_amdgcn_readlane(__builtin_bit_cast(int, mv), e2)); rank += (o > mv || (o == mv && e2 < lane)) ? 1 : 0; }
            const bool chosen = rank < 8;
            const unsigned long long mask = __ballot(chosen);
            const float wsum = wave_sum(chosen ? score : 0.f);
            const float wgt = score / wsum * 2.5f;
            if (chosen) { const int j = __builtin_popcountll(mask & ((1ull << lane) - 1ull)); SELW[(size_t)t * 8 + j] = wgt; }
            if (lane == 0) SELMASK[t] = mask;
            mycnt += chosen ? 1 : 0;
        }
        __hip_atomic_fetch_add(&CNTL[lane], mycnt, __ATOMIC_RELAXED, __HIP_MEMORY_SCOPE_WORKGROUP);
        __syncthreads();
        if (F.tid < 64) CNT[blk * 64 + F.tid] = CNTL[F.tid];
        __syncthreads();
    }
}

__device__ __forceinline__ void phase_lists(Frame& F) {
    const unsigned long long* SELMASK = (const unsigned long long*)(F.ws + WS_MISC + MS_SELMASK); const int* CNT = (const int*)(F.ws + WS_MISC + MS_CNT);
    int* TOK2SLOT = (int*)(F.ws + WS_MISC + MS_TOK2SLOT); int* SLOTTOK = (int*)(F.ws + WS_MISC + MS_SLOTTOK); int* BLKE = (int*)(F.ws + WS_MISC + MS_BLKE); int* NBLK = (int*)(F.ws + WS_MISC + MS_NBLK);
    LAS int* P = (LAS int*)F.lds;
    LAS int* TOT = P + 1024;
    LAS int* PST = TOT + 64; LAS int* BASE = TOT + 192;
    const int lane = F.lane, e = F.tid & 63, part = F.tid >> 6;
    for (int blk = F.bid; blk < T / 64; blk += F.G) {
        int tot = 0, pre = 0;
        for (int b2 = part; b2 < T / 64; b2 += 8) { const int c = CNT[b2 * 64 + e]; tot += c; pre += (b2 < blk) ? c : 0; }
        P[part * 64 + e] = tot; P[512 + part * 64 + e] = pre;
        __syncthreads();
        if (F.tid < 64) { int t2 = 0, p2 = 0;
#pragma unroll
            for (int q = 0; q < 8; ++q) { t2 += P[q * 64 + e]; p2 += P[512 + q * 64 + e]; }
            TOT[e] = t2; BASE[e] = p2;
            const int padded = (t2 + 255) & ~255;
            const int incl = wave_scan_i(padded, lane);
            PST[e] = incl - padded; if (e == 63) PST[64] = incl;
        }
        __syncthreads();
        if (F.wave == 0) {
            int running = PST[lane] + BASE[lane];
            const unsigned long long mymask = SELMASK[blk * 64 + lane];
            const unsigned mlo = (unsigned)mymask, mhi = (unsigned)(mymask >> 32);
            for (int i = 0; i < 64; ++i) {
                const unsigned long long mk = ((unsigned long long)(unsigned)__builtin_amdgcn_readlane((int)mhi, i) << 32) | (unsigned)__builtin_amdgcn_readlane((int)mlo, i);
                if ((mk >> lane) & 1ull) { const int t = blk * 64 + i, j = __builtin_popcountll(mk & ((1ull << lane) - 1ull)); TOK2SLOT[t * 8 + j] = running; SLOTTOK[running] = t; ++running; }
            }
        }
        if (blk == 0) {
            const int nblk = PST[64] >> 8;
            if (F.tid == 0) NBLK[0] = nblk;
            for (int ee = F.wave; ee < 64; ee += NWAVES) { const int s0 = PST[ee] + TOT[ee], s1 = PST[ee + 1]; for (int s = s0 + lane; s < s1; s += 64) SLOTTOK[s] = 0;
                for (int j = (PST[ee] >> 8) + lane; j < (PST[ee + 1] >> 8); j += 64) BLKE[j] = ee; }
            for (int j = F.tid; j < 64; j += NTHR) BLKE[MAXSLOT / 256 + j] = 64;
        }
        for (int i = F.tid; i < 64; i += NTHR) SLOTTOK[MAXSLOT + blk * 64 + i] = blk * 64 + i;
        __syncthreads();
    }
}

constexpr int MOE_TOKL = 131072, MOE_BLKL = 131072 + 12288;
__device__ __forceinline__ bool moe_unit(int i, int c, int G, int NT, int nb, int& j, int& pl) {
    if ((G & 7) == 0 && ((G >> 3) % NT) == 0) { const int W = G >> 3, x = c & 7, q = c >> 3; j = i * (G / NT) + x * (W / NT) + q / NT; pl = q % NT; return j < nb; }
    const int L = i * G + c; j = L / NT; pl = L - j * NT; return j < nb;
}
struct MoeOrder2 {
    const LAS int* blke_l; int nblk, NT, G, c;
    __device__ bool next(int i, pg8::Unit& u) const {
        int j, pl; if (!moe_unit(i, c, G, NT, nblk + 64, j, pl)) return false;
        const int jj = j < nblk ? j : (MAXSLOT / 256 + (j - nblk));
        u.pm = jj; u.pn = __builtin_amdgcn_readfirstlane(blke_l[i]) * NT + pl; return true;
    }
};
template <bool GATHER> __device__ __forceinline__ void moe_fill(Frame& F, int nblk, int NT) {
    const int* BLKE = (const int*)(F.ws + WS_MISC + MS_BLKE); const int* SLOTTOK = (const int*)(F.ws + WS_MISC + MS_SLOTTOK);
    LAS int* TOKL = (LAS int*)(F.lds + MOE_TOKL); LAS int* BLKL = (LAS int*)(F.lds + MOE_BLKL);
    for (int i = 0; i < (GATHER ? 12 : 64); ++i) { int j, pl; if (!moe_unit(i, F.bid, F.G, NT, nblk + 64, j, pl)) break;
        const int jj = j < nblk ? j : (MAXSLOT / 256 + (j - nblk));
        if (F.tid == 0) BLKL[i] = BLKE[jj];
        if (GATHER && F.tid < 256) TOKL[i * 256 + F.tid] = SLOTTOK[jj * 256 + F.tid]; }
    __syncthreads();
}

__device__ __forceinline__ void phase_combine(Frame& F, const Args& a, int l) {
    const int gw = F.bid * NWAVES + F.wave, NGW = F.G * NWAVES;
    const GAS char* X1 = (const GAS char*)(F.ws + WS_H); const GAS char* OS = (const GAS char*)(F.ws + WS_OS);
    const int* TOK2SLOT = (const int*)(F.ws + WS_MISC + MS_TOK2SLOT); const float* SELW = (const float*)(F.ws + WS_MISC + MS_SELW);
    GAS char* XRES = (GAS char*)((l == DEPTH - 1) ? a.out : (float*)(F.ws + WS_XRES)); GAS char* XB = (GAS char*)(F.ws + WS_XB);
    const GAS char* gp = (const GAS char*)(a.in[25] + (size_t)l * D); const GAS char* bp = (const GAS char*)(a.in[26] + (size_t)l * D);
    for (int m = gw; m < T; m += NGW) {
        int ln = F.lane; asm volatile("" : "+v"(ln));
        const unsigned o32 = (unsigned)ln * 32u, o8 = (unsigned)ln * 8u;
        int slot[8]; float wt[8];
#pragma unroll
        for (int k = 0; k < 8; ++k) { slot[k] = __builtin_amdgcn_readfirstlane(TOK2SLOT[m * 8 + k]); wt[k] = __builtin_bit_cast(float, __builtin_amdgcn_readfirstlane(__builtin_bit_cast(int, SELW[m * 8 + k]))) * (1.0f / OSCALE); }
        const GAS char* xr = X1 + (size_t)m * (D * 2); const GAS char* shr = OS + (size_t)(MAXSLOT + m) * D;
        float v[4][8];
#pragma unroll
        for (int j = 0; j < 4; ++j) {
            const u32x4 xp8 = *(const GAS u32x4*)(xr + 2u * o8 + 1024 * j);
            const u32x2 sh = *(const GAS u32x2*)(shr + o8 + 512 * j);
            u32x2 ex[8];
#pragma unroll
            for (int k = 0; k < 8; ++k) ex[k] = *(const GAS u32x2*)(OS + (size_t)slot[k] * D + o8 + 512 * j);
            float acc[8] = {bflo(xp8.x) * ALPHA, bfhi(xp8.x) * ALPHA, bflo(xp8.y) * ALPHA, bfhi(xp8.y) * ALPHA, bflo(xp8.z) * ALPHA, bfhi(xp8.z) * ALPHA, bflo(xp8.w) * ALPHA, bfhi(xp8.w) * ALPHA};
            {   float f0[4], f1[4]; unpk4_fp8(sh.x, f0); unpk4_fp8(sh.y, f1);
#pragma unroll
                for (int q = 0; q < 4; ++q) { acc[q] += f0[q] * (1.0f / OSCALE); acc[4 + q] += f1[q] * (1.0f / OSCALE); } }
#pragma unroll
            for (int k = 0; k < 8; ++k) { float f0[4], f1[4]; unpk4_fp8(ex[k].x, f0); unpk4_fp8(ex[k].y, f1);
#pragma unroll
                for (int q = 0; q < 4; ++q) { acc[q] += wt[k] * f0[q]; acc[4 + q] += wt[k] * f1[q]; } }
#pragma unroll
            for (int q = 0; q < 8; ++q) v[j][q] = acc[q];
        }
        float s = 0.f;
#pragma unroll
        for (int j = 0; j < 4; ++j)
#pragma unroll
            for (int q = 0; q < 8; ++q) s += v[j][q];
        const float mean = wave_sum(s) * (1.f / D); float s2 = 0.f;
#pragma unroll
        for (int j = 0; j < 4; ++j)
#pragma unroll
            for (int q = 0; q < 8; ++q) { v[j][q] -= mean; s2 += v[j][q] * v[j][q]; }
        const float rstd = 1.f / sqrtf(wave_sum(s2) * (1.f / D) + EPS);
        GAS char* orow = XRES + (size_t)m * (D * 4); GAS char* orow16 = XRES + (size_t)m * (D * 2); GAS char* xbr = XB + (size_t)m * D;
#pragma unroll
        for (int j = 0; j < 4; ++j) { const f32x4 g0 = *(const GAS f32x4*)(gp + o32 + 2048 * j), g1 = *(const GAS f32x4*)(gp + o32 + 2048 * j + 16), b0 = *(const GAS f32x4*)(bp + o32 + 2048 * j), b1 = *(const GAS f32x4*)(bp + o32 + 2048 * j + 16);
            const f32x4 y0 = {v[j][0] * rstd * g0.x + b0.x, v[j][1] * rstd * g0.y + b0.y, v[j][2] * rstd * g0.z + b0.z, v[j][3] * rstd * g0.w + b0.w};
            const f32x4 y1 = {v[j][4] * rstd * g1.x + b1.x, v[j][5] * rstd * g1.y + b1.y, v[j][6] * rstd * g1.z + b1.z, v[j][7] * rstd * g1.w + b1.w};
            if (l == DEPTH - 1) { *(GAS f32x4*)(orow + o32 + 2048 * j) = y0; *(GAS f32x4*)(orow + o32 + 2048 * j + 16) = y1; }
            else {
                u32x4 wb; wb.x = cvt_pk_bf16(y0.x, y0.y); wb.y = cvt_pk_bf16(y0.z, y0.w); wb.z = cvt_pk_bf16(y1.x, y1.y); wb.w = cvt_pk_bf16(y1.z, y1.w); *(GAS u32x4*)(orow16 + 2u * o8 + 1024 * j) = wb;
                u32x2 w; w.x = pk4_fp8(y0.x, y0.y, y0.z, y0.w); w.y = pk4_fp8(y1.x, y1.y, y1.z, y1.w); *(GAS u32x2*)(xbr + o8 + 512 * j) = w; } }
    }
}

typedef short v4i16_t __attribute__((ext_vector_type(4)));
__device__ __forceinline__ unsigned offb(unsigned row, unsigned ch) { return 256u * row + 16u * (ch ^ (((row & 3u) << 2) | ((row >> 2) & 3u))); }
__device__ __forceinline__ s16x4 trr(const LAS unsigned char* p) { return __builtin_bit_cast(s16x4, __builtin_amdgcn_ds_read_tr16_b64_v4i16((LAS v4i16_t*)p)); }
#define MFMA32(a, b, c) __builtin_amdgcn_mfma_f32_32x32x16_bf16((a), (b), (c), 0, 0, 0)
__device__ __forceinline__ int crow(int i, int hh) { return (i & 3) + 8 * (i >> 2) + 4 * hh; }
__device__ __forceinline__ bf16x8 frag_row(const LAS unsigned char* img, int row0, int s, int lane) { return *(const LAS bf16x8*)(img + offb(row0 + (lane & 31), 2 * s + (lane >> 5))); }
template <bool PERMK> __device__ __forceinline__ bf16x8 frag_tr(const LAS unsigned char* img, int cb, int k0, int lane) {
    const int hh = lane >> 5, blk = (lane >> 4) & 1, q = (lane & 15) >> 2, p = lane & 3;
    const int r0 = PERMK ? (k0 + 4 * hh + q) : (k0 + 8 * hh + q), r1 = PERMK ? (r0 + 8) : (r0 + 4);
    const int ch = 4 * cb + 2 * blk + (p >> 1);
    const s16x4 lo = trr(img + offb(r0, ch) + 8 * (p & 1)), hi = trr(img + offb(r1, ch) + 8 * (p & 1));
    return __builtin_shufflevector(lo, hi, 0, 1, 2, 3, 4, 5, 6, 7);
}
__device__ __forceinline__ bf16x8 pack_acc(const f32x16& x, int half) {
    u32x4 p;
    if (half == 0) { p.x = cvtpk(x[0], x[1]); p.y = cvtpk(x[2], x[3]); p.z = cvtpk(x[4], x[5]); p.w = cvtpk(x[6], x[7]); }
    else { p.x = cvtpk(x[8], x[9]); p.y = cvtpk(x[10], x[11]); p.z = cvtpk(x[12], x[13]); p.w = cvtpk(x[14], x[15]); }
    return __builtin_bit_cast(bf16x8, p);
}

__device__ __forceinline__ void attn_unit(Frame& F, const bf16_t* PROJ, fp8_t* BRCAT, const float* normg, int b, int h, int j, float lam, float lam_init) {
    int tid_ = F.tid; asm volatile("" : "+v"(tid_));
    const int tid = tid_, lane = tid & 63, w = F.wave, c = w >> 2, r0 = 32 * (w & 3), r32 = lane & 31, hh = lane >> 5;
    LAS unsigned char* lds = F.lds;
    unsigned rowa = offb(r32, hh), tb[4][2];
    {   const int blk = (lane >> 4) & 1, q = (lane & 15) >> 2, p = lane & 3; const unsigned tra = 32768u + offb(4 * hh + q, 2 * blk + (p >> 1)) + 8 * (p & 1);
#pragma unroll
        for (int cb = 0; cb < 4; ++cb) { tb[cb][0] = tra ^ (64u * cb); tb[cb][1] = ((tra ^ (64u * cb)) ^ 32u) + 2048u; asm volatile("" : "+v"(tb[cb][0]), "+v"(tb[cb][1])); } }
    asm volatile("" : "+v"(rowa));
    const unsigned kq = (unsigned)(c * 16384), qq = (unsigned)(65536 + w * 8192);
    unsigned ko = (unsigned)(((tid >> 4) * NPROJ + PQ_DAK + h * 256 + 8 * (tid & 15)) * 2), vo = (unsigned)(((tid >> 5) * NPROJ + PQ_DAV + h * 256 + 8 * (tid & 31)) * 2);
    unsigned kl = offb(tid >> 4, tid & 15), vl = 32768u + ((tid >> 4) & 1) * 16384u + offb(tid >> 5, tid & 15);
    asm volatile("" : "+v"(ko), "+v"(vo), "+v"(kl), "+v"(vl));
    const float c1 = 0.08838834764831845f * 1.4426950408889634f;
    __syncthreads();
    {   int ln = lane; asm volatile("" : "+v"(ln));
        const char* qp = (const char*)(PROJ + ((size_t)b * SEQ + 128 * j + r0) * NPROJ + PQ_DAQ + h * 256 + c * 128);
#pragma unroll
        for (int i = 0; i < 8; ++i) { const int id = ln + 64 * i, row = id >> 4, ch = id & 15; const u32x4 qv = *(const u32x4*)(qp + (unsigned)((row * NPROJ + 8 * ch) * 2));
            u32x4 qs; qs.x = cvtpk(bflo(qv.x) * c1, bfhi(qv.x) * c1); qs.y = cvtpk(bflo(qv.y) * c1, bfhi(qv.y) * c1); qs.z = cvtpk(bflo(qv.z) * c1, bfhi(qv.z) * c1); qs.w = cvtpk(bflo(qv.w) * c1, bfhi(qv.w) * c1);
            *(LAS u32x4*)(lds + qq + offb(row, ch)) = qs; } }
    f32x16 o[8];
#pragma unroll
    for (int eb = 0; eb < 8; ++eb)
#pragma unroll
        for (int i = 0; i < 16; ++i) o[eb][i] = 0.f;
    float mrun = 0.f, lrun = 0.f;
    const int qpos = 128 * j + r0 + r32;
    const float c2 = __builtin_amdgcn_exp2f(-2.0f * (float)(h + 1)) * 1.4426950408889634f;
    const int nt = 2 * (j + 1);
    u32x4 k1a, k2a, k1b, k2b, v0, v1, v2, v3;
#define ATT_LOAD(kt_) do { const char* kb_ = (const char*)(PROJ + ((size_t)b * SEQ + 64 * (kt_)) * NPROJ); \
        k1a = *(const u32x4*)(kb_ + ko); k2a = *(const u32x4*)(kb_ + ko + 256); k1b = *(const u32x4*)(kb_ + ko + 32 * NPROJ * 2); k2b = *(const u32x4*)(kb_ + ko + 32 * NPROJ * 2 + 256); \
        v0 = *(const u32x4*)(kb_ + vo); v1 = *(const u32x4*)(kb_ + vo + 16 * NPROJ * 2); v2 = *(const u32x4*)(kb_ + vo + 32 * NPROJ * 2); v3 = *(const u32x4*)(kb_ + vo + 48 * NPROJ * 2); } while (0)
    ATT_LOAD(0);
    for (int kt = 0; kt < nt; ++kt) {
        __syncthreads();
        *(LAS u32x4*)(lds + kl) = k1a; *(LAS u32x4*)(lds + kl + 16384) = k2a; *(LAS u32x4*)(lds + kl + 8192) = k1b; *(LAS u32x4*)(lds + kl + 8192 + 16384) = k2b;
        *(LAS u32x4*)(lds + vl) = v0; *(LAS u32x4*)(lds + vl + 4096) = v1; *(LAS u32x4*)(lds + vl + 8192) = v2; *(LAS u32x4*)(lds + vl + 12288) = v3;
        __syncthreads();
        if (kt + 1 < nt) ATT_LOAD(kt + 1);
        const int kbase = 64 * kt + 4 * hh - qpos;
        const float fkb = c2 * (float)kbase - (kt == 0 ? 0.f : mrun);
        f32x16 p0, p1;
#pragma unroll
        for (int i = 0; i < 16; ++i) { p0[i] = fmaf(c2, (float)((i & 3) + 8 * (i >> 2)), fkb); p1[i] = fmaf(c2, (float)(32 + (i & 3) + 8 * (i >> 2)), fkb); }
#pragma unroll
        for (int s = 0; s < 8; ++s) { const unsigned ra = rowa ^ (32u * s); const bf16x8 a0 = *(const LAS bf16x8*)(lds + kq + ra), a1 = *(const LAS bf16x8*)(lds + kq + ra + 8192), qv = *(const LAS bf16x8*)(lds + qq + ra);
            p0 = MFMA32(a0, qv, p0); p1 = MFMA32(a1, qv, p1); }
        if (kt >= 2 * j) {
#pragma unroll
            for (int i = 0; i < 16; ++i) { const int dk = kbase + (i & 3) + 8 * (i >> 2); if (dk > 0) p0[i] = -INFINITY; if (dk + 32 > 0) p1[i] = -INFINITY; } }
        float mx = fmaxf(p0[0], p1[0]);
#pragma unroll
        for (int i = 1; i < 16; ++i) mx = fmaxf(fmaxf(mx, p0[i]), p1[i]);
        mx = x32_max(mx);
        if (kt == 0) {
#pragma unroll
            for (int i = 0; i < 16; ++i) { p0[i] -= mx; p1[i] -= mx; }
            mrun = mx; mx = 0.f; }
        float psum = 0.f;
#pragma unroll
        for (int i = 0; i < 16; ++i) { p0[i] = __builtin_amdgcn_exp2f(p0[i]); p1[i] = __builtin_amdgcn_exp2f(p1[i]); psum += p0[i] + p1[i]; }
        lrun += psum;
        bf16x8 pf[4]; pf[0] = pack_acc(p0, 0); pf[1] = pack_acc(p0, 1); pf[2] = pack_acc(p1, 0); pf[3] = pack_acc(p1, 1);
#pragma unroll
        for (int ks = 0; ks < 4; ++ks)
#pragma unroll
            for (int eb = 0; eb < 8; ++eb) { const unsigned ab = (eb >> 2) * 16384 + ks * 4096;
                const s16x4 lo = trr(lds + tb[eb & 3][0] + ab), hi = trr(lds + tb[eb & 3][1] + ab);
                const bf16x8 va = __builtin_shufflevector(lo, hi, 0, 1, 2, 3, 4, 5, 6, 7); o[eb] = MFMA32(va, pf[ks], o[eb]); }
        const float dm = fmaxf(mx, 0.f);
        if (__builtin_amdgcn_ballot_w64(dm > 0.f) != 0ull) { const float sc = __builtin_amdgcn_exp2f(-dm);
#pragma unroll
            for (int eb = 0; eb < 8; ++eb) o[eb] = o[eb] * sc;
            lrun *= sc; mrun += dm; }
    }
#undef ATT_LOAD
    asm volatile("" : "+s"(normg), "+s"(BRCAT) :: "memory");
    const GAS float* normg_g = (const GAS float*)normg; GAS fp8_t* brcat_g = (GAS fp8_t*)BRCAT;
    const float lsum = x32_sum(lrun), inv = 1.0f / lsum;
    LAS float* XCH = (LAS float*)lds;
    int ln2 = lane; asm volatile("" : "+v"(ln2));
    const int hh2 = ln2 >> 5;
    __syncthreads();
    if (c == 1) {
        const float sc = inv * lam;
#pragma unroll
        for (int eb = 0; eb < 8; ++eb)
#pragma unroll
            for (int i = 0; i < 16; ++i) XCH[(((w & 3) * 128 + eb * 16 + i) << 6) + ln2] = o[eb][i] * sc;
    }
    __syncthreads();
    if (c == 0) {
        float ss = 0.f;
#pragma unroll
        for (int eb = 0; eb < 8; ++eb)
#pragma unroll
            for (int i = 0; i < 16; ++i) { const float v = o[eb][i] * inv - XCH[(((w & 3) * 128 + eb * 16 + i) << 6) + ln2]; o[eb][i] = v; ss += v * v; }
        ss = x32_sum(ss);
        const float rstd = (1.0f - lam_init) / sqrtf(ss * (1.0f / 256.0f) + EPS);
        GAS char* op = (GAS char*)(brcat_g + ((size_t)b * SEQ + 128 * j + r0) * 3072 + h * 256);
        const unsigned oo = (unsigned)((ln2 & 31) * 3072 + 4 * hh2);
#pragma unroll
        for (int eb = 0; eb < 8; ++eb)
#pragma unroll
            for (int g = 0; g < 4; ++g) { const int e0 = 32 * eb + 8 * g; const f32x4 gn = *(const GAS f32x4*)(normg_g + e0 + 4 * hh2);
                *(GAS unsigned*)(op + oo + e0) = pk4_fp8(o[eb][4 * g] * rstd * gn.x, o[eb][4 * g + 1] * rstd * gn.y, o[eb][4 * g + 2] * rstd * gn.z, o[eb][4 * g + 3] * rstd * gn.w); }
    }
}
__device__ __forceinline__ void phase_attn(Frame& F, const Args& a, int l) {
    const bf16_t* PROJ = (const bf16_t*)(F.ws + WS_PROJ); fp8_t* BRCAT = (fp8_t*)(F.ws + WS_BRCAT);
    const float* lp = a.in[2] + (size_t)l * 4 * 128; const float* normg = a.in[3] + (size_t)l * 256;
    const float s01 = wave_sum(lp[F.lane] * lp[128 + F.lane] + lp[64 + F.lane] * lp[192 + F.lane]);
    const float s23 = wave_sum(lp[256 + F.lane] * lp[384 + F.lane] + lp[320 + F.lane] * lp[448 + F.lane]);
    const float lam_init = 0.8f - 0.6f * expf(-0.3f * (float)l);
    const float lam = __builtin_bit_cast(float, __builtin_amdgcn_readfirstlane(__builtin_bit_cast(int, expf(s01) - expf(s23) + lam_init)));
    volatile LAS unsigned* qslot = (volatile LAS unsigned*)(F.lds + MISC_OFF + 128);
    for (;;) {
        __syncthreads();
        if (F.tid == 0) *qslot = __hip_atomic_fetch_add((unsigned*)(F.ws + WS_CTL) + CW_ATTQ + 64 * l, 1u, __ATOMIC_RELAXED, __HIP_MEMORY_SCOPE_AGENT);
        __syncthreads();
        const int k = __builtin_amdgcn_readfirstlane((int)*qslot);
        if (k >= 512) break;
        const int bh = k & 15, b = bh >> 2, h = bh & 3;
        attn_unit(F, PROJ, BRCAT, normg, b, h, 31 - (k >> 4), lam, lam_init);
    }
}


__device__ __forceinline__ void gla_gates(Frame& F, const float* SMALL, const float* w2, const float* b2, int h, size_t t0, float (&bc)[16], float& btot) {
    LAS float* LR = (LAS float*)F.lds; LAS float* GT = (LAS float*)(F.lds + 4096);
    const int tid = F.tid, d = tid & 127, g4 = tid >> 7;
#pragma unroll
    for (int i = 0; i < 2; ++i) { const int id = tid + 512 * i, pos = id >> 4, r = id & 15; LR[id] = SMALL[(t0 + pos) * 32 + r]; }
    float wv[16];
#pragma unroll
    for (int r = 0; r < 16; ++r) wv[r] = w2[r * 512 + h * 128 + d];
    const float bb = b2[h * 128 + d];
    __syncthreads();
    float run = 0.f;
#pragma unroll
    for (int i = 0; i < 16; ++i) { const int pos = 16 * g4 + i; float z = bb;
#pragma unroll
        for (int r4 = 0; r4 < 4; ++r4) { const f32x4 lv = *(const LAS f32x4*)(LR + pos * 16 + 4 * r4); z += lv.x * wv[4 * r4] + lv.y * wv[4 * r4 + 1] + lv.z * wv[4 * r4 + 2] + lv.w * wv[4 * r4 + 3]; }
        const float ls = fminf(z, 0.f) - fast_log(1.0f + fast_exp(-fabsf(z)));
        run += ls * (1.0f / 16.0f); bc[i] = run; }
    GT[g4 * 128 + d] = run;
    __syncthreads();
    float pre = 0.f, tot = 0.f;
#pragma unroll
    for (int q = 0; q < 4; ++q) { const float v = GT[q * 128 + d]; tot += v; pre += (q < g4) ? v : 0.f; }
#pragma unroll
    for (int i = 0; i < 16; ++i) bc[i] += pre;
    btot = tot;
}
__device__ __forceinline__ void gla_stage_v(Frame& F, const bf16_t* PROJ, int h, size_t t0, int voff) {
#pragma unroll
    for (int i = 0; i < 4; ++i) { const int cid = F.tid + 512 * i, row = cid >> 5, c32 = cid & 31;
        const u32x4 v = *(const u32x4*)(PROJ + (t0 + row) * NPROJ + PQ_GV + h * 256 + 8 * c32);
        *(LAS u32x4*)(F.lds + voff + (c32 >> 4) * 16384 + offb(row, c32 & 15)) = v; }
}
__device__ __forceinline__ void gla_stage128(Frame& F, const bf16_t* PROJ, int col0, size_t t0, int off) {
#pragma unroll
    for (int i = 0; i < 2; ++i) { const int cid = F.tid + 512 * i, row = cid >> 4, ch = cid & 15;
        *(LAS u32x4*)(F.lds + off + offb(row, ch)) = *(const u32x4*)(PROJ + (t0 + row) * NPROJ + col0 + 8 * ch); }
}
__device__ __forceinline__ void phase_gla_local(Frame& F, const Args& a, int l) {
    const bf16_t* PROJ = (const bf16_t*)(F.ws + WS_PROJ); const float* SMALL = (const float*)(F.ws + WS_SMALL);
    bf16_t* UPDT = (bf16_t*)(F.ws + WS_UPDT); float* GDEC = (float*)(F.ws + WS_GDEC);
    const float* w2 = a.in[4] + (size_t)l * 16 * 512; const float* b2 = a.in[5] + (size_t)l * 512;
    const int w = F.wave;
    constexpr int KDT = 8192, VOFF = 40960, KRAW = 73728;
    u32x4 pk[2], pv[4];
    auto ldkv = [&](int uu) { const int bh2 = uu >> 6, n2 = uu & 63, b2i = bh2 >> 2, h2 = bh2 & 3; const size_t tt = (size_t)b2i * SEQ + 64 * n2;
#pragma unroll
        for (int i = 0; i < 2; ++i) { const int cid = F.tid + 512 * i, row = cid >> 4, ch = cid & 15; pk[i] = *(const u32x4*)(PROJ + (tt + row) * NPROJ + PQ_GK + h2 * 128 + 8 * ch); }
#pragma unroll
        for (int i = 0; i < 4; ++i) { const int cid = F.tid + 512 * i, row = cid >> 5, c32 = cid & 31; pv[i] = *(const u32x4*)(PROJ + (tt + row) * NPROJ + PQ_GV + h2 * 256 + 8 * c32); } };
    if (F.bid < 1024) ldkv(F.bid);
    for (int u = F.bid; u < 1024; u += F.G) {
        const int bh = u >> 6, n = u & 63, b = bh >> 2, h = bh & 3; const size_t t0 = (size_t)b * SEQ + 64 * n;
        int tid_ = F.tid; asm volatile("" : "+v"(tid_));
        const int tid = tid_, lane = tid & 63, d = tid & 127, g4 = tid >> 7, r32 = lane & 31, hh = lane >> 5;
        __syncthreads();
        float bc[16], btot;
#pragma unroll
        for (int i = 0; i < 2; ++i) { const int cid = F.tid + 512 * i, row = cid >> 4, ch = cid & 15; *(LAS u32x4*)(F.lds + KRAW + offb(row, ch)) = pk[i]; }
#pragma unroll
        for (int i = 0; i < 4; ++i) { const int cid = F.tid + 512 * i, row = cid >> 5, c32 = cid & 31; *(LAS u32x4*)(F.lds + VOFF + (c32 >> 4) * 16384 + offb(row, c32 & 15)) = pv[i]; }
        gla_gates(F, SMALL, w2, b2, h, t0, bc, btot);
        { const int un = u + F.G; ldkv(un < 1024 ? un : u); }
        {   float kd[16];
#pragma unroll
            for (int i = 0; i < 16; ++i) kd[i] = bf2f(*(const LAS unsigned short*)(F.lds + KRAW + offb(16 * g4 + i, d >> 3) + 2 * (d & 7))) * fast_exp(btot - bc[i]);
            u32x4 w0, w1; w0.x = cvtpk(kd[0], kd[1]); w0.y = cvtpk(kd[2], kd[3]); w0.z = cvtpk(kd[4], kd[5]); w0.w = cvtpk(kd[6], kd[7]);
            w1.x = cvtpk(kd[8], kd[9]); w1.y = cvtpk(kd[10], kd[11]); w1.z = cvtpk(kd[12], kd[13]); w1.w = cvtpk(kd[14], kd[15]);
            *(LAS u32x4*)(F.lds + KDT + offb(d, 2 * g4)) = w0; *(LAS u32x4*)(F.lds + KDT + offb(d, 2 * g4 + 1)) = w1;
            if (g4 == 0) GDEC[((size_t)bh * 64 + n) * 128 + d] = fast_exp(btot);
        }
        __syncthreads();
        f32x16 acc[4];
#pragma unroll
        for (int db = 0; db < 4; ++db)
#pragma unroll
            for (int i = 0; i < 16; ++i) acc[db][i] = 0.f;
#pragma unroll
        for (int s = 0; s < 4; ++s) { const bf16x8 va = frag_tr<false>(F.lds + VOFF + (w >> 2) * 16384, w & 3, 16 * s, lane);
#pragma unroll
            for (int db = 0; db < 4; ++db) { const bf16x8 kb = frag_row(F.lds + KDT, 32 * db, s, lane); acc[db] = MFMA32(va, kb, acc[db]); } }
        bf16_t* up = UPDT + ((size_t)bh * 64 + n) * 256 * 128;
#pragma unroll
        for (int db = 0; db < 4; ++db)
#pragma unroll
            for (int i = 0; i < 16; ++i) up[(size_t)(32 * w + crow(i, hh)) * 128 + 32 * db + r32] = (bf16_t)(cvtpk(acc[db][i], 0.f) & 0xffffu);
    }
}
__device__ __forceinline__ void phase_gla_scan(Frame& F) {
    const bf16_t* UPDT = (const bf16_t*)(F.ws + WS_UPDT); const float* GDEC = (const float*)(F.ws + WS_GDEC); bf16_t* SPT = (bf16_t*)(F.ws + WS_SPREVT);
    for (int idx = F.bid * NTHR + F.tid; idx < 16 * 256 * 32; idx += F.G * NTHR) {
        const int bh = idx >> 13, e = (idx >> 5) & 255, d4 = idx & 31;
        f32x4 st = {0.f, 0.f, 0.f, 0.f};
        const size_t base = ((size_t)bh * 64) * 256 * 128 + (size_t)e * 128 + 4 * d4;
#pragma unroll 8
        for (int n = 0; n < 64; ++n) {
            const u32x2 up2 = *(const u32x2*)(UPDT + base + (size_t)n * 256 * 128); const f32x4 uu = {bflo(up2.x), bfhi(up2.x), bflo(up2.y), bfhi(up2.y)}; const f32x4 dc = *(const f32x4*)(GDEC + ((size_t)bh * 64 + n) * 128 + 4 * d4);
            u32x2 o; o.x = cvtpk(st.x, st.y); o.y = cvtpk(st.z, st.w); *(u32x2*)(SPT + base + (size_t)n * 256 * 128) = o;
            st = dc * st + uu; }
    }
}
__device__ __forceinline__ void phase_gla_out(Frame& F, const Args& a, int l) {
    const bf16_t* PROJ = (const bf16_t*)(F.ws + WS_PROJ); const float* SMALL = (const float*)(F.ws + WS_SMALL); const bf16_t* SPT = (const bf16_t*)(F.ws + WS_SPREVT);
    fp8_t* BRCAT = (fp8_t*)(F.ws + WS_BRCAT);
    const float* w2 = a.in[4] + (size_t)l * 16 * 512; const float* b2 = a.in[5] + (size_t)l * 512; const float* normg = a.in[6] + (size_t)l * 256;
    const int w = F.wave;
    constexpr int SSO = 6144, QE = 8192, KE = 24576, VOFF = 40960;
    LAS float* SS = (LAS float*)(F.lds + SSO);
    u32x4 pq[2], pk[2], pv[4];
    auto ldqkv = [&](int uu) { const int bh2 = uu >> 6, n2 = uu & 63, bi2 = bh2 >> 2, h2 = bh2 & 3; const size_t tt = (size_t)bi2 * SEQ + 64 * n2;
#pragma unroll
        for (int i = 0; i < 2; ++i) { const int cid = F.tid + 512 * i, row = cid >> 4, ch = cid & 15; pq[i] = *(const u32x4*)(PROJ + (tt + row) * NPROJ + PQ_GQ + h2 * 128 + 8 * ch); pk[i] = *(const u32x4*)(PROJ + (tt + row) * NPROJ + PQ_GK + h2 * 128 + 8 * ch); }
#pragma unroll
        for (int i = 0; i < 4; ++i) { const int cid = F.tid + 512 * i, row = cid >> 5, c32 = cid & 31; pv[i] = *(const u32x4*)(PROJ + (tt + row) * NPROJ + PQ_GV + h2 * 256 + 8 * c32); } };
    if (F.bid < 1024) ldqkv(F.bid);
    for (int u = F.bid; u < 1024; u += F.G) {
        const int bh = u >> 6, n = u & 63, b = bh >> 2, h = bh & 3; const size_t t0 = (size_t)b * SEQ + 64 * n;
        int tid_ = F.tid; asm volatile("" : "+v"(tid_));
        const int tid = tid_, lane = tid & 63, d = tid & 127, g4 = tid >> 7, r32 = lane & 31, hh = lane >> 5;
        bf16x8 spf[8]; u32x2 rvp[2][4];
        {   const bf16_t* sp = SPT + (((size_t)bh * 64 + n) * 256 + 32 * w + r32) * 128 + 8 * hh;
#pragma unroll
            for (int ks = 0; ks < 8; ++ks) spf[ks] = *(const bf16x8*)(sp + 16 * ks);
#pragma unroll
            for (int qb = 0; qb < 2; ++qb)
#pragma unroll
                for (int g = 0; g < 4; ++g) rvp[qb][g] = *(const u32x2*)(PROJ + (t0 + 32 * qb + r32) * NPROJ + PQ_GR + h * 256 + 32 * w + 8 * g + 4 * hh); }
        __syncthreads();
        float bc[16], btot;
#pragma unroll
        for (int i = 0; i < 2; ++i) { const int cid = F.tid + 512 * i, row = cid >> 4, ch = cid & 15; *(LAS u32x4*)(F.lds + QE + offb(row, ch)) = pq[i]; *(LAS u32x4*)(F.lds + KE + offb(row, ch)) = pk[i]; }
#pragma unroll
        for (int i = 0; i < 4; ++i) { const int cid = F.tid + 512 * i, row = cid >> 5, c32 = cid & 31; *(LAS u32x4*)(F.lds + VOFF + (c32 >> 4) * 16384 + offb(row, c32 & 15)) = pv[i]; }
        gla_gates(F, SMALL, w2, b2, h, t0, bc, btot);
#pragma unroll
        for (int i = 0; i < 16; ++i) { const int pos = 16 * g4 + i; const float eb = fast_exp(bc[i]), reb = __builtin_amdgcn_rcpf(eb);
            LAS unsigned short* qa = (LAS unsigned short*)(F.lds + QE + offb(pos, d >> 3) + 2 * (d & 7)); LAS unsigned short* ka = (LAS unsigned short*)(F.lds + KE + offb(pos, d >> 3) + 2 * (d & 7));
            const float qv = bf2f(*qa) * 0.08838834764831845f * eb, kv = bf2f(*ka) * reb;
            *qa = f2bf(qv); *ka = f2bf(kv); }
        __syncthreads();
        f32x16 att[2][2];
#pragma unroll
        for (int sb = 0; sb < 2; ++sb)
#pragma unroll
            for (int qb = 0; qb < 2; ++qb)
#pragma unroll
                for (int i = 0; i < 16; ++i) att[sb][qb][i] = 0.f;
#pragma unroll
        for (int ks = 0; ks < 8; ++ks) { const bf16x8 k0 = frag_row(F.lds + KE, 0, ks, lane), k1 = frag_row(F.lds + KE, 32, ks, lane), q0 = frag_row(F.lds + QE, 0, ks, lane), q1 = frag_row(F.lds + QE, 32, ks, lane);
            att[0][0] = MFMA32(k0, q0, att[0][0]); att[0][1] = MFMA32(k0, q1, att[0][1]); att[1][0] = MFMA32(k1, q0, att[1][0]); att[1][1] = MFMA32(k1, q1, att[1][1]); }
#pragma unroll
        for (int sb = 0; sb < 2; ++sb)
#pragma unroll
            for (int qb = 0; qb < 2; ++qb)
#pragma unroll
                for (int i = 0; i < 16; ++i) { const int sp = 32 * sb + crow(i, hh), qp = 32 * qb + r32; if (sp > qp) att[sb][qb][i] = 0.f; }
        f32x16 o[2];
#pragma unroll
        for (int qb = 0; qb < 2; ++qb)
#pragma unroll
            for (int i = 0; i < 16; ++i) o[qb][i] = 0.f;
#pragma unroll
        for (int ks = 0; ks < 4; ++ks) { const bf16x8 va = frag_tr<true>(F.lds + VOFF + (w >> 2) * 16384, w & 3, 16 * ks, lane);
#pragma unroll
            for (int qb = 0; qb < 2; ++qb) { const bf16x8 pf = pack_acc(att[ks >> 1][qb], ks & 1); o[qb] = MFMA32(va, pf, o[qb]); } }
#pragma unroll
        for (int ks = 0; ks < 8; ++ks) {
#pragma unroll
            for (int qb = 0; qb < 2; ++qb) { const bf16x8 qf = frag_row(F.lds + QE, 32 * qb, ks, lane); o[qb] = MFMA32(spf[ks], qf, o[qb]); } }
        f32x4 gnv[4];
#pragma unroll
        for (int g = 0; g < 4; ++g) gnv[g] = *(const f32x4*)(normg + 32 * w + 8 * g + 4 * hh);
        { const int un = u + F.G; ldqkv(un < 1024 ? un : u); }
#pragma unroll
        for (int qb = 0; qb < 2; ++qb) { float ss = 0.f;
#pragma unroll
            for (int i = 0; i < 16; ++i) ss += o[qb][i] * o[qb][i];
            ss = x32_sum(ss);
            if (hh == 0) SS[w * 64 + 32 * qb + r32] = ss; }
        __syncthreads();
#pragma unroll
        for (int qb = 0; qb < 2; ++qb) { float tot = 0.f;
#pragma unroll
            for (int q = 0; q < 8; ++q) tot += SS[q * 64 + 32 * qb + r32];
            const float rstd = __builtin_amdgcn_rsqf(tot * (1.0f / 256.0f) + EPS);
            const size_t t = t0 + 32 * qb + r32;
#pragma unroll
            for (int g = 0; g < 4; ++g) { const int e0 = 32 * w + 8 * g + 4 * hh; const f32x4 gn = gnv[g];
                const u32x2 rv = rvp[qb][g];
                const float y0 = o[qb][4 * g] * rstd * gn.x * siluf_(bflo(rv.x)), y1 = o[qb][4 * g + 1] * rstd * gn.y * siluf_(bfhi(rv.x));
                const float y2 = o[qb][4 * g + 2] * rstd * gn.z * siluf_(bflo(rv.y)), y3 = o[qb][4 * g + 3] * rstd * gn.w * siluf_(bfhi(rv.y));
                *(unsigned*)(BRCAT + t * 3072 + 1024 + h * 256 + e0) = pk4_fp8(y0, y1, y2, y3); } }
    }
}

constexpr int SD_DT = 0, SD_ACS = 2048, SD_WT = 4096, SD_SSX = 4352, SD_XT = 8192, SD_BT = 73728, SD_CT = 106496;
__device__ __forceinline__ void ssd_tables(Frame& F, const Args& a, int l, const float* SMALL, int g, size_t t0, int tid) {
    LAS float* DT = (LAS float*)(F.lds + SD_DT); LAS float* ACS = (LAS float*)(F.lds + SD_ACS); LAS float* WT = (LAS float*)(F.lds + SD_WT);
    const int lane = tid & 63, hq = tid >> 7, pos = tid & 127, hd = 4 * g + hq;
    const float raw = SMALL[(t0 + pos) * 32 + 16 + hd] + a.in[9][l * 16 + hd];
    const float dt = raw > 20.f ? raw : logf(1.0f + expf(raw));
    const float A = -expf(a.in[10][l * 16 + hd]);
    float incl = wave_scan_f(dt * A, lane);
    if (lane == 63) WT[F.wave] = incl;
    __syncthreads();
    if (F.wave & 1) incl += WT[F.wave - 1];
    DT[hq * 128 + pos] = dt; ACS[hq * 128 + pos] = incl;
    __syncthreads();
}
struct SsdRows { u32x4 r[19]; };
template <int MODE> __device__ __forceinline__ void ssd_conv_load(SsdRows& R, const bf16_t* PROJ, int g, int n, size_t t0, int tid) {
    const int cg = tid & 63, seg = tid >> 6, pos0 = 16 * seg;
    const int cc0 = cg < 32 ? g * 256 + 8 * cg : (cg < 48 ? 1024 + g * 128 + 8 * (cg - 32) : 1536 + g * 128 + 8 * (cg - 48));
    const bf16_t* src = PROJ + (t0 + pos0) * NPROJ + PQ_SX + cc0;
    const bool havehalo = (n > 0) || (seg > 0);
#pragma unroll
    for (int p = 0; p < 19; ++p) { if ((p >= 3 || havehalo) && !(MODE == 0 && cg >= 48)) R.r[p] = *(const u32x4*)(src + (ptrdiff_t)(p - 3) * NPROJ); else R.r[p] = (u32x4){0u, 0u, 0u, 0u}; }
}
template <int MODE> __device__ __forceinline__ void ssd_conv(Frame& F, const Args& a, int l, const SsdRows& R, int g, int tid) {
    const LAS float* DT = (const LAS float*)(F.lds + SD_DT); const LAS float* ACS = (const LAS float*)(F.lds + SD_ACS);
    const int cg = tid & 63, seg = tid >> 6, pos0 = 16 * seg;
    if (MODE == 0 && cg >= 48) return;
    int cc0, row0; LAS unsigned char* img;
    if (cg < 32) { cc0 = g * 256 + 8 * cg; img = F.lds + SD_XT; row0 = 8 * cg; }
    else if (cg < 48) { cc0 = 1024 + g * 128 + 8 * (cg - 32); img = F.lds + SD_BT; row0 = 8 * (cg - 32); }
    else { cc0 = 1536 + g * 128 + 8 * (cg - 48); img = F.lds + SD_CT; row0 = 8 * (cg - 48); }
    const float* cw = a.in[7] + (size_t)l * 4 * 2048 + cc0; const float* cbp = a.in[8] + (size_t)l * 2048 + cc0;
    float wt[4][8], cb[8];
#pragma unroll
    for (int j = 0; j < 4; ++j) { const f32x4 w0 = *(const f32x4*)(cw + 2048 * j), w1 = *(const f32x4*)(cw + 2048 * j + 4); wt[j][0] = w0.x; wt[j][1] = w0.y; wt[j][2] = w0.z; wt[j][3] = w0.w; wt[j][4] = w1.x; wt[j][5] = w1.y; wt[j][6] = w1.z; wt[j][7] = w1.w; }
    {   const f32x4 b0 = *(const f32x4*)cbp, b1 = *(const f32x4*)(cbp + 4); cb[0] = b0.x; cb[1] = b0.y; cb[2] = b0.z; cb[3] = b0.w; cb[4] = b1.x; cb[5] = b1.y; cb[6] = b1.z; cb[7] = b1.w; }
    const int hq = cg >> 3;
    const float alast = (MODE == 0 && cg < 32) ? ACS[hq * 128 + 127] : 0.f;
    float sc[16];
#pragma unroll
    for (int p = 0; p < 16; ++p) { sc[p] = 1.0f; if (cg < 32) { sc[p] = DT[hq * 128 + pos0 + p]; if (MODE == 0) sc[p] *= fast_exp(alast - ACS[hq * 128 + pos0 + p]); } }
#pragma unroll
    for (int c = 0; c < 8; ++c) {
        float y[16];
#pragma unroll
        for (int p = 0; p < 16; ++p) { float v = cb[c];
#pragma unroll
            for (int j = 0; j < 4; ++j) { const unsigned wv = R.r[p + j][c >> 1]; v += wt[j][c] * ((c & 1) ? bfhi(wv) : bflo(wv)); }
            y[p] = siluf_(v) * sc[p]; }
        u32x4 o0, o1; o0.x = cvtpk(y[0], y[1]); o0.y = cvtpk(y[2], y[3]); o0.z = cvtpk(y[4], y[5]); o0.w = cvtpk(y[6], y[7]);
        o1.x = cvtpk(y[8], y[9]); o1.y = cvtpk(y[10], y[11]); o1.z = cvtpk(y[12], y[13]); o1.w = cvtpk(y[14], y[15]);
        *(LAS u32x4*)(img + offb(row0 + c, 2 * seg)) = o0; *(LAS u32x4*)(img + offb(row0 + c, 2 * seg + 1)) = o1; }
}
__device__ __forceinline__ void phase_ssd_local(Frame& F, const Args& a, int l) {
    const bf16_t* PROJ = (const bf16_t*)(F.ws + WS_PROJ); const float* SMALL = (const float*)(F.ws + WS_SMALL);
    bf16_t* STATES = (bf16_t*)(F.ws + WS_STATES); float* ALAST = (float*)(F.ws + WS_ALAST);
    const int w = F.wave;
    SsdRows R;
    if (F.bid < 512) { const int u0 = F.bid; ssd_conv_load<0>(R, PROJ, u0 & 3, (u0 >> 2) & 31, (size_t)(u0 >> 7) * SEQ + 128 * ((u0 >> 2) & 31), F.tid); }
    for (int u = F.bid; u < 512; u += F.G) {
        const int b = u >> 7, n = (u >> 2) & 31, g = u & 3; const size_t t0 = (size_t)b * SEQ + 128 * n;
        int tid_ = F.tid; asm volatile("" : "+v"(tid_));
        __syncthreads();
        ssd_tables(F, a, l, SMALL, g, t0, tid_);
        ssd_conv<0>(F, a, l, R, g, tid_);
        { const int un = (u + F.G < 512) ? u + F.G : u; ssd_conv_load<0>(R, PROJ, un & 3, (un >> 2) & 31, (size_t)(un >> 7) * SEQ + 128 * ((un >> 2) & 31), tid_); }
        if (F.tid < 4) ALAST[((size_t)b * 32 + n) * 16 + 4 * g + F.tid] = ((const LAS float*)(F.lds + SD_ACS))[F.tid * 128 + 127];
        __syncthreads();
        int ln = F.lane; asm volatile("" : "+v"(ln));
        const int lane = ln, r32 = lane & 31, hh = lane >> 5;
        const int hd = w >> 1, pb = w & 1;
        f32x16 acc[4];
#pragma unroll
        for (int sb = 0; sb < 4; ++sb)
#pragma unroll
            for (int i = 0; i < 16; ++i) acc[sb][i] = 0.f;
#pragma unroll
        for (int ks = 0; ks < 8; ++ks) { const bf16x8 xa = frag_row(F.lds + SD_XT, 64 * hd + 32 * pb, ks, lane);
#pragma unroll
            for (int sb = 0; sb < 4; ++sb) { const bf16x8 bb = frag_row(F.lds + SD_BT, 32 * sb, ks, lane); acc[sb] = MFMA32(xa, bb, acc[sb]); } }
        bf16_t* sp = STATES + ((((size_t)b * 32 + n) * 16 + 4 * g + hd) * 64) * 128;
#pragma unroll
        for (int sb = 0; sb < 4; ++sb)
#pragma unroll
            for (int i = 0; i < 16; ++i) sp[(size_t)(32 * pb + crow(i, hh)) * 128 + 32 * sb + r32] = (bf16_t)(cvtpk(acc[sb][i], 0.f) & 0xffffu);
    }
}
__device__ __forceinline__ void phase_ssd_scan(Frame& F) {
    const bf16_t* STATES = (const bf16_t*)(F.ws + WS_STATES); const float* ALAST = (const float*)(F.ws + WS_ALAST); bf16_t* SPV = (bf16_t*)(F.ws + WS_SPREV);
    for (int idx = F.bid * NTHR + F.tid; idx < 4 * 16 * 64 * 32; idx += F.G * NTHR) {
        const int b = idx >> 15, hd = (idx >> 11) & 15, ps = idx & 2047;
        f32x4 st = {0.f, 0.f, 0.f, 0.f};
#pragma unroll 8
        for (int n = 0; n < 32; ++n) { const size_t off = ((((size_t)b * 32 + n) * 16 + hd) * 64) * 128 + 4 * ps;
            const u32x2 up2 = *(const u32x2*)(STATES + off); const f32x4 uu = {bflo(up2.x), bfhi(up2.x), bflo(up2.y), bfhi(up2.y)}; const float dc = fast_exp(ALAST[((size_t)b * 32 + n) * 16 + hd]);
            u32x2 o; o.x = cvtpk(st.x, st.y); o.y = cvtpk(st.z, st.w); *(u32x2*)(SPV + off) = o;
            st = st * dc + uu; }
    }
}
__device__ __forceinline__ void phase_ssd_out(Frame& F, const Args& a, int l) {
    const bf16_t* PROJ = (const bf16_t*)(F.ws + WS_PROJ); const float* SMALL = (const float*)(F.ws + WS_SMALL); const bf16_t* SPV = (const bf16_t*)(F.ws + WS_SPREV);
    fp8_t* BRCAT = (fp8_t*)(F.ws + WS_BRCAT);
    const float* normg = a.in[12] + (size_t)l * 1024;
    const int w = F.wave, lb = w & 3, hp = w >> 2;
    const LAS float* DT = (const LAS float*)(F.lds + SD_DT); const LAS float* ACS = (const LAS float*)(F.lds + SD_ACS); LAS float* SSX = (LAS float*)(F.lds + SD_SSX);
    for (int u = F.bid; u < 512; u += F.G) {
        const int b = u >> 7, n = (u >> 2) & 31, g = u & 3; const size_t t0 = (size_t)b * SEQ + 128 * n;
        int tid_ = F.tid; asm volatile("" : "+v"(tid_));
        SsdRows R; ssd_conv_load<1>(R, PROJ, g, n, t0, tid_);
        __syncthreads();
        ssd_tables(F, a, l, SMALL, g, t0, tid_);
        ssd_conv<1>(F, a, l, R, g, tid_);
        __syncthreads();
        int ln = F.lane; asm volatile("" : "+v"(ln));
        const int lane = ln, r32 = lane & 31, hh = lane >> 5, lpos = 32 * lb + r32;
        f32x16 y[2][2];
#pragma unroll
        for (int hi = 0; hi < 2; ++hi)
#pragma unroll
            for (int pb = 0; pb < 2; ++pb)
#pragma unroll
                for (int i = 0; i < 16; ++i) y[hi][pb][i] = 0.f;
        {   const bf16_t* sp0 = SPV + (((((size_t)b * 32 + n) * 16 + 4 * g + 2 * hp) * 64) + r32) * 128 + 8 * hh;
#pragma unroll
            for (int ks = 0; ks < 8; ++ks) { const bf16x8 cf = frag_tr<false>(F.lds + SD_CT, lb, 16 * ks, lane);
#pragma unroll
                for (int hi = 0; hi < 2; ++hi)
#pragma unroll
                    for (int pb = 0; pb < 2; ++pb) { const bf16x8 sa = *(const bf16x8*)(sp0 + (size_t)(hi * 64 + 32 * pb) * 128 + 16 * ks); y[hi][pb] = MFMA32(sa, cf, y[hi][pb]); } }
        }
        float acl[2];
#pragma unroll
        for (int hi = 0; hi < 2; ++hi) { acl[hi] = ACS[(2 * hp + hi) * 128 + lpos]; const float ea = fast_exp(acl[hi]);
#pragma unroll
            for (int pb = 0; pb < 2; ++pb)
#pragma unroll
                for (int i = 0; i < 16; ++i) y[hi][pb][i] *= ea; }
#pragma unroll 1
        for (int mb = 0; mb <= lb; ++mb) {
            f32x16 cbt;
#pragma unroll
            for (int i = 0; i < 16; ++i) cbt[i] = 0.f;
#pragma unroll
            for (int ks = 0; ks < 8; ++ks) { const bf16x8 bf = frag_tr<false>(F.lds + SD_BT, mb, 16 * ks, lane), cf = frag_tr<false>(F.lds + SD_CT, lb, 16 * ks, lane); cbt = MFMA32(bf, cf, cbt); }
#pragma unroll
            for (int hi = 0; hi < 2; ++hi) { const int hq = 2 * hp + hi;
                f32x16 mt;
#pragma unroll
                for (int i = 0; i < 16; ++i) { const int m = 32 * mb + crow(i, hh); const float am = ACS[hq * 128 + m]; mt[i] = (m <= lpos) ? cbt[i] * fast_exp(acl[hi] - am) : 0.f; }
#pragma unroll
                for (int half = 0; half < 2; ++half) { const bf16x8 mf = pack_acc(mt, half);
                    const int ksx = 2 * mb + half;
#pragma unroll
                    for (int pb = 0; pb < 2; ++pb) { const int row = 64 * hq + 32 * pb + r32;
                        const s16x4 lo = *(const LAS s16x4*)(F.lds + SD_XT + offb(row, 2 * ksx) + 8 * hh), hi4 = *(const LAS s16x4*)(F.lds + SD_XT + offb(row, 2 * ksx + 1) + 8 * hh);
                        const bf16x8 xa = __builtin_shufflevector(lo, hi4, 0, 1, 2, 3, 4, 5, 6, 7);
                        y[hi][pb] = MFMA32(xa, mf, y[hi][pb]); } } }
        }
        float ssq = 0.f;
#pragma unroll
        for (int hi = 0; hi < 2; ++hi) { const int hq = 2 * hp + hi, hd = 4 * g + hq;
            const float dsk = a.in[11][l * 16 + hd] * __builtin_amdgcn_rcpf(DT[hq * 128 + lpos]);
#pragma unroll
            for (int pb = 0; pb < 2; ++pb)
#pragma unroll
                for (int gq = 0; gq < 4; ++gq) { const int p0 = 32 * pb + 8 * gq + 4 * hh;
                    const u32x2 zv = *(const u32x2*)(PROJ + (t0 + lpos) * NPROJ + PQ_SZ + hd * 64 + p0);
                    const float zz[4] = {bflo(zv.x), bfhi(zv.x), bflo(zv.y), bfhi(zv.y)};
#pragma unroll
                    for (int jj = 0; jj < 4; ++jj) { const int row = 64 * hq + p0 + jj;
                        const float xd = bf2f(*(const LAS unsigned short*)(F.lds + SD_XT + offb(row, lpos >> 3) + 2 * (lpos & 7)));
                        float v = y[hi][pb][4 * gq + jj] + xd * dsk; v *= siluf_(zz[jj]); y[hi][pb][4 * gq + jj] = v; ssq += v * v; } }
        }
        ssq = x32_sum(ssq);
        if (hh == 0) SSX[(hp * 4 + lb) * 32 + r32] = ssq;
        __syncthreads();
        const float rstd = __builtin_amdgcn_rsqf((SSX[lb * 32 + r32] + SSX[(4 + lb) * 32 + r32]) * (1.0f / 256.0f) + EPS);
#pragma unroll
        for (int hi = 0; hi < 2; ++hi) { const int hq = 2 * hp + hi;
#pragma unroll
            for (int pb = 0; pb < 2; ++pb)
#pragma unroll
                for (int gq = 0; gq < 4; ++gq) { const int p0 = 32 * pb + 8 * gq + 4 * hh, ch = g * 256 + hq * 64 + p0; const f32x4 gn = *(const f32x4*)(normg + ch);
                    *(unsigned*)(BRCAT + (t0 + lpos) * 3072 + 2048 + ch) = pk4_fp8(y[hi][pb][4 * gq] * rstd * gn.x, y[hi][pb][4 * gq + 1] * rstd * gn.y, y[hi][pb][4 * gq + 2] * rstd * gn.z, y[hi][pb][4 * gq + 3] * rstd * gn.w); } }
    }
}

__device__ __forceinline__ void phase_small(Frame& F, const bf16_t* xsb) {
    const bf16_t* SM = (const bf16_t*)(F.ws + WS_SM); float* SMALL = (float*)(F.ws + WS_SMALL);
    const int li = F.lane & 15, lq = F.lane >> 4, w = F.wave, kh = w >> 2;
    LAS float* red = (LAS float*)F.lds;
    for (int tb = F.bid; tb < T / 64; tb += F.G) {
        const int task = 4 * tb + (w & 3);
        const bf16_t* w0 = SM + (size_t)li * D + 1024 * kh + 8 * lq; const bf16_t* w1 = SM + (size_t)(16 + li) * D + 1024 * kh + 8 * lq; const bf16_t* xp = xsb + (size_t)(task * 16 + li) * D + 1024 * kh + 8 * lq;
        f32x4 c0 = {0.f, 0.f, 0.f, 0.f}, c1 = {0.f, 0.f, 0.f, 0.f};
#pragma unroll 8
        for (int ks = 0; ks < 32; ++ks) { const bf16x8 av = *(const bf16x8*)(xp + 32 * ks), b0 = *(const bf16x8*)(w0 + 32 * ks), b1 = *(const bf16x8*)(w1 + 32 * ks);
            c0 = __builtin_amdgcn_mfma_f32_16x16x32_bf16(av, b0, c0, 0, 0, 0); c1 = __builtin_amdgcn_mfma_f32_16x16x32_bf16(av, b1, c1, 0, 0, 0); }
        __syncthreads();
        if (kh == 1) { *(LAS f32x4*)(red + ((w & 3) * 64 + F.lane) * 8) = c0; *(LAS f32x4*)(red + ((w & 3) * 64 + F.lane) * 8 + 4) = c1; }
        __syncthreads();
        if (kh == 0) { c0 += *(const LAS f32x4*)(red + (w * 64 + F.lane) * 8); c1 += *(const LAS f32x4*)(red + (w * 64 + F.lane) * 8 + 4);
#pragma unroll
            for (int r = 0; r < 4; ++r) { SMALL[(size_t)(task * 16 + 4 * lq + r) * 32 + li] = c0[r]; SMALL[(size_t)(task * 16 + 4 * lq + r) * 32 + 16 + li] = c1[r]; } }
    }
    __syncthreads();
}

constexpr int PPL = 13, NPH = PPL * DEPTH;
constexpr int NCVT = 96;
#ifndef CV_DEFER
#define CV_DEFER 49920
#endif
#ifndef MK_ONE_LAUNCH
#define MK_ONE_LAUNCH 1
#endif
#ifndef PH_MASK
#define PH_MASK 0x1fff
#endif
#ifndef REP_MASK
#define REP_MASK 0
#endif
#ifndef REP_SUB
#define REP_SUB 0
#endif
#ifndef SUB_MASK
#define SUB_MASK 0xff
#endif
__global__ void __launch_bounds__(NTHR, 2) fwd(Args a) {
    extern __shared__ __attribute__((aligned(16))) unsigned char lds_raw[];
    Frame F;
    const int wave0 = __builtin_amdgcn_readfirstlane((int)threadIdx.x >> 6);
    F.lds = (LAS unsigned char*)lds_raw; F.ws = a.ws; F.G = gridDim.x; F.bid = blockIdx.x; F.wave = wave0; F.lane = lane_id(); F.tid = wave0 * 64 + F.lane;
    volatile LAS unsigned* MISCW = (volatile LAS unsigned*)(F.lds + MISC_OFF);
    for (int u = F.tid; u < (LDS_BYTES - LDSCTL_OFF) / 4; u += NTHR) ((LAS unsigned*)(F.lds + LDSCTL_OFF))[u] = 0u;
    __syncthreads();
    unsigned* barw = (unsigned*)(a.ws + WS_CTL) + CW_BAR;
    XcdBarrier bar; bar.bar = barw; bar.x = 0; bar.st = MISCW + 8;
    const int lo = a.ph_lo, hi = a.ph_hi;
    if (hi - lo > 1) bar = xcd_barrier_post(barw, MISCW + 8, F.tid == 0);
#define SUB(k) ((SUB_MASK >> (k)) & 1)
#define IN(k) (((PH_MASK >> (k)) & 1) && lo <= p0 + (k) && p0 + (k) < hi)
#define PH_BEGIN() int ln_ = lane_id(), b_ = blockIdx.x; asm volatile("" : "+v"(ln_), "+s"(b_)); F.lane = ln_; F.wave = wave0; F.tid = wave0 * 64 + ln_; F.bid = b_; \
    const Args al = load_args(a); F.ws = al.ws
#define SEAM(k) do { if (IN(k) && p0 + (k) + 1 < hi) xcd_barrier(bar, wave0 == 0 && lane_id() == 0); } while (0)
#define WSP(T_, off) ((T_*)(F.ws + (off)))
    for (int l = 0; l < DEPTH; ++l) {
        const int p0 = l * PPL;
        if (IN(0)) { PH_BEGIN(); phase_convert(F, al, l, 0, CV_NITEMS - CV_DEFER, F.bid * NWAVES + F.wave, F.G * NWAVES, l == 0); }
        SEAM(0);
        if (IN(1)) {
            PH_BEGIN();
            if (SUB(5)) phase_small(F, WSP(const bf16_t, WS_XRES));
            {   pg8::Gemm g{WSP(const fp8_t, WS_XB), WSP(const fp8_t, WS_WIN), D, nullptr}; pg8::StaticOrder S; S.init(T, NPROJ, F.G, F.bid);
                pg8::EpiBf16 E{WSP(bf16_t, WS_PROJ), NPROJ, 0};
                pg8::gemm_phase<pg8::EpiBf16, pg8::StaticOrder, false>(F.lds, g, S, E, F.tid); }
            {   pg8::Gemm g{WSP(const fp8_t, WS_XB), WSP(const fp8_t, WS_WIN) + (size_t)NPROJ * D, D, nullptr}; pg8::StaticOrder S; S.init(T, NGATE, F.G, F.bid);
                pg8::EpiGate E{WSP(unsigned char, WS_G8)};
                pg8::gemm_phase<pg8::EpiGate, pg8::StaticOrder, false>(F.lds, g, S, E, F.tid); }
        }
        SEAM(1);
        if (IN(2)) { PH_BEGIN();
            if (SUB(0) && (al.sub & 1)) {
                if (CV_DEFER > 0 && F.bid >= F.G - NCVT) phase_convert_experts(F, al, l, 65 * 768 - CV_DEFER, 65 * 768, (F.bid - (F.G - NCVT)) * NWAVES + F.wave, NCVT * NWAVES);
                phase_attn(F, al, l);
                { int ln2 = lane_id(); asm volatile("" : "+v"(ln2)); F.lane = ln2; F.tid = wave0 * 64 + ln2; } }
            if (SUB(1) && (al.sub & 2)) phase_gla_local(F, al, l); if (SUB(2) && (al.sub & 4)) phase_ssd_local(F, al, l); }
        SEAM(2);
        if (IN(3)) { PH_BEGIN(); phase_gla_scan(F); phase_ssd_scan(F); }
        SEAM(3);
        if (IN(4)) { PH_BEGIN(); if (SUB(3) && (al.sub & 8)) phase_gla_out(F, al, l); if (SUB(4) && (al.sub & 16)) phase_ssd_out(F, al, l); }
        SEAM(4);
        if (IN(5)) {
            PH_BEGIN();
            pg8::Gemm g{WSP(const fp8_t, WS_BRCAT), WSP(const fp8_t, WS_WBR), 3072, nullptr}; pg8::StaticOrder S; S.init(T, D, F.G, F.bid);
            pg8::EpiMerge E{WSP(const unsigned char, WS_G8), WSP(fp8_t, WS_MERGED)};
            pg8::gemm_phase<pg8::EpiMerge, pg8::StaticOrder, false>(F.lds, g, S, E, F.tid);
        }
        SEAM(5);
        if (IN(6)) {
            PH_BEGIN();
            pg8::Gemm g{WSP(const fp8_t, WS_MERGED), WSP(const fp8_t, WS_WOUT), D, nullptr}; pg8::StaticOrder S; S.init(T, D, F.G, F.bid);
            pg8::EpiWout E{WSP(const bf16_t, WS_XRES), WSP(bf16_t, WS_H)};
            pg8::gemm_phase<pg8::EpiWout, pg8::StaticOrder, false>(F.lds, g, S, E, F.tid);
        }
        SEAM(6);
        if (!FUSE_LN1) { if (IN(7)) { PH_BEGIN(); phase_ln1(F, al, l); }
            SEAM(7); }
        if (IN(8)) { PH_BEGIN(); phase_router(F, al, l); }
        SEAM(8);
        if (IN(9)) { PH_BEGIN(); phase_lists(F); }
        SEAM(9);
        if (IN(10)) {
            PH_BEGIN();
            const int nblk = __builtin_amdgcn_readfirstlane(WSP(const int, WS_MISC + MS_NBLK)[0]);
            moe_fill<true>(F, nblk, 4);
            pg8::Gemm g{WSP(const fp8_t, WS_X1B), WSP(const fp8_t, WS_EXP1), D, (const LAS int*)(F.lds + MOE_TOKL)}; MoeOrder2 S{(const LAS int*)(F.lds + MOE_BLKL), nblk, 4, F.G, F.bid};
            pg8::EpiSwiglu E{WSP(fp8_t, WS_HS), EDIM};
            pg8::gemm_phase<pg8::EpiSwiglu, MoeOrder2, true>(F.lds, g, S, E, F.tid);
        }
        SEAM(10);
        if (IN(11)) {
            PH_BEGIN();
            const int nblk = __builtin_amdgcn_readfirstlane(WSP(const int, WS_MISC + MS_NBLK)[0]);
            moe_fill<false>(F, nblk, 8);
            pg8::Gemm g{WSP(const fp8_t, WS_HS), WSP(const fp8_t, WS_EXP2), EDIM, nullptr}; MoeOrder2 S{(const LAS int*)(F.lds + MOE_BLKL), nblk, 8, F.G, F.bid};
            pg8::EpiFp8 E{WSP(fp8_t, WS_OS), D, 8};
            pg8::gemm_phase<pg8::EpiFp8, MoeOrder2, false>(F.lds, g, S, E, F.tid);
        }
        SEAM(11);
        if (IN(12)) { PH_BEGIN(); phase_combine(F, al, l); }
        SEAM(12);
    }
#undef IN
#undef SEAM
}

extern "C" void kernel_launch(void* const* d_in, const int* in_sizes, int n_in, void* d_out, int out_size, void* d_ws, size_t ws_size, hipStream_t stream) {
    static int grid = 0;
    if (grid == 0) {
        if (n_in != 27 || out_size != T * D || ws_size < WS_END) { fprintf(stderr, "kernel_launch: unexpected sizes n_in %d out %d ws %zu (need %zu)\n", n_in, out_size, ws_size, (size_t)WS_END); grid = -1; return; }
        int dev = 0, cus = 0, per_cu = 0;
        if (hipGetDevice(&dev) != hipSuccess || hipDeviceGetAttribute(&cus, hipDeviceAttributeMultiprocessorCount, dev) != hipSuccess) { grid = -1; return; }
        if (hipFuncSetAttribute((const void*)fwd, hipFuncAttributeMaxDynamicSharedMemorySize, LDS_BYTES) != hipSuccess) { fprintf(stderr, "kernel_launch: hipFuncSetAttribute failed\n"); grid = -1; return; }
        if (hipOccupancyMaxActiveBlocksPerMultiprocessor(&per_cu, (const void*)fwd, NTHR, LDS_BYTES) != hipSuccess || per_cu < 1) fprintf(stderr, "kernel_launch: occupancy query says %d\n", per_cu);
        (void)hipGetLastError();
        grid = cus;
    }
    if (grid < 0) return;
    if (hipMemsetAsync((char*)d_ws + WS_CTL, 0, CTL_ZERO_BYTES, stream) != hipSuccess) return;
    Args a{};
    for (int i = 0; i < 27; ++i) a.in[i] = (const float*)d_in[i];
    a.out = (float*)d_out; a.ws = (unsigned char*)d_ws; a.sub = 0xff; a.pad = 0;
#if MK_ONE_LAUNCH
    a.ph_lo = 0; a.ph_hi = NPH;
    hipLaunchKernelGGL(fwd, dim3(grid), dim3(NTHR), LDS_BYTES, stream, a);
#else
    for (int k = 0; k < NPH; ++k) { a.ph_lo = k; a.ph_hi = k + 1;
#ifdef HOTPROBE
#ifndef HOTPHASE
#define HOTPHASE 1
#endif
        if ((k % PPL) == HOTPHASE) { a.pad = HOTPROBE; hipLaunchKernelGGL(fwd, dim3(grid), dim3(NTHR), LDS_BYTES, stream, a); a.pad = 0; }
#endif
        const int reps = ((REP_MASK >> (k % PPL)) & 1) ? 2 : 1;
        for (int r = 0; r < reps; ++r) hipLaunchKernelGGL(fwd, dim3(grid), dim3(NTHR), LDS_BYTES, stream, a);
        if (REP_SUB && ((k % PPL) == 2 || (k % PPL) == 4)) { a.sub = REP_SUB; hipLaunchKernelGGL(fwd, dim3(grid), dim3(NTHR), LDS_BYTES, stream, a); a.sub = 0xff; } }
#endif
}
```
